# Optimizing an MI355X kernel written in HIP

```python
import jax, jax.numpy as jnp
from jax import lax
import numpy as np

D_MODEL = 4096
BATCH = 1
SEQ = 8192
DEPTH = 1

CHUNK = 64
Q_BLOCK = 128
D_MIX = D_MODEL
FOX_HEADS = 16
FOX_HEAD_DIM = 128
FOX_WIDTH = FOX_HEADS * FOX_HEAD_DIM
HGRN_HEADS = 16
HGRN_DK = 128
HGRN_DV = 128
HGRN_KWIDTH = HGRN_HEADS * HGRN_DK
HGRN_VWIDTH = HGRN_HEADS * HGRN_DV
D_FF = 11008
CONV_WIDTH = 3
N_MOD = 6
EPS = 1e-6

FOX_Q0 = 0
FOX_K0 = FOX_Q0 + FOX_WIDTH
FOX_V0 = FOX_K0 + FOX_WIDTH
FOX_F0 = FOX_V0 + FOX_WIDTH
HG_Q0 = FOX_F0 + FOX_HEADS
HG_F0 = HG_Q0 + HGRN_KWIDTH
HG_I0 = HG_F0 + HGRN_KWIDTH
HG_G0 = HG_I0 + HGRN_VWIDTH
IN_COLS = HG_G0 + HGRN_VWIDTH

kernel_name = "hybrid_fox_hgrn2_convffn_adaln"


def rms_norm(x, g):
    xf = x.astype(jnp.float32)
    y = xf * lax.rsqrt(jnp.mean(xf * xf, axis=-1, keepdims=True) + EPS)
    return (y * g.astype(jnp.float32)).astype(x.dtype)


def modulate(h, shift, scale):
    return h * (1 + scale[:, None, :]) + shift[:, None, :]


def forgetting_attention(q, k, v, log_f):
    B, T, H, Dh = q.shape
    nb = T // Q_BLOCK
    cum = jnp.cumsum(log_f, axis=1).transpose(0, 2, 1)
    qh = q.transpose(0, 2, 1, 3)
    kh = k.transpose(0, 2, 1, 3)
    vh = v.transpose(0, 2, 1, 3)
    qb = qh.reshape(B, H, nb, Q_BLOCK, Dh).transpose(2, 0, 1, 3, 4)
    cb = cum.reshape(B, H, nb, Q_BLOCK).transpose(2, 0, 1, 3)
    pos = jnp.arange(T)
    pb = pos.reshape(nb, Q_BLOCK)
    scale = Dh ** -0.5

    def block(args):
        q_blk, c_blk, p_blk = args
        s = jnp.einsum('bhqd,bhkd->bhqk', q_blk, kh).astype(jnp.float32) * scale
        s = s + c_blk[..., :, None] - cum[..., None, :]
        mask = pos[None, :] <= p_blk[:, None]
        s = jnp.where(mask, s, -jnp.inf)
        p = jax.nn.softmax(s, axis=-1)
        return jnp.einsum('bhqk,bhkd->bhqd', p.astype(vh.dtype), vh)

    ob = lax.map(block, (qb, cb, pb))
    return ob.transpose(1, 0, 3, 2, 4).reshape(B, T, H, Dh)


def hgrn2_recurrence(q, f, i, lb):
    B, T, H, Dk = q.shape
    Dv = i.shape[-1]
    n = T // CHUNK
    lbh = lb.reshape(H, Dk)
    fg = lbh + (1 - lbh) * jax.nn.sigmoid(f.astype(jnp.float32))
    log_f = jnp.log(fg)
    kk = 1 - fg
    qf = jax.nn.silu(q.astype(jnp.float32))

    def chunks(a):
        return a.reshape(B, n, CHUNK, H, a.shape[-1]).transpose(1, 0, 3, 2, 4)

    xs = (chunks(qf), chunks(kk), chunks(log_f), chunks(i.astype(jnp.float32)))
    causal = jnp.tril(jnp.ones((CHUNK, CHUNK), dtype=bool))

    def step(S, inp):
        qc, kc, lc, ic = inp
        b = jnp.cumsum(lc, axis=2)
        o_inter = jnp.einsum('bhtk,bhkv->bhtv', qc * jnp.exp(b), S)
        rel = jnp.where(causal[:, :, None], b[:, :, :, None, :] - b[:, :, None, :, :], -jnp.inf)
        A = jnp.einsum('bhtk,bhsk,bhtsk->bhts', qc, kc, jnp.exp(rel))
        o_intra = jnp.einsum('bhts,bhsv->bhtv', A, ic)
        b_last = b[:, :, -1:, :]
        S = jnp.exp(b_last[:, :, 0, :, None]) * S + jnp.einsum(
            'bhsk,bhsv->bhkv', kc * jnp.exp(b_last - b), ic)
        return S, o_inter + o_intra

    S0 = jnp.zeros((B, H, Dk, Dv), jnp.float32)
    _, o = lax.scan(step, S0, xs)
    return o.transpose(1, 0, 3, 2, 4).reshape(B, T, H, Dv)


def causal_depthwise_conv(u, w, b):
    T = u.shape[1]
    up = jnp.pad(u, ((0, 0), (CONV_WIDTH - 1, 0), (0, 0)))
    y = b + w[0] * up[:, 0:T]
    for j in range(1, CONV_WIDTH):
        y = y + w[j] * up[:, j:j + T]
    return y


def setup_inputs(seed: int = 0) -> dict:
    key = jax.random.key(seed)
    ks = jax.random.split(key, 17)
    f32 = jnp.float32
    nrm = lambda k, shape, s: jax.random.normal(k, shape, f32) * s
    return {
        "x": nrm(ks[0], (BATCH, SEQ, D_MODEL), 1.0),
        "c": nrm(ks[1], (BATCH, D_MODEL), 1.0),
        "w_ada": nrm(ks[2], (DEPTH, D_MODEL, N_MOD * D_MODEL), 0.5 * D_MODEL ** -0.5),
        "b_ada": nrm(ks[3], (DEPTH, N_MOD * D_MODEL), 0.02),
        "g_mix_norm": 1.0 + nrm(ks[4], (DEPTH, D_MODEL), 0.02),
        "w_in": nrm(ks[5], (DEPTH, D_MODEL, IN_COLS), D_MODEL ** -0.5),
        "b_fox_f": nrm(ks[6], (DEPTH, FOX_HEADS), 0.1),
        "hgrn_lb_logits": nrm(ks[7], (DEPTH + 1, HGRN_KWIDTH), 1.0),
        "g_fox_out": 1.0 + nrm(ks[8], (DEPTH, FOX_WIDTH), 0.02),
        "g_hgrn_out": 1.0 + nrm(ks[9], (DEPTH, HGRN_VWIDTH), 0.02),
        "w_out": nrm(ks[10], (DEPTH, D_MIX, D_MODEL), D_MIX ** -0.5),
        "g_ffn_norm": 1.0 + nrm(ks[11], (DEPTH, D_MODEL), 0.02),
        "w_up": nrm(ks[12], (DEPTH, D_MODEL, 2 * D_FF), D_MODEL ** -0.5),
        "conv_w": nrm(ks[13], (DEPTH, CONV_WIDTH, 2 * D_FF), CONV_WIDTH ** -0.5),
        "conv_b": nrm(ks[14], (DEPTH, 2 * D_FF), 0.02),
        "w_down": nrm(ks[15], (DEPTH, D_FF, D_MODEL), D_FF ** -0.5),
        "g_final": 1.0 + nrm(ks[16], (D_MODEL,), 0.02),
    }


def reference(x, c, w_ada, b_ada, g_mix_norm, w_in, b_fox_f, hgrn_lb_logits, g_fox_out,
              g_hgrn_out, w_out, g_ffn_norm, w_up, conv_w, conv_b, w_down, g_final):
    B, T, _ = x.shape
    lb_table = jnp.cumsum(jax.nn.softmax(hgrn_lb_logits.astype(jnp.float32), axis=0), axis=0)
    cond = jax.nn.silu(c)
    for l in range(DEPTH):
        mod = cond @ w_ada[l] + b_ada[l]
        sh1, sc1, gt1, sh2, sc2, gt2 = jnp.split(mod, N_MOD, axis=-1)

        h = modulate(rms_norm(x, g_mix_norm[l]), sh1, sc1)
        proj = h @ w_in[l]
        fq = proj[..., FOX_Q0:FOX_K0].reshape(B, T, FOX_HEADS, FOX_HEAD_DIM)
        fk = proj[..., FOX_K0:FOX_V0].reshape(B, T, FOX_HEADS, FOX_HEAD_DIM)
        fv = proj[..., FOX_V0:FOX_F0].reshape(B, T, FOX_HEADS, FOX_HEAD_DIM)
        log_f = jax.nn.log_sigmoid((proj[..., FOX_F0:HG_Q0] + b_fox_f[l]).astype(jnp.float32))
        hq = proj[..., HG_Q0:HG_F0].reshape(B, T, HGRN_HEADS, HGRN_DK)
        hf = proj[..., HG_F0:HG_I0].reshape(B, T, HGRN_HEADS, HGRN_DK)
        hi = proj[..., HG_I0:HG_G0].reshape(B, T, HGRN_HEADS, HGRN_DV)
        hg = proj[..., HG_G0:IN_COLS].reshape(B, T, HGRN_HEADS, HGRN_DV)

        o_fox = forgetting_attention(fq, fk, fv, log_f)
        o_fox = rms_norm(o_fox, g_fox_out[l].reshape(FOX_HEADS, FOX_HEAD_DIM))
        o_hg = hgrn2_recurrence(hq, hf, hi, lb_table[l]).astype(x.dtype)
        o_hg = rms_norm(o_hg, g_hgrn_out[l].reshape(HGRN_HEADS, HGRN_DV)) * jax.nn.silu(hg)

        mixed = jnp.concatenate([o_fox.reshape(B, T, FOX_WIDTH),
                                 o_hg.reshape(B, T, HGRN_VWIDTH)], axis=-1)
        x = x + gt1[:, None, :] * (mixed @ w_out[l])

        h = modulate(rms_norm(x, g_ffn_norm[l]), sh2, sc2)
        u = causal_depthwise_conv(h @ w_up[l], conv_w[l], conv_b[l])
        a, v = jnp.split(u, 2, axis=-1)
        x = x + gt2[:, None, :] * ((jax.nn.silu(a) * v) @ w_down[l])
    return rms_norm(x, g_final)
```

```cpp
#include <hip/hip_runtime.h>
#include <cstdio>
#include <cstdint>

namespace nv {
constexpr int T = 8192, D = 4096, NMOD = 6 * D, INC = 14352, FF = 11008, FF2 = 22016;
constexpr int FOX_F0 = 6144, HG_Q0 = 6160, HG_F0 = HG_Q0 + 2048, HG_I0 = HG_F0 + 2048, HG_G0 = HG_I0 + 2048;
constexpr float EPS = 1e-6f;

__device__ __forceinline__ float sigmoidf_(float z) { return 1.f / (1.f + __expf(-z)); }
__device__ __forceinline__ float siluf_(float z) { return z / (1.f + __expf(-z)); }

__global__ void k_mod(const float* c, const float* w, const float* b, float* mod, const float* lbl, float* lb) {
    const int n = blockIdx.x * 256 + threadIdx.x;
    if (n < NMOD) {
        float s = 0.f;
        for (int k = 0; k < D; ++k) s += siluf_(c[k]) * w[(size_t)k * NMOD + n];
        mod[n] = s + b[n];
    }
    if (n < 2048) lb[n] = sigmoidf_(lbl[n] - lbl[2048 + n]);
}
__global__ void k_rmsmod(const float* x, const float* g, const float* sh, const float* sc, float* y) {
    __shared__ float red[256];
    const int row = blockIdx.x, tid = threadIdx.x;
    const float* xr = x + (size_t)row * D; float s = 0.f;
    for (int i = tid; i < D; i += 256) { const float v = xr[i]; s += v * v; }
    red[tid] = s; __syncthreads();
    for (int o = 128; o > 0; o >>= 1) { if (tid < o) red[tid] += red[tid + o]; __syncthreads(); }
    const float r = rsqrtf(red[0] / D + EPS);
    for (int i = tid; i < D; i += 256) { float v = xr[i] * r * g[i]; if (sc) v = v * (1.f + sc[i]) + sh[i]; y[(size_t)row * D + i] = v; }
}
template <int EPI>
__global__ __launch_bounds__(256) void k_gemm(const float* __restrict__ A, const float* __restrict__ B, float* __restrict__ C, int M, int N, int K,
                                               const float* __restrict__ R, const float* __restrict__ gate) {
    __shared__ float As[16][132], Bs[16][132];
    const int bm = blockIdx.y * 128, bn = blockIdx.x * 128, tid = threadIdx.x, tx = tid & 15, ty = tid >> 4;
    float acc[8][8];
#pragma unroll
    for (int i = 0; i < 8; ++i)
#pragma unroll
        for (int j = 0; j < 8; ++j) acc[i][j] = 0.f;
    const int ar = tid >> 1, ac = (tid & 1) * 8, br = tid >> 4, bc = (tid & 15) * 8;
    for (int k0 = 0; k0 < K; k0 += 16) {
        const float4 a0 = *(const float4*)(A + (size_t)(bm + ar) * K + k0 + ac), a1 = *(const float4*)(A + (size_t)(bm + ar) * K + k0 + ac + 4);
        float4 b0 = make_float4(0, 0, 0, 0), b1 = b0;
        if (bn + bc < N) { b0 = *(const float4*)(B + (size_t)(k0 + br) * N + bn + bc); b1 = *(const float4*)(B + (size_t)(k0 + br) * N + bn + bc + 4); }
        __syncthreads();
        As[ac + 0][ar] = a0.x; As[ac + 1][ar] = a0.y; As[ac + 2][ar] = a0.z; As[ac + 3][ar] = a0.w;
        As[ac + 4][ar] = a1.x; As[ac + 5][ar] = a1.y; As[ac + 6][ar] = a1.z; As[ac + 7][ar] = a1.w;
        *(float4*)&Bs[br][bc] = b0; *(float4*)&Bs[br][bc + 4] = b1;
        __syncthreads();
#pragma unroll
        for (int kk = 0; kk < 16; ++kk) {
            float a[8], b[8];
            *(float4*)&a[0] = *(const float4*)&As[kk][ty * 8]; *(float4*)&a[4] = *(const float4*)&As[kk][ty * 8 + 4];
            *(float4*)&b[0] = *(const float4*)&Bs[kk][tx * 8]; *(float4*)&b[4] = *(const float4*)&Bs[kk][tx * 8 + 4];
#pragma unroll
            for (int i = 0; i < 8; ++i)
#pragma unroll
                for (int j = 0; j < 8; ++j) acc[i][j] += a[i] * b[j];
        }
    }
    if (bn + tx * 8 < N) {
#pragma unroll
        for (int i = 0; i < 8; ++i) {
            const size_t off = (size_t)(bm + ty * 8 + i) * N + bn + tx * 8;
#pragma unroll
            for (int j = 0; j < 8; ++j) {
                float v = acc[i][j];
                if (EPI == 1) v = R[off + j] + gate[bn + tx * 8 + j] * v;
                C[off + j] = v;
            }
        }
    }
}
__global__ void k_cum(const float* proj, const float* bf, double* cum) {
    const int h = threadIdx.x; if (h >= 16) return;
    double c = 0.0;
    for (int t = 0; t < T; ++t) { const float z = proj[(size_t)t * INC + FOX_F0 + h] + bf[h]; const float ls = fminf(z, 0.f) - log1pf(__expf(-fabsf(z))); c += (double)ls; cum[h * T + t] = c; }
}
__global__ __launch_bounds__(256) void k_attn(const float* proj, const double* cum, float* ofox) {
    __shared__ float Ks[32][128], Vs[32][128]; __shared__ double Cs[32];
    const int h = blockIdx.y, qb = blockIdx.x, tid = threadIdx.x, r = tid >> 2, part = tid & 3, t = qb * 64 + r;
    float q[32], o[32];
    const float scale = 0.08838834764831845f;
#pragma unroll
    for (int i = 0; i < 32; ++i) { q[i] = proj[(size_t)t * INC + h * 128 + part * 32 + i] * scale; o[i] = 0.f; }
    float m = -1e30f, l = 0.f; const double ct = cum[h * T + t];
    for (int kt = 0; kt <= qb * 2 + 1; ++kt) {
        __syncthreads();
        for (int e = tid; e < 32 * 128; e += 256) { const int s = e >> 7, d = e & 127; const size_t base = (size_t)(kt * 32 + s) * INC + h * 128 + d;
            Ks[s][d] = proj[base + 2048]; Vs[s][d] = proj[base + 4096]; }
        if (tid < 32) Cs[tid] = cum[h * T + kt * 32 + tid];
        __syncthreads();
        for (int s = 0; s < 32; ++s) {
            float d = 0.f;
#pragma unroll
            for (int i = 0; i < 32; ++i) d += q[i] * Ks[s][part * 32 + i];
            d += __shfl_xor(d, 1); d += __shfl_xor(d, 2);
            const int sg = kt * 32 + s;
            if (sg <= t) {
                const float sc = d + (float)(ct - Cs[s]);
                const float mn = fmaxf(m, sc), a = __expf(m - mn), p = __expf(sc - mn);
                l = l * a + p; m = mn;
#pragma unroll
                for (int i = 0; i < 32; ++i) o[i] = o[i] * a + p * Vs[s][part * 32 + i];
            }
        }
    }
    const float il = 1.f / l;
#pragma unroll
    for (int i = 0; i < 32; ++i) ofox[(size_t)t * 2048 + h * 128 + part * 32 + i] = o[i] * il;
}
__global__ __launch_bounds__(256) void k_hgrn(const float* proj, const float* lb, float* ohg) {
    const int w = blockIdx.x * 4 + (threadIdx.x >> 6), lane = threadIdx.x & 63, h = w >> 7, v = w & 127;
    const float lb0 = lb[h * 128 + lane], lb1 = lb[h * 128 + lane + 64];
    float S0 = 0.f, S1 = 0.f;
    for (int t = 0; t < T; ++t) {
        const float* p = proj + (size_t)t * INC;
        const float f0 = p[HG_F0 + h * 128 + lane], f1 = p[HG_F0 + h * 128 + lane + 64];
        const float q0 = siluf_(p[HG_Q0 + h * 128 + lane]), q1 = siluf_(p[HG_Q0 + h * 128 + lane + 64]);
        const float iv = p[HG_I0 + h * 128 + v];
        const float s0 = sigmoidf_(f0), s1 = sigmoidf_(f1);
        const float fg0 = lb0 + (1.f - lb0) * s0, fg1 = lb1 + (1.f - lb1) * s1;
        const float k0 = (1.f - lb0) * (1.f - s0), k1 = (1.f - lb1) * (1.f - s1);
        S0 = fg0 * S0 + k0 * iv; S1 = fg1 * S1 + k1 * iv;
        float o = S0 * q0 + S1 * q1;
#pragma unroll
        for (int d = 1; d < 64; d <<= 1) o += __shfl_xor(o, d);
        if (lane == 0) ohg[(size_t)t * 2048 + h * 128 + v] = o;
    }
}
__global__ __launch_bounds__(256) void k_headnorm(const float* ofox, const float* ohg, const float* proj, const float* gfox, const float* ghg, float* mixed) {
    const int w = blockIdx.x * 4 + (threadIdx.x >> 6), lane = threadIdx.x & 63, t = w >> 5, hs = w & 31;
    const bool fox = hs < 16; const int h = hs & 15;
    const float* src = (fox ? ofox : ohg) + (size_t)t * 2048 + h * 128;
    const float v0 = src[lane], v1 = src[lane + 64];
    float s = v0 * v0 + v1 * v1;
#pragma unroll
    for (int d = 1; d < 64; d <<= 1) s += __shfl_xor(s, d);
    const float r = rsqrtf(s / 128.f + EPS);
    const float* g = (fox ? gfox : ghg) + h * 128;
    float y0 = v0 * r * g[lane], y1 = v1 * r * g[lane + 64];
    if (!fox) { y0 *= siluf_(proj[(size_t)t * INC + HG_G0 + h * 128 + lane]); y1 *= siluf_(proj[(size_t)t * INC + HG_G0 + h * 128 + lane + 64]); }
    mixed[(size_t)t * D + hs * 128 + lane] = y0; mixed[(size_t)t * D + hs * 128 + lane + 64] = y1;
}
__global__ void k_convact(const float* u, const float* cw, const float* cb, float* act) {
    const size_t idx = (size_t)blockIdx.x * 256 + threadIdx.x; if (idx >= (size_t)T * FF) return;
    const int t = (int)(idx / FF), j = (int)(idx % FF);
    float a = cb[j], v = cb[FF + j];
#pragma unroll
    for (int jj = 0; jj < 3; ++jj) { const int tt = t - 2 + jj; if (tt >= 0) { a += cw[jj * FF2 + j] * u[(size_t)tt * FF2 + j]; v += cw[jj * FF2 + FF + j] * u[(size_t)tt * FF2 + FF + j]; } }
    act[idx] = siluf_(a) * v;
}
}

extern "C" void kernel_launch(void* const* d_in, const int* in_sizes, int n_in, void* d_out, int out_size, void* d_ws, size_t ws_size, hipStream_t stream) {
    using namespace nv;
    const float* x = (const float*)d_in[0]; const float* c = (const float*)d_in[1]; const float* w_ada = (const float*)d_in[2]; const float* b_ada = (const float*)d_in[3];
    const float* g_mix = (const float*)d_in[4]; const float* w_in = (const float*)d_in[5]; const float* b_fox = (const float*)d_in[6]; const float* lbl = (const float*)d_in[7];
    const float* g_fox = (const float*)d_in[8]; const float* g_hg = (const float*)d_in[9]; const float* w_out = (const float*)d_in[10]; const float* g_ffn = (const float*)d_in[11];
    const float* w_up = (const float*)d_in[12]; const float* conv_w = (const float*)d_in[13]; const float* conv_b = (const float*)d_in[14]; const float* w_down = (const float*)d_in[15];
    const float* g_fin = (const float*)d_in[16];
    float* out = (float*)d_out;
    constexpr size_t MiB = 1u << 20;
    char* ws = (char*)d_ws;
    float* proj = (float*)(ws); float* u = (float*)(ws);
    float* act = (float*)(ws + 700 * MiB);
    float* hbuf = (float*)(ws + 1050 * MiB); float* mixed = (float*)(ws + 1180 * MiB); float* x1 = (float*)(ws + 1310 * MiB);
    float* ofox = (float*)(ws + 700 * MiB);
    float* ohg = (float*)(ws + 800 * MiB);
    float* mod = (float*)(ws + 1440 * MiB); float* lb = mod + NMOD; double* cum = (double*)(ws + 1441 * MiB);
    if (ws_size < 1450 * MiB) { fprintf(stderr, "kernel_launch: workspace too small (%zu)\n", ws_size); return; }
    const float *sh1 = mod, *sc1 = mod + D, *gt1 = mod + 2 * D, *sh2 = mod + 3 * D, *sc2 = mod + 4 * D, *gt2 = mod + 5 * D;
    k_mod<<<NMOD / 256, 256, 0, stream>>>(c, w_ada, b_ada, mod, lbl, lb);
    k_rmsmod<<<T, 256, 0, stream>>>(x, g_mix, sh1, sc1, hbuf);
    k_gemm<0><<<dim3((INC + 127) / 128, T / 128), 256, 0, stream>>>(hbuf, w_in, proj, T, INC, D, nullptr, nullptr);
    k_cum<<<1, 64, 0, stream>>>(proj, b_fox, cum);
    k_attn<<<dim3(T / 64, 16), 256, 0, stream>>>(proj, cum, ofox);
    k_hgrn<<<16 * 128 / 4, 256, 0, stream>>>(proj, lb, ohg);
    k_headnorm<<<T * 32 / 4, 256, 0, stream>>>(ofox, ohg, proj, g_fox, g_hg, mixed);
    k_gemm<1><<<dim3(D / 128, T / 128), 256, 0, stream>>>(mixed, w_out, x1, T, D, D, x, gt1);
    k_rmsmod<<<T, 256, 0, stream>>>(x1, g_ffn, sh2, sc2, hbuf);
    k_gemm<0><<<dim3(FF2 / 128, T / 128), 256, 0, stream>>>(hbuf, w_up, u, T, FF2, D, nullptr, nullptr);
    k_convact<<<(unsigned)(((size_t)T * FF + 255) / 256), 256, 0, stream>>>(u, conv_w, conv_b, act);
    k_gemm<1><<<dim3(D / 128, T / 128), 256, 0, stream>>>(act, w_down, x1, T, D, FF, x1, gt2);
    k_rmsmod<<<T, 256, 0, stream>>>(x1, g_fin, nullptr, nullptr, out);
}
```

```cpp
#include <hip/hip_runtime.h>
#include <cstdio>
#include <cstdint>

constexpr int T = 8192, D = 4096, NMOD = 6 * D, INC = 14352, FF = 11008, FF2 = 22016, NH = 16, HD = 128;
constexpr int FOX_F0 = 6144, HG_Q0 = 6160, HG_F0 = HG_Q0 + 2048, HG_I0 = HG_F0 + 2048, HG_G0 = HG_I0 + 2048;
constexpr int NPROJ = 14336;
constexpr float EPS = 1e-6f;
constexpr float LOG2E = 1.4426950408889634f;
constexpr float QSCALE = 0.08838834764831845f * 1.4426950408889634f;
constexpr size_t HEADBUF = (size_t)NH * T * HD;
__device__ __forceinline__ int lane_id() { int l; asm volatile("v_mbcnt_lo_u32_b32 %0, -1, 0\n\tv_mbcnt_hi_u32_b32 %0, -1, %0" : "=v"(l)); return l; }


#ifndef PG8_WGM
#define PG8_WGM 8
#endif
namespace pg8 {
#define PG8_LAS __attribute__((address_space(3)))
typedef unsigned short bf16_t;
typedef short bf16x8 __attribute__((ext_vector_type(8)));
typedef float f32x4 __attribute__((ext_vector_type(4)));
typedef unsigned u32x4 __attribute__((ext_vector_type(4)));
constexpr int BM = 256, BK = 64, HALF = 128, HTB = HALF * BK * 2  , STAGE_BYTES = 8 * HTB, NXCD = 8, WGM = PG8_WGM;

__host__ __device__ __forceinline__ int lds_byte(int r, int c) { const int st = (r >> 4) * 2 + (c >> 5), rr = r & 15, cc = c & 31, ob = rr * 64 + cc * 2; return st * 1024 + (ob ^ (((ob >> 9) & 1) << 5)); }
__host__ __device__ __forceinline__ void stage_rc(int b, int& R, int& C) { const int st = b / 1024, sb = b % 1024, swz = sb ^ (((sb >> 9) & 1) << 5); R = (st >> 1) * 16 + swz / 64; C = (st & 1) * 32 + (swz % 64) / 2; }
__host__ __device__ __forceinline__ int perm32(int rho) { const int n = rho >> 4, i = rho & 15; return 8 * (i >> 2) + 4 * n + (i & 3); }

struct Unit { int pm, pn; };
struct Gemm { const bf16_t* A; const bf16_t* Bt; int M, N, K; };

struct StaticOrder {
    int nM, nN, nwg, G, c;
    __host__ __device__ void init(int M, int N, int G_, int c_) { nM = M / BM; nN = N / BM; nwg = nM * nN; G = G_; c = c_; }
    __host__ __device__ bool next(int i, Unit& u) const {
        const long L = (long)i * G + c; if (L >= nwg) return false;
        int wgid = (int)L; { const int q = nwg / NXCD, r = nwg % NXCD, xcd = wgid % NXCD, off = wgid / NXCD; wgid = (xcd < r ? xcd * (q + 1) : r * (q + 1) + (xcd - r) * q) + off; }
        const int nig = WGM * nN, gid = wgid / nig, fm = gid * WGM, gsz = (nM - fm) < WGM ? (nM - fm) : WGM;
        u.pm = fm + ((wgid % nig) % gsz); u.pn = (wgid % nig) / gsz; return true;
    }
    __device__ __forceinline__ void a_ready(const Unit&) const {}
    __device__ __forceinline__ void done(const Unit&) const {}
};


__device__ __forceinline__ unsigned cvt_pk_bf16(float lo, float hi) { unsigned r; asm volatile("v_cvt_pk_bf16_f32 %0, %1, %2" : "=v"(r) : "v"(lo), "v"(hi)); return r; }
__device__ __forceinline__ float silu_f(float v) { return v * __builtin_amdgcn_rcpf(1.0f + __builtin_amdgcn_exp2f(-1.4426950408889634f * v)); }
struct EpiBf16 {
    static constexpr bool PERM = true, AFTER_DRAIN = false;
    bf16_t* O; int ldc;
    __device__ __forceinline__ void operator()(const f32x4 (&acc)[2][2][4][2], const Unit& u, int wr, int wc, int fr, int fq) const {
        const int row0 = u.pm * BM + wr * 64 + fr, col0 = u.pn * BM + wc * 32 + 8 * fq;
#pragma unroll
        for (int ai = 0; ai < 2; ++ai)
#pragma unroll
            for (int m = 0; m < 4; ++m) { bf16_t* rowp = O + (size_t)(row0 + ai * HALF + m * 16) * ldc + col0;
#pragma unroll
                for (int bj = 0; bj < 2; ++bj) { const f32x4 v0 = acc[ai][bj][m][0], v1 = acc[ai][bj][m][1];
                    u32x4 w; w.x = cvt_pk_bf16(v0[0], v0[1]); w.y = cvt_pk_bf16(v0[2], v0[3]); w.z = cvt_pk_bf16(v1[0], v1[1]); w.w = cvt_pk_bf16(v1[2], v1[3]);
                    *(u32x4*)(rowp + bj * HALF) = w; } }
    }
};
struct EpiProj {
    static constexpr bool PERM = true, AFTER_DRAIN = false;
    bf16_t* base; size_t bufsz; int tlen; float qscale; float* nrm4;
    __device__ __forceinline__ void operator()(const f32x4 (&acc)[2][2][4][2], const Unit& u, int wr, int wc, int fr, int fq) const {
        const int type = u.pn >> 3, hp = u.pn & 7;
        const int row0 = u.pm * BM + wr * 64 + fr, cin = wc * 32 + 8 * fq;
        bf16_t* tb = base + (size_t)type * bufsz;
        const bool act = (type == 3) || (type == 6); const float sc = (type == 0) ? qscale : 1.0f;
#pragma unroll
        for (int ai = 0; ai < 2; ++ai)
#pragma unroll
            for (int m = 0; m < 4; ++m) { const int row = row0 + ai * HALF + m * 16;
#pragma unroll
                for (int bj = 0; bj < 2; ++bj) { f32x4 v0 = acc[ai][bj][m][0], v1 = acc[ai][bj][m][1];
                    if (act) {
#pragma unroll
                        for (int e = 0; e < 4; ++e) { v0[e] = silu_f(v0[e]); v1[e] = silu_f(v1[e]); } }
                    v0 = v0 * sc; v1 = v1 * sc;
                    u32x4 w; w.x = cvt_pk_bf16(v0[0], v0[1]); w.y = cvt_pk_bf16(v0[2], v0[3]); w.z = cvt_pk_bf16(v1[0], v1[1]); w.w = cvt_pk_bf16(v1[2], v1[3]);
                    *(u32x4*)(tb + ((size_t)(2 * hp + bj) * tlen + row) * 128 + cin) = w; } }
        if (type <= 1) {
#pragma unroll
            for (int ai = 0; ai < 2; ++ai)
#pragma unroll
                for (int bj = 0; bj < 2; ++bj) { float mx = 0.f;
#pragma unroll
                    for (int m = 0; m < 4; ++m) { const f32x4 v0 = acc[ai][bj][m][0] * sc, v1 = acc[ai][bj][m][1] * sc;
                        float ss = (v0[0] * v0[0] + v0[1] * v0[1]) + (v0[2] * v0[2] + v0[3] * v0[3]) + (v1[0] * v1[0] + v1[1] * v1[1]) + (v1[2] * v1[2] + v1[3] * v1[3]);
                        ss += __shfl_xor(ss, 16); ss += __shfl_xor(ss, 32); mx = fmaxf(mx, ss); }
                    mx = fmaxf(mx, __shfl_xor(mx, 1)); mx = fmaxf(mx, __shfl_xor(mx, 2)); mx = fmaxf(mx, __shfl_xor(mx, 4)); mx = fmaxf(mx, __shfl_xor(mx, 8));
                    if (fr == 0 && fq == 0) nrm4[(((size_t)type * 16 + 2 * hp + bj) * (tlen / 64) + (u.pm * 4 + 2 * ai + wr)) * 4 + wc] = mx * 1.01f; }
        }
    }
};
struct EpiGate {
    static constexpr bool PERM = true, AFTER_DRAIN = false;
    bf16_t* O; int ldc; const float* gate;
    __device__ __forceinline__ void operator()(const f32x4 (&acc)[2][2][4][2], const Unit& u, int wr, int wc, int fr, int fq) const {
        const int row0 = u.pm * BM + wr * 64 + fr, col0 = u.pn * BM + wc * 32 + 8 * fq;
        f32x4 gv[2][2];
#pragma unroll
        for (int bj = 0; bj < 2; ++bj)
#pragma unroll
            for (int n = 0; n < 2; ++n) gv[bj][n] = *(const f32x4*)(gate + col0 + bj * HALF + 4 * n);
#pragma unroll
        for (int ai = 0; ai < 2; ++ai)
#pragma unroll
            for (int m = 0; m < 4; ++m) { bf16_t* rowp = O + (size_t)(row0 + ai * HALF + m * 16) * ldc + col0;
#pragma unroll
                for (int bj = 0; bj < 2; ++bj) { const f32x4 v0 = acc[ai][bj][m][0] * gv[bj][0], v1 = acc[ai][bj][m][1] * gv[bj][1];
                    u32x4 w; w.x = cvt_pk_bf16(v0[0], v0[1]); w.y = cvt_pk_bf16(v0[2], v0[3]); w.z = cvt_pk_bf16(v1[0], v1[1]); w.w = cvt_pk_bf16(v1[2], v1[3]);
                    *(u32x4*)(rowp + bj * HALF) = w; } }
    }
};
struct EpiRes {
    static constexpr bool PERM = false, AFTER_DRAIN = false;
    const float* R; float* out; int ldc; const float* gate;
    __device__ __forceinline__ void operator()(const f32x4 (&acc)[2][2][4][2], const Unit& u, int wr, int wc, int fr, int fq) const {
        const int col0 = u.pn * BM + wc * 32 + 4 * fq;
        f32x4 gv[2][2];
#pragma unroll
        for (int bj = 0; bj < 2; ++bj)
#pragma unroll
            for (int n = 0; n < 2; ++n) gv[bj][n] = *(const f32x4*)(gate + col0 + bj * HALF + n * 16);
#pragma unroll
        for (int ai = 0; ai < 2; ++ai)
#pragma unroll
            for (int m = 0; m < 4; ++m) { const size_t off = (size_t)(u.pm * BM + ai * HALF + wr * 64 + m * 16 + fr) * ldc + col0;
#pragma unroll
                for (int bj = 0; bj < 2; ++bj)
#pragma unroll
                    for (int n = 0; n < 2; ++n) { const f32x4 rs = *(const f32x4*)(R + off + bj * HALF + n * 16);
                        *(f32x4*)(out + off + bj * HALF + n * 16) = rs + gv[bj][n] * acc[ai][bj][m][n]; } }
    }
};


__device__ __forceinline__ float dpp_f(float oldv, float src, const int ctrl_sel) {
    return ctrl_sel == 0 ? __int_as_float(__builtin_amdgcn_update_dpp(__float_as_int(oldv), __float_as_int(src), 0x111, 0xF, 0xF, false))
         : ctrl_sel == 1 ? __int_as_float(__builtin_amdgcn_update_dpp(__float_as_int(oldv), __float_as_int(src), 0x112, 0xF, 0xF, false))
         : ctrl_sel == 2 ? __int_as_float(__builtin_amdgcn_update_dpp(__float_as_int(oldv), __float_as_int(src), 0x15F, 0xF, 0xF, false))
         :                 __int_as_float(__builtin_amdgcn_update_dpp(__float_as_int(oldv), __float_as_int(src), 0x15E, 0xF, 0xF, false));
}
struct EpiConv {
    static constexpr bool PERM = true, AFTER_DRAIN = false;
    bf16_t* ACT; const float* cw; const float* cb; float* UH; PG8_LAS unsigned char* halo; int ff;
    __device__ __forceinline__ void operator()(const f32x4 (&acc)[2][2][4][2], const Unit& u, int wr, int wc, int fr, int fq) const {
        const int cin = wc * 32 + 8 * fq, j0 = u.pn * 128 + cin, ff2 = 2 * ff;
        PG8_LAS f32x4* hl = (PG8_LAS f32x4*)halo;
        if (fr >= 14) {
#pragma unroll
            for (int ai = 0; ai < 2; ++ai)
#pragma unroll
                for (int bj = 0; bj < 2; ++bj)
#pragma unroll
                    for (int n = 0; n < 2; ++n) hl[(((2 * ai + wr) * 2 + (fr - 14)) * 2 + bj) * 32 + (cin >> 2) + n] = acc[ai][bj][3][n];
            if (wr == 1) {
#pragma unroll
                for (int bj = 0; bj < 2; ++bj)
#pragma unroll
                    for (int n = 0; n < 2; ++n) *(f32x4*)(UH + (size_t)(u.pm * 4 + 2 + (fr - 14)) * ff2 + bj * ff + j0 + 4 * n) = acc[1][bj][3][n];
            }
        }
        if (wr == 0 && fr < 2) {
#pragma unroll
            for (int bj = 0; bj < 2; ++bj)
#pragma unroll
                for (int n = 0; n < 2; ++n) *(f32x4*)(UH + (size_t)(u.pm * 4 + fr) * ff2 + bj * ff + j0 + 4 * n) = acc[0][bj][0][n];
        }
        f32x4 wA[3][2], wV[3][2], bA[2], bV[2];
#pragma unroll
        for (int n = 0; n < 2; ++n) {
#pragma unroll
            for (int tp = 0; tp < 3; ++tp) { wA[tp][n] = *(const f32x4*)(cw + (size_t)tp * ff2 + j0 + 4 * n); wV[tp][n] = *(const f32x4*)(cw + (size_t)tp * ff2 + ff + j0 + 4 * n); }
            bA[n] = *(const f32x4*)(cb + j0 + 4 * n); bV[n] = *(const f32x4*)(cb + ff + j0 + 4 * n); }
        asm volatile("s_waitcnt lgkmcnt(0)" ::: "memory"); __builtin_amdgcn_s_barrier(); asm volatile("" ::: "memory");
#pragma unroll
        for (int ai = 0; ai < 2; ++ai) {
            const int g = 2 * ai + wr;
#pragma unroll
            for (int m = 0; m < 4; ++m) {
                const int row = u.pm * BM + ai * HALF + wr * 64 + m * 16 + fr;
                f32x4 y[2][2];
#pragma unroll
                for (int bj = 0; bj < 2; ++bj)
#pragma unroll
                    for (int n = 0; n < 2; ++n) {
                        const f32x4 cur = acc[ai][bj][m][n]; f32x4 p62, p63;
                        if (m == 0) {
                            if (g == 0) { p62 = (f32x4){0.f, 0.f, 0.f, 0.f}; p63 = p62; }
                            else { p62 = hl[(((g - 1) * 2 + 0) * 2 + bj) * 32 + (cin >> 2) + n]; p63 = hl[(((g - 1) * 2 + 1) * 2 + bj) * 32 + (cin >> 2) + n]; }
                        } else {
#pragma unroll
                            for (int e = 0; e < 4; ++e) { p63[e] = dpp_f(0.f, acc[ai][bj][m - 1][n][e], 2); p62[e] = dpp_f(0.f, acc[ai][bj][m - 1][n][e], 3); }
                        }
                        const f32x4 w0 = bj ? wV[0][n] : wA[0][n], w1 = bj ? wV[1][n] : wA[1][n], w2 = bj ? wV[2][n] : wA[2][n], bb = bj ? bV[n] : bA[n];
                        f32x4 o;
#pragma unroll
                        for (int e = 0; e < 4; ++e) { const float xx = dpp_f(p62[e], p63[e], 0);
                            const float pr1 = dpp_f(p63[e], cur[e], 0), pr2 = dpp_f(xx, cur[e], 1);
                            o[e] = bb[e] + w0[e] * pr2 + w1[e] * pr1 + w2[e] * cur[e]; }
                        y[bj][n] = o;
                    }
                u32x4 w;
                { const f32x4 a0 = y[0][0], a1 = y[0][1], v0 = y[1][0], v1 = y[1][1];
                  w.x = cvt_pk_bf16(silu_f(a0[0]) * v0[0], silu_f(a0[1]) * v0[1]); w.y = cvt_pk_bf16(silu_f(a0[2]) * v0[2], silu_f(a0[3]) * v0[3]);
                  w.z = cvt_pk_bf16(silu_f(a1[0]) * v1[0], silu_f(a1[1]) * v1[1]); w.w = cvt_pk_bf16(silu_f(a1[2]) * v1[2], silu_f(a1[3]) * v1[3]); }
                const bool skip = (g == 0) && (m == 0) && (fr < 2) && (u.pm > 0);
                if (!skip) *(u32x4*)(ACT + (size_t)row * ff + j0) = w;
            }
        }
    }
};

template <class Epi, class Sched, bool ALIGN_EPI = false, bool SP2 = false>
__device__ __forceinline__ void gemm_phase(PG8_LAS unsigned char* lds, const Gemm g, const Sched& S, const Epi& E, int wid) {
    const int lane = lane_id(), tid = wid * 64 + lane, wr = wid >> 2, wc = wid & 3, fr = lane & 15, fq = lane >> 4;
    const int K = g.K, nt = K / BK;
    unsigned voffA[2], voffB[2];
#pragma unroll
    for (int i = 0; i < 2; ++i) { int R, C; stage_rc(tid * 16 + i * 8192, R, C); const int Rb = Epi::PERM ? ((R & ~31) + perm32(R & 31)) : R;
        voffA[i] = (unsigned)(R * K + C) * 2u; voffB[i] = (unsigned)(Rb * K + C) * 2u; }
    const size_t kstep = (size_t)(BK * 2);
    const size_t hstep = (size_t)HALF * K * 2;
    const size_t tstep = 2 * hstep;
    const unsigned ldsw = (unsigned)wid * 1024u;
    const int aoff = lds_byte(wr * 64 + fr, fq * 8), boff = lds_byte(wc * 32 + fr, fq * 8);
#define PG8_SA(b, h) (((b) * 2 + (h)) * HTB)
#define PG8_SB(b, h) ((4 + (b) * 2 + (h)) * HTB)
#define PG8_STAGE(bufoff, gbase, voff) do { _Pragma("unroll") for (int _i = 0; _i < 2; ++_i) \
        __builtin_amdgcn_global_load_lds((const unsigned*)((const char*)(gbase) + (voff)[_i]), (PG8_LAS unsigned*)(lds + (bufoff) + ldsw + _i * 8192), 16, 0, 0); } while (0)
#define PG8_LDA(dst, b, h) do { _Pragma("unroll") for (int m = 0; m < 4; ++m) _Pragma("unroll") for (int k = 0; k < 2; ++k) dst[m][k] = *(const PG8_LAS bf16x8*)(lds + PG8_SA(b, h) + aoff + m * 2048 + k * 1024); } while (0)
#define PG8_LDB(dst, b, h) do { _Pragma("unroll") for (int n = 0; n < 2; ++n) _Pragma("unroll") for (int k = 0; k < 2; ++k) dst[n][k] = *(const PG8_LAS bf16x8*)(lds + PG8_SB(b, h) + boff + n * 2048 + k * 1024); } while (0)
#define PG8_MMA(ai, bj, At, Bt) do { __builtin_amdgcn_s_setprio(1); _Pragma("unroll") for (int m = 0; m < 4; ++m) _Pragma("unroll") for (int n = 0; n < 2; ++n) _Pragma("unroll") for (int k = 0; k < 2; ++k) \
        acc[ai][bj][m][n] = __builtin_amdgcn_mfma_f32_16x16x32_bf16(Bt[n][k], At[m][k], acc[ai][bj][m][n], 0, 0, 0); __builtin_amdgcn_s_setprio(0); } while (0)
#define PG8_WAIT_V(n) asm volatile("s_waitcnt vmcnt(" #n ")" ::: "memory")
#define PG8_WAIT_L(n) asm volatile("s_waitcnt lgkmcnt(" #n ")" ::: "memory")
#define PG8_BAR __builtin_amdgcn_s_barrier()
#define PG8_SCHED __builtin_amdgcn_sched_barrier(0)
    Unit cur, nxt; int ui = 0;
    if (!S.next(0, cur)) return;
    f32x4 acc[2][2][4][2];
#pragma unroll
    for (int a = 0; a < 2; ++a)
#pragma unroll
        for (int b = 0; b < 2; ++b)
#pragma unroll
            for (int m = 0; m < 4; ++m)
#pragma unroll
                for (int n = 0; n < 2; ++n) acc[a][b][m][n] = (f32x4){0.f, 0.f, 0.f, 0.f};
    bf16x8 At[4][2], B0[2][2], B1[2][2];
    const char* cA = (const char*)g.A + (size_t)cur.pm * tstep; const char* cB = (const char*)g.Bt + (size_t)cur.pn * tstep;
    S.a_ready(cur);
    if constexpr (SP2) {
        PG8_STAGE(PG8_SB(0, 0), cB, voffB); PG8_STAGE(PG8_SB(0, 1), cB + hstep, voffB); PG8_STAGE(PG8_SA(0, 0), cA, voffA); PG8_STAGE(PG8_SA(0, 1), cA + hstep, voffA);
        if (wr == 1) PG8_BAR;
        PG8_WAIT_V(2); PG8_BAR;
        PG8_STAGE(PG8_SB(1, 0), cB + kstep, voffB); PG8_STAGE(PG8_SA(1, 0), cA + kstep, voffA); PG8_STAGE(PG8_SB(1, 1), cB + hstep + kstep, voffB);
        PG8_WAIT_V(6); PG8_BAR;
    } else {
        PG8_STAGE(PG8_SB(0, 0), cB, voffB); PG8_STAGE(PG8_SA(0, 0), cA, voffA); PG8_STAGE(PG8_SB(0, 1), cB + hstep, voffB); PG8_STAGE(PG8_SA(0, 1), cA + hstep, voffA);
        if (wr == 1) PG8_BAR;
        PG8_WAIT_V(4); PG8_BAR;
        PG8_STAGE(PG8_SB(1, 0), cB + kstep, voffB); PG8_STAGE(PG8_SA(1, 0), cA + kstep, voffA); PG8_STAGE(PG8_SB(1, 1), cB + hstep + kstep, voffB);
        PG8_WAIT_V(6); PG8_BAR;
    }
    for (;;) {
        const bool has_next = S.next(ui + 1, nxt);
        const char* nA = has_next ? (const char*)g.A + (size_t)nxt.pm * tstep : cA; const char* nB = has_next ? (const char*)g.Bt + (size_t)nxt.pn * tstep : cB;
        for (int t = 0; t < nt; t += 2) {
            const bool last = (t == nt - 2);
            const char* a1 = cA + (size_t)(t + 1) * kstep;
            const char* a2 = last ? nA : cA + (size_t)(t + 2) * kstep; const char* b2 = last ? nB : cB + (size_t)(t + 2) * kstep;
            const char* a3 = a2 + kstep; const char* b3 = b2 + kstep;
            if (last && has_next) S.a_ready(nxt);
            if constexpr (SP2) {
            PG8_LDB(B0, 0, 0); PG8_LDB(B1, 0, 1); PG8_SCHED; PG8_LDA(At, 0, 0); PG8_STAGE(PG8_SA(1, 1), a1 + hstep, voffA);
            PG8_WAIT_V(8); PG8_WAIT_L(0); PG8_BAR; PG8_MMA(0, 0, At, B0); PG8_MMA(0, 1, At, B1); PG8_BAR; PG8_SCHED;
            PG8_LDA(At, 0, 1); PG8_STAGE(PG8_SB(0, 0), b2, voffB); PG8_STAGE(PG8_SB(0, 1), b2 + hstep, voffB); PG8_STAGE(PG8_SA(0, 0), a2, voffA);
            PG8_WAIT_V(8); PG8_WAIT_L(0); PG8_BAR; PG8_MMA(1, 0, At, B0); PG8_MMA(1, 1, At, B1); PG8_BAR; PG8_SCHED;
            PG8_LDB(B0, 1, 0); PG8_LDB(B1, 1, 1); PG8_SCHED; PG8_LDA(At, 1, 0); PG8_STAGE(PG8_SA(0, 1), a2 + hstep, voffA);
            PG8_WAIT_V(8); PG8_WAIT_L(0); PG8_BAR; PG8_MMA(0, 0, At, B0); PG8_MMA(0, 1, At, B1); PG8_BAR; PG8_SCHED;
            PG8_LDA(At, 1, 1); PG8_STAGE(PG8_SB(1, 0), b3, voffB); PG8_STAGE(PG8_SB(1, 1), b3 + hstep, voffB); PG8_STAGE(PG8_SA(1, 0), a3, voffA);
            PG8_WAIT_V(8); PG8_WAIT_L(0); PG8_BAR; PG8_MMA(1, 0, At, B0); PG8_MMA(1, 1, At, B1); PG8_BAR; PG8_SCHED;
            } else {
            PG8_LDB(B0, 0, 0); PG8_SCHED; PG8_LDA(At, 0, 0); PG8_STAGE(PG8_SA(1, 1), a1 + hstep, voffA);
            PG8_WAIT_L(8); PG8_BAR; PG8_WAIT_L(0); PG8_MMA(0, 0, At, B0); PG8_BAR; PG8_SCHED;
            PG8_LDB(B1, 0, 1); PG8_STAGE(PG8_SB(0, 0), b2, voffB);
            PG8_BAR; PG8_WAIT_L(0); PG8_MMA(0, 1, At, B1); PG8_BAR;
            PG8_LDA(At, 0, 1); PG8_STAGE(PG8_SA(0, 0), a2, voffA);
            PG8_BAR; PG8_WAIT_L(0); PG8_MMA(1, 0, At, B0); PG8_BAR; PG8_SCHED;
            PG8_STAGE(PG8_SB(0, 1), b2 + hstep, voffB);
            PG8_WAIT_V(6); PG8_BAR; PG8_MMA(1, 1, At, B1); PG8_BAR;
            PG8_LDB(B0, 1, 0); PG8_SCHED; PG8_LDA(At, 1, 0); PG8_STAGE(PG8_SA(0, 1), a2 + hstep, voffA);
            PG8_WAIT_L(8); PG8_BAR; PG8_WAIT_L(0); PG8_MMA(0, 0, At, B0); PG8_BAR; PG8_SCHED;
            PG8_LDB(B1, 1, 1); PG8_STAGE(PG8_SB(1, 0), b3, voffB);
            PG8_BAR; PG8_WAIT_L(0); PG8_MMA(0, 1, At, B1); PG8_BAR;
            PG8_LDA(At, 1, 1); PG8_STAGE(PG8_SA(1, 0), a3, voffA);
            PG8_BAR; PG8_WAIT_L(0); PG8_MMA(1, 0, At, B0); PG8_BAR; PG8_SCHED;
            PG8_STAGE(PG8_SB(1, 1), b3 + hstep, voffB);
            PG8_WAIT_V(6); PG8_BAR; PG8_MMA(1, 1, At, B1); PG8_BAR;
            }
        }
        if constexpr (ALIGN_EPI) { if (wr == 0) PG8_BAR; }
        if constexpr (!Epi::AFTER_DRAIN) { E(acc, cur, wr, wc, fr, fq); S.done(cur); }
        if (!has_next) break;
#pragma unroll
        for (int a = 0; a < 2; ++a)
#pragma unroll
            for (int b = 0; b < 2; ++b)
#pragma unroll
                for (int m = 0; m < 4; ++m)
#pragma unroll
                    for (int n = 0; n < 2; ++n) acc[a][b][m][n] = (f32x4){0.f, 0.f, 0.f, 0.f};
        cur = nxt; cA = nA; cB = nB; ++ui;
        if constexpr (ALIGN_EPI) { if (wr == 1) PG8_BAR; }
    }
    PG8_WAIT_V(0);
    if constexpr (!ALIGN_EPI) { if (wr == 0) PG8_BAR; }
    PG8_BAR;
    if constexpr (Epi::AFTER_DRAIN) { E.fused(acc, cur, wr, wc, fr, fq, lds, wid, lane); S.done(cur); }
#undef PG8_SA
#undef PG8_SB
#undef PG8_STAGE
#undef PG8_LDA
#undef PG8_LDB
#undef PG8_MMA
#undef PG8_WAIT_V
#undef PG8_WAIT_L
#undef PG8_BAR
#undef PG8_SCHED
}
}


#define GAS __attribute__((address_space(1)))
#define LAS __attribute__((address_space(3)))
typedef unsigned short bf16;
typedef unsigned v4u __attribute__((ext_vector_type(4)));
typedef float f32x4 __attribute__((ext_vector_type(4)));
typedef short bf16x8 __attribute__((ext_vector_type(8)));
typedef GAS unsigned gu32;
typedef GAS unsigned long long gu64;
#define RLX_AGENT __ATOMIC_RELAXED, __HIP_MEMORY_SCOPE_AGENT
#define LDS_WAIT() asm volatile("s_waitcnt lgkmcnt(0)" ::: "memory")
#define VM_WAIT() asm volatile("s_waitcnt vmcnt(0)" ::: "memory")
__device__ __forceinline__ unsigned long long rt() { return __builtin_amdgcn_s_memrealtime(); }
__device__ __forceinline__ unsigned f2bf(float f) { unsigned u = __builtin_bit_cast(unsigned, f); return (u + 0x7fffu + ((u >> 16) & 1u)) >> 16; }
__device__ __forceinline__ unsigned pk2(float lo, float hi) { return f2bf(lo) | (f2bf(hi) << 16); }

#define XB_TMO      128
#define XB_XCNT(j)  (256  + 64 * (j))
#define XB_XSUB(j)  (1280 + 64 * (j))
#define XB_XGEN(j)  (2304 + 64 * (j))
#define XB_TOP      3328
#define XB_TOPGEN   3392
#define XCD_BAR_WORDS 3456
#define XB_SPIN_CAP (1u << 18)

__device__ __forceinline__ unsigned xb_ld(unsigned* p)              { return __hip_atomic_load(p, __ATOMIC_RELAXED, __HIP_MEMORY_SCOPE_AGENT); }
__device__ __forceinline__ unsigned xb_add(unsigned* p, unsigned v) { return __hip_atomic_fetch_add(p, v, __ATOMIC_RELAXED, __HIP_MEMORY_SCOPE_AGENT); }
__device__ __forceinline__ unsigned xb_xcc_id() { return (unsigned)__builtin_amdgcn_s_getreg((3 << 11) | 20) & 0xFu; }
#define XB_SPIN(cond, bar) do { unsigned _sp = 0; while (cond) { __builtin_amdgcn_s_sleep(1); \
    if ((++_sp & 255u) == 0u) { if (xb_ld(&(bar)[XB_TMO])) break; if (_sp > XB_SPIN_CAP) { atomicAdd(&(bar)[XB_TMO], 1u); break; } } } } while (0)

struct XcdBarrier {
    unsigned* bar; unsigned x;
    volatile LAS unsigned* st;
};

__device__ __forceinline__ XcdBarrier xcd_barrier_post(unsigned* bar, volatile LAS unsigned* st) {
    XcdBarrier b; b.bar = bar; b.x = xb_xcc_id(); b.st = st;
    if (threadIdx.x == 0) (void)xb_add(&bar[XB_XCNT(b.x)], 1u);
    return b;
}
__device__ __forceinline__ void xcd_barrier_complete(unsigned* bar, unsigned x, unsigned& nloc, unsigned& nx) {
    const unsigned G = gridDim.x * gridDim.y * gridDim.z;
    unsigned sum, cnt, mine, sp = 0u;
    for (;;) {
        sum = 0u; cnt = 0u; mine = 0u;
#pragma unroll
        for (unsigned j = 0; j < 16; ++j) { const unsigned c = xb_ld(&bar[XB_XCNT(j)]); sum += c; cnt += (c > 0u) ? 1u : 0u; mine = (j == x) ? c : mine; }
        if (sum == G) break;
        __builtin_amdgcn_s_sleep(1);
        if ((++sp & 255u) == 0u) { if (xb_ld(&bar[XB_TMO])) break; if (sp > XB_SPIN_CAP) { atomicAdd(&bar[XB_TMO], 1u); break; } }
    }
    nloc = mine > 0u ? mine : 1u; nx = cnt > 0u ? cnt : 1u;
}

__device__ __forceinline__ void xcd_barrier(const XcdBarrier& b) {
    asm volatile("s_waitcnt vmcnt(0)" ::: "memory");
    __syncthreads();
    if (threadIdx.x == 0) {
        unsigned* bar = b.bar;
        __builtin_amdgcn_s_waitcnt(0);
        unsigned nloc = b.st[0], nx = b.st[1];
        if (nloc == 0u) { xcd_barrier_complete(bar, b.x, nloc, nx); b.st[0] = nloc; b.st[1] = nx; }
        const unsigned old = xb_add(&bar[XB_XSUB(b.x)], 1u);
        const unsigned gen = old / nloc;
        if (old + 1u == (gen + 1u) * nloc) {
            __builtin_amdgcn_fence(__ATOMIC_RELEASE, "agent");
            asm volatile("s_waitcnt vmcnt(0)" ::: "memory");
            const unsigned og = xb_add(&bar[XB_TOP], 1u);
            const unsigned tg = og / nx;
            if (og + 1u == (tg + 1u) * nx) xb_add(&bar[XB_TOPGEN], 1u);
            else XB_SPIN(xb_ld(&bar[XB_TOPGEN]) == tg, bar);
            __builtin_amdgcn_fence(__ATOMIC_ACQUIRE, "agent");
            xb_add(&bar[XB_XGEN(b.x)], 1u);
            asm volatile("s_waitcnt vmcnt(0)" ::: "memory");
        } else {
            XB_SPIN(xb_ld(&bar[XB_XGEN(b.x)]) == gen, bar);
            __builtin_amdgcn_fence(__ATOMIC_ACQUIRE, "agent");
            asm volatile("s_waitcnt vmcnt(0)" ::: "memory");
        }
    }
    __syncthreads();
}


constexpr size_t MiB = 1u << 20;
constexpr size_t WS_CTL = 0, CTL_ZERO_BYTES = 32 * 1024;
constexpr size_t WS_PART = 1 * MiB;
constexpr size_t WS_MOD = 3 * MiB, WS_LB = 3 * MiB + 128 * 1024;
constexpr size_t WS_LF = 4 * MiB, WS_CL = 5 * MiB, WS_BB = 6 * MiB;
constexpr size_t WS_DBT = 6 * MiB + 65536;
constexpr size_t WS_NRM = 7 * MiB;
constexpr size_t WS_WF = 8 * MiB;
constexpr size_t WS_WIN = 16 * MiB, WS_WO = 128 * MiB, WS_WUP = 160 * MiB, WS_WD = 332 * MiB;
constexpr size_t WS_H = 418 * MiB;
constexpr size_t WS_PROJ = 482 * MiB;
constexpr size_t WS_MIX = 706 * MiB;
constexpr size_t WS_D1 = 770 * MiB, WS_D2 = 834 * MiB;
constexpr size_t WS_HU = 898 * MiB, WS_HS = 1026 * MiB, WS_HD = 1090 * MiB;
constexpr size_t WS_UH = 898 * MiB;
constexpr size_t WS_ACT = 482 * MiB;
constexpr size_t WS_OFOX = 1100 * MiB, WS_OHG = 1164 * MiB, WS_END = 1228 * MiB;
constexpr int CW_BAR = 4096;
constexpr int CW_WD = 128;
constexpr int KSPLIT = 16;

constexpr int RING_BYTES = 133120  , LDSCTL_OFF = RING_BYTES, MISC_OFF = LDSCTL_OFF + 320, HALO_OFF = RING_BYTES + 1024  , LDS_BYTES = 147456;

enum { PC_PRO = 0, PC_MODR = 1, PC_NORM1 = 2, PC_CUM = 3, PC_GEMM1 = 4, PC_HGA = 5, PC_HGB = 6, PC_HGC = 7, PC_ATTN = 8, PC_GEMM2 = 9, PC_NORM2 = 10, PC_GEMM3 = 11, PC_CONV = 12, PC_GEMM4 = 13, PC_FNORM = 14, PC_N = 15 };

struct Args { const float* in[17]; float* out; unsigned char* ws; unsigned mask; unsigned pad; };

__device__ __forceinline__ float wave_sum(float v) {
#pragma unroll
    for (int o = 1; o < 64; o <<= 1) v += __shfl_xor(v, o);
    return v;
}
__device__ __forceinline__ float sigm_f(float z) { return __builtin_amdgcn_rcpf(1.0f + __builtin_amdgcn_exp2f(-LOG2E * z)); }
__device__ __forceinline__ float silu2_f(float z) { return z * sigm_f(z); }

#ifndef WD_PRO_KB
#define WD_PRO_KB 0
#endif
constexpr int WD_PRO_ITEMS = WD_PRO_KB * (D / 64), WD_DEFER_ITEMS = (FF / 64) * (D / 64) - WD_PRO_ITEMS;
struct TrItem { const float* src; bf16* dst; int ldw, ldt; int nt; };
__device__ __forceinline__ void tr_load(const TrItem& it, f32x4 (&r)[16], int lane) {
    const int a4 = (lane & 15) * 4, kr = lane >> 4;
#pragma unroll
#ifdef TRLOAD_PLAIN
    for (int i = 0; i < 16; ++i) r[i] = *((const GAS f32x4*)(it.src + (size_t)(4 * i + kr) * it.ldw + a4));
#else
    for (int i = 0; i < 16; ++i) r[i] = __builtin_nontemporal_load((const GAS f32x4*)(it.src + (size_t)(4 * i + kr) * it.ldw + a4));
#endif
}
__device__ __forceinline__ void tr_store(const TrItem& it, const f32x4 (&r)[16], LAS float* scr, int lane) {
    const int a4 = (lane & 15) * 4, kr = lane >> 4;
#pragma unroll
    for (int i = 0; i < 16; ++i) { LAS float* d = scr + (4 * i + kr) * 65 + a4; d[0] = r[i].x; d[1] = r[i].y; d[2] = r[i].z; d[3] = r[i].w; }
    LDS_WAIT(); asm volatile("" ::: "memory");
    const int c = lane & 7;
#pragma unroll
    for (int j = 0; j < 8; ++j) { const int n = (lane >> 3) + 8 * j; const LAS float* s = scr + (8 * c) * 65 + n;
        v4u o; o.x = pk2(s[0 * 65], s[1 * 65]); o.y = pk2(s[2 * 65], s[3 * 65]); o.z = pk2(s[4 * 65], s[5 * 65]); o.w = pk2(s[6 * 65], s[7 * 65]);
        GAS v4u* dp = (GAS v4u*)(it.dst + (size_t)n * it.ldt + 8 * c); if (it.nt) __builtin_nontemporal_store(o, dp); else *dp = o; }
    LDS_WAIT(); asm volatile("" ::: "memory");
}
__device__ __forceinline__ TrItem tr_mk(const float* W, int ldw, int c0, int k0, bf16* WT, int ldt, int drow0, int nt = 0) { TrItem t; t.src = W + (size_t)k0 * ldw + c0; t.dst = WT + (size_t)drow0 * ldt + k0; t.ldw = ldw; t.ldt = ldt; t.nt = nt; return t; }
__device__ __forceinline__ void tr_item(const float* W, int ldw, int c0, int k0, bf16* WT, int ldt, int drow0, LAS float* scr, int lane) {
    const TrItem t = tr_mk(W, ldw, c0, k0, WT, ldt, drow0); f32x4 r[16]; tr_load(t, r, lane); tr_store(t, r, scr, lane);
}
template <int PARTS>
__device__ __forceinline__ void ph_prologue(const Args* ka, LAS unsigned char* lds, int vcu, int G, int tid, int lane, int wave) {
    unsigned char* ws = ka->ws;
    const float* c = ka->in[1]; const float* w_ada = ka->in[2]; const float* w_in = ka->in[5]; const float* lbl = ka->in[7];
    const float* w_out = ka->in[10]; const float* w_up = ka->in[12]; const float* w_down = ka->in[15];
    LAS float* sc_ = (LAS float*)lds;
    for (int i = tid; i < D; i += 512) sc_[i] = silu2_f(c[i]);
    __syncthreads();
    float* part = (float*)(ws + WS_PART);
    constexpr int NCG = NMOD / 4, KROWS = D / KSPLIT, CG0 = (PARTS & 1) ? 0 : 2 * D / 4, CG1 = (PARTS & 2) ? NCG : 2 * D / 4, NCGP = CG1 - CG0;
    for (int it = vcu * 512 + tid; it < KSPLIT * NCGP; it += G * 512) {
        const int ks = it / NCGP, cg = CG0 + it % NCGP;
        const GAS f32x4* wp = (const GAS f32x4*)(w_ada + (size_t)(ks * KROWS) * NMOD) + cg;
        f32x4 acc = {0.f, 0.f, 0.f, 0.f};
#pragma unroll 8
        for (int k = 0; k < KROWS; ++k) { const f32x4 w = __builtin_nontemporal_load(wp + (size_t)k * NCG); acc += w * sc_[ks * KROWS + k]; }
        ((GAS f32x4*)(part + (size_t)ks * NMOD))[cg] = acc;
    }
    if constexpr (PARTS & 1) {
    float* lb = (float*)(ws + WS_LB);
    for (int i = vcu * 512 + tid; i < 2048; i += G * 512) lb[i] = 1.0f / (1.0f + __expf(-(lbl[i] - lbl[2048 + i])));
    bf16* WfT = (bf16*)(ws + WS_WF);
    for (int i = vcu * 512 + tid; i < 16 * D; i += G * 512) { const int k = i >> 4, n = i & 15; WfT[(size_t)n * D + k] = (bf16)f2bf(w_in[(size_t)k * INC + FOX_F0 + n]); }
    }
    __syncthreads();
    LAS float* scr = (LAS float*)(lds + wave * 16640);
    const int gw = vcu * 8 + wave, NGW = G * 8;
    constexpr int NB_A = FOX_F0 / 64, NB_B = (NPROJ - FOX_F0) / 64, NB_C = D / 64, NB_D = FF2 / 64, NB_E = D / 64;
    constexpr int I_A = 64 * NB_A, I_B = 64 * NB_B, I_C = 64 * NB_C, I_D = 64 * NB_D, I_E = WD_PRO_ITEMS  , NITEMS = I_A + I_B + I_C + I_D + I_E;
    bf16* WinT = (bf16*)(ws + WS_WIN); bf16* WoT = (bf16*)(ws + WS_WO); bf16* WupT = (bf16*)(ws + WS_WUP); bf16* WdT = (bf16*)(ws + WS_WD);
    auto decode = [&](int it) -> TrItem { int r = it;
        if (r < I_A) { const int kb = 8 * ((r >> 3) / NB_A) + (r & 7), nb = (r >> 3) % NB_A; return tr_mk(w_in, INC, 64 * nb, 64 * kb, WinT, D, 64 * nb); } r -= I_A;
        if (r < I_B) { const int kb = 8 * ((r >> 3) / NB_B) + (r & 7), nb = (r >> 3) % NB_B; return tr_mk(w_in, INC, HG_Q0 + 64 * nb, 64 * kb, WinT, D, FOX_F0 + 64 * nb); } r -= I_B;
        if (r < I_C) { const int kb = 8 * ((r >> 3) / NB_C) + (r & 7), nb = (r >> 3) % NB_C; return tr_mk(w_out, D, 64 * nb, 64 * kb, WoT, D, 64 * nb, 1); } r -= I_C;
        if (r < I_D) { const int kb = 8 * ((r >> 3) / NB_D) + (r & 7), nb = (r >> 3) % NB_D; const int c0 = 64 * nb, cc = c0 < FF ? c0 : c0 - FF; return tr_mk(w_up, FF2, c0, 64 * kb, WupT, D, 256 * (cc >> 7) + (c0 < FF ? 0 : 128) + (cc & 127), 1); } r -= I_D;
        { const int kb = r / NB_E, nb = r % NB_E; return tr_mk(w_down, D, 64 * nb, 64 * kb, WdT, FF, 64 * nb); } };
    f32x4 ra[16], rb[16];
    constexpr int IT0 = (PARTS & 1) ? 0 : I_A + I_B, IT1 = (PARTS & 2) ? NITEMS : I_A + I_B;
    static_assert(I_E == 0, "the w_down items sit behind the deferred ones");
    int it = IT0 + gw;
    if (it < IT1) { TrItem ta = decode(it); tr_load(ta, ra, lane);
        for (;;) {
            const int itb = it + NGW; const bool hb = itb < IT1; TrItem tb = ta; if (hb) { tb = decode(itb); tr_load(tb, rb, lane); }
            tr_store(ta, ra, scr, lane);
            if (!hb) break;
            const int itc = itb + NGW; const bool hc = itc < IT1; if (hc) { ta = decode(itc); tr_load(ta, ra, lane); }
            tr_store(tb, rb, scr, lane);
            if (!hc) break;
            it = itc;
        }
    }
}
__device__ __forceinline__ void ph_convert_wd(const Args* ka, LAS unsigned char* lds, int rank, int nrank, int wave) {
    const int lane = lane_id(); const float* w_down = ka->in[15]; bf16* WdT = (bf16*)(ka->ws + WS_WD);
    LAS float* scr = (LAS float*)(lds + wave * 16640);
    for (int r0 = rank * 8 + wave; r0 < WD_DEFER_ITEMS; r0 += nrank * 8) { const int r = r0 + WD_PRO_ITEMS, kb = r / (D / 64), nb = r % (D / 64); tr_item(w_down, D, 64 * nb, 64 * kb, WdT, FF, 64 * nb, scr, lane); }
}
__device__ __forceinline__ void ph_convert_wd_dyn(const Args* ka, LAS unsigned char* lds, int wave) {
    const int lane = lane_id(); const float* w_down = ka->in[15]; bf16* WdT = (bf16*)(ka->ws + WS_WD);
    unsigned* ctr = (unsigned*)(ka->ws + WS_CTL) + CW_WD;
    LAS float* scr = (LAS float*)(lds + wave * 16640);
#ifndef WD_CHUNK
#define WD_CHUNK 8
#endif
    int cur = 0, end = 0;
    auto next = [&]() -> int { if (cur == end) { unsigned v = 0u; if (lane == 0) v = xb_add(ctr, 1u); cur = (int)__builtin_amdgcn_readfirstlane(v) * WD_CHUNK; end = cur + WD_CHUNK; } return cur++; };
    auto mk = [&](int r0) -> TrItem { const int r = r0 + WD_PRO_ITEMS, kb = r / (D / 64), nb = r % (D / 64); return tr_mk(w_down, D, 64 * nb, 64 * kb, WdT, FF, 64 * nb); };
    static_assert(WD_DEFER_ITEMS % WD_CHUNK == 0, "whole chunks");
    f32x4 ra[16], rb[16];
    const int ia = next();
    if (ia >= WD_DEFER_ITEMS) return;
    TrItem ta = mk(ia); tr_load(ta, ra, lane);
    for (;;) {
        const int ib = next(); const bool hb = ib < WD_DEFER_ITEMS; TrItem tb = ta; if (hb) { tb = mk(ib); tr_load(tb, rb, lane); }
        tr_store(ta, ra, scr, lane);
        if (!hb) break;
        const int ic = next(); const bool hc = ic < WD_DEFER_ITEMS; if (hc) { ta = mk(ic); tr_load(ta, ra, lane); }
        tr_store(tb, rb, scr, lane);
        if (!hc) break;
    }
}
__device__ __forceinline__ void ph_modreduce(const Args* ka, int i0, int vcu, int G, int tid) {
    const float* part = (const float*)(ka->ws + WS_PART); const float* b = ka->in[3]; float* mod = (float*)(ka->ws + WS_MOD);
    for (int i = i0 + vcu * 512 + tid; i < NMOD; i += G * 512) { float s = b[i];
#pragma unroll
        for (int ks = 0; ks < KSPLIT; ++ks) s += part[(size_t)ks * NMOD + i];
        mod[i] = s; }
}
template <bool FGATE>
__device__ __forceinline__ void ph_norm(const float* x, const bf16* d1, const float* g, const float* sh, const float* sc, bf16* H, const bf16* WfT, const float* bfox, float* lf, float* modout, int modn,
                                        LAS unsigned char* lds, int vcu, int G, int tid, int lane, int wave) {
    LAS float* A_ = (LAS float*)lds; LAS float* B_ = A_ + D;
    if constexpr (FGATE) {
        const float* part = sh; const float* bada = sc;
#ifndef RED_REP
#define RED_REP 1
#endif
#ifndef FG_REP
#define FG_REP 1
#endif
        for (int rr_ = 0; rr_ < RED_REP; ++rr_)
        for (int i4 = tid; i4 < D / 4; i4 += 512) { f32x4 s0 = *(const GAS f32x4*)(bada + 4 * i4), s1 = *(const GAS f32x4*)(bada + D + 4 * i4);
#pragma unroll
            for (int ks = 0; ks < KSPLIT; ++ks) { s0 += *(const GAS f32x4*)(part + (size_t)ks * NMOD + 4 * i4); s1 += *(const GAS f32x4*)(part + (size_t)ks * NMOD + D + 4 * i4); }
            const f32x4 gv = *(const GAS f32x4*)(g + 4 * i4);
            *(LAS f32x4*)(A_ + 4 * i4) = gv * (s1 + 1.0f); *(LAS f32x4*)(B_ + 4 * i4) = s0; }
        const int nred = modn, per = (nred + G - 1) / G, iend = (vcu + 1) * per < nred ? (vcu + 1) * per : nred;
        for (int i = vcu * per + tid; i < iend; i += 512) { float s = bada[i];
#pragma unroll
            for (int ks = 0; ks < KSPLIT; ++ks) s += part[(size_t)ks * NMOD + i];
            modout[i] = s; }
    } else {
        for (int i = tid; i < D; i += 512) { A_[i] = g[i] * (1.0f + sc[i]); B_[i] = sh[i]; }
    }
    __syncthreads();
    for (int blk = vcu; blk < T / 32; blk += G) {
        const int row0 = blk * 32;
#pragma unroll 1
        for (int j = 0; j < 4; ++j) {
            const int row = row0 + wave * 4 + j;
            const GAS f32x4* xr = (const GAS f32x4*)(x + (size_t)row * D) + lane;
            f32x4 v[16]; float s = 0.f;
#pragma unroll
            for (int jj = 0; jj < 16; ++jj) { v[jj] = __builtin_nontemporal_load(xr + 64 * jj);
                if constexpr (!FGATE) { const unsigned long long dw = ((const GAS unsigned long long*)(d1 + (size_t)row * D) + lane)[64 * jj]; const unsigned w0 = (unsigned)dw, w1 = (unsigned)(dw >> 32);
                    v[jj].x += __uint_as_float(w0 << 16); v[jj].y += __uint_as_float(w0 & 0xffff0000u); v[jj].z += __uint_as_float(w1 << 16); v[jj].w += __uint_as_float(w1 & 0xffff0000u); }
                s += (v[jj].x * v[jj].x + v[jj].y * v[jj].y) + (v[jj].z * v[jj].z + v[jj].w * v[jj].w); }
            const float r = 1.0f / sqrtf(wave_sum(s) * (1.0f / D) + EPS);
            GAS unsigned long long* o8 = (GAS unsigned long long*)(H + (size_t)row * D) + lane;
#pragma unroll
            for (int jj = 0; jj < 16; ++jj) { const f32x4 av = *(const LAS f32x4*)(A_ + 4 * (lane + 64 * jj)), bv = *(const LAS f32x4*)(B_ + 4 * (lane + 64 * jj));
                const f32x4 hv = v[jj] * r * av + bv;
                o8[64 * jj] = (unsigned long long)pk2(hv.x, hv.y) | ((unsigned long long)pk2(hv.z, hv.w) << 32); }
        }
        if constexpr (FGATE) for (int fr_ = 0; fr_ < FG_REP; ++fr_) {
            __syncthreads();
            const int g_ = wave >> 2, kq = wave & 3; f32x4 acc = {0.f, 0.f, 0.f, 0.f};
            const bf16* ap = H + (size_t)(row0 + 16 * g_ + (lane & 15)) * D + kq * 1024 + (lane >> 4) * 8;
            const bf16* bp = WfT + (size_t)(lane & 15) * D + kq * 1024 + (lane >> 4) * 8;
#pragma unroll 16
            for (int s = 0; s < 32; ++s) { const bf16x8 av = *(const GAS bf16x8*)(ap + 32 * s), bv = *(const GAS bf16x8*)(bp + 32 * s); acc = __builtin_amdgcn_mfma_f32_16x16x32_bf16(av, bv, acc, 0, 0, 0); }
            LAS f32x4* red = (LAS f32x4*)(lds + 32768);
            red[wave * 64 + lane] = acc;
            __syncthreads();
            if (kq == 0) { const f32x4 t = (red[(g_ * 4 + 0) * 64 + lane] + red[(g_ * 4 + 1) * 64 + lane]) + (red[(g_ * 4 + 2) * 64 + lane] + red[(g_ * 4 + 3) * 64 + lane]);
                const int head = lane & 15; const float bias = bfox[head];
#pragma unroll
                for (int e = 0; e < 4; ++e) { const float z = t[e] + bias; lf[(size_t)head * T + row0 + 16 * g_ + (lane >> 4) * 4 + e] = fminf(z, 0.f) - log1pf(__expf(-fabsf(z))); } }
            __syncthreads();
        }
    }
}
__device__ __forceinline__ void ph_cum(const Args* ka, LAS unsigned char* lds, int vcu, int tid, int lane) {
    if (vcu >= NH) return;
    const int h = vcu; const float* lf = (const float*)(ka->ws + WS_LF) + (size_t)h * T + tid * 16; float* cl = (float*)(ka->ws + WS_CL) + (size_t)h * T + tid * 16;
    double* Bb = (double*)(ka->ws + WS_BB) + h * 32;
    float v[16];
#pragma unroll
    for (int q = 0; q < 4; ++q) { const f32x4 t = ((const GAS f32x4*)lf)[q]; v[4 * q] = t.x; v[4 * q + 1] = t.y; v[4 * q + 2] = t.z; v[4 * q + 3] = t.w; }
    float run = 0.f;
#pragma unroll
    for (int j = 0; j < 16; ++j) { run += v[j] * LOG2E; v[j] = run; }
    float s = run;
#pragma unroll
    for (int d = 1; d < 16; d <<= 1) { const float y = __shfl_up(s, d, 16); if ((lane & 15) >= d) s += y; }
    const float excl = s - run;
#pragma unroll
    for (int q = 0; q < 4; ++q) ((GAS f32x4*)cl)[q] = (f32x4){-(v[4 * q] + excl), -(v[4 * q + 1] + excl), -(v[4 * q + 2] + excl), -(v[4 * q + 3] + excl)};
    LAS double* bt = (LAS double*)lds;
    if ((lane & 15) == 15) bt[tid >> 4] = (double)s;
    __syncthreads();
    if (tid == 0) { double c = 0.0; for (int b = 0; b < 32; ++b) { Bb[b] = c; c += bt[b]; } }
    __syncthreads();
    if (tid < 32) { double c = 0.0; for (int b = 0; b < tid; ++b) c += bt[b]; bt[32 + tid] = c; }
    __syncthreads();
    { float* dBt = (float*)(ka->ws + WS_DBT) + h * 1024;
      for (int e = tid; e < 1024; e += 512) dBt[e] = (float)(bt[32 + (e >> 5)] - bt[32 + (e & 31)]); }
    __syncthreads();
}
__device__ __forceinline__ void ph_convfix(const Args* ka, int vcu, int G, int tid) {
    const float* UH = (const float*)(ka->ws + WS_UH); bf16* ACT = (bf16*)(ka->ws + WS_ACT); const float* cw = ka->in[13]; const float* cb = ka->in[14];
    constexpr int NCG = FF / 4, NIT = 31 * NCG;
    for (int it = vcu * 512 + tid; it < NIT; it += G * 512) {
        const int pm = 1 + it / NCG, j0 = (it % NCG) * 4;
        f32x4 act[2];
        f32x4 ua[4], uv[4];
#pragma unroll
        for (int q = 0; q < 4; ++q) { const size_t rowoff = (size_t)((q < 2 ? (pm - 1) * 4 + 2 + q : pm * 4 + (q - 2))) * FF2;
            ua[q] = *(const GAS f32x4*)(UH + rowoff + j0); uv[q] = *(const GAS f32x4*)(UH + rowoff + FF + j0); }
        f32x4 wa[3], wv[3];
#pragma unroll
        for (int tp = 0; tp < 3; ++tp) { wa[tp] = *(const GAS f32x4*)(cw + (size_t)tp * FF2 + j0); wv[tp] = *(const GAS f32x4*)(cw + (size_t)tp * FF2 + FF + j0); }
        const f32x4 ba = *(const GAS f32x4*)(cb + j0), bv = *(const GAS f32x4*)(cb + FF + j0);
#pragma unroll
        for (int rr = 0; rr < 2; ++rr) { const f32x4 ya = ba + wa[0] * ua[rr] + wa[1] * ua[rr + 1] + wa[2] * ua[rr + 2], yv = bv + wv[0] * uv[rr] + wv[1] * uv[rr + 1] + wv[2] * uv[rr + 2];
            act[rr] = (f32x4){silu2_f(ya.x) * yv.x, silu2_f(ya.y) * yv.y, silu2_f(ya.z) * yv.z, silu2_f(ya.w) * yv.w};
            *(GAS unsigned long long*)(ACT + (size_t)(pm * 256 + rr) * FF + j0) = (unsigned long long)pk2(act[rr].x, act[rr].y) | ((unsigned long long)pk2(act[rr].z, act[rr].w) << 32); }
    }
}
__device__ __forceinline__ void ph_fnorm(const float* x, const bf16* d1, const bf16* d2, float* out, const float* g, int vcu, int G, int lane, int wave) {
    const int gw = vcu * 8 + wave, NGW = G * 8;
    for (int row = gw; row < T; row += NGW) {
        const GAS f32x4* xr = (const GAS f32x4*)(x + (size_t)row * D) + lane;
        const GAS unsigned long long* p1 = (const GAS unsigned long long*)(d1 + (size_t)row * D) + lane; const GAS unsigned long long* p2 = (const GAS unsigned long long*)(d2 + (size_t)row * D) + lane;
        f32x4 v[16]; float s = 0.f;
#pragma unroll
        for (int jj = 0; jj < 16; ++jj) { v[jj] = __builtin_nontemporal_load(xr + 64 * jj); const unsigned long long a1 = __builtin_nontemporal_load(p1 + 64 * jj), a2 = __builtin_nontemporal_load(p2 + 64 * jj);
            const unsigned w0 = (unsigned)a1, w1 = (unsigned)(a1 >> 32), y0 = (unsigned)a2, y1 = (unsigned)(a2 >> 32);
            v[jj].x += __uint_as_float(w0 << 16) + __uint_as_float(y0 << 16); v[jj].y += __uint_as_float(w0 & 0xffff0000u) + __uint_as_float(y0 & 0xffff0000u);
            v[jj].z += __uint_as_float(w1 << 16) + __uint_as_float(y1 << 16); v[jj].w += __uint_as_float(w1 & 0xffff0000u) + __uint_as_float(y1 & 0xffff0000u);
            s += (v[jj].x * v[jj].x + v[jj].y * v[jj].y) + (v[jj].z * v[jj].z + v[jj].w * v[jj].w); }
        const float r = 1.0f / sqrtf(wave_sum(s) * (1.0f / D) + EPS);
        GAS f32x4* orow = (GAS f32x4*)(out + (size_t)row * D) + lane;
#pragma unroll
        for (int jj = 0; jj < 16; ++jj) { const f32x4 gv = *(const GAS f32x4*)(g + 4 * (lane + 64 * jj)); __builtin_nontemporal_store(v[jj] * r * gv, orow + 64 * jj); }
    }
}

namespace fa {
typedef short bf16x8 __attribute__((ext_vector_type(8)));
typedef short s16x4 __attribute__((ext_vector_type(4)));
typedef float f32x16 __attribute__((ext_vector_type(16)));
typedef float f32x4 __attribute__((ext_vector_type(4)));
typedef unsigned u32x4 __attribute__((ext_vector_type(4)));
constexpr int NW = 8, QBLK = 32, KVBLK = 64, QB = NW * QBLK, DH = 128;
constexpr int SHM_V = KVBLK * DH * 2, SHM_K = KVBLK * DH * 2;
constexpr int LDS_BYTES = 2 * SHM_V + 2 * SHM_K + NW * 64 * 4;
constexpr float THR2 = 11.5f;
#define KSWZ(row, colB) ((row) * 256 + ((colB) ^ (((row) & 7) << 4)))
#define SBAR() __builtin_amdgcn_sched_barrier(0)
__device__ __forceinline__ int v_st(int k, int c) { const int kk = (k & ~0xC) | ((k & 4) << 1) | ((k & 8) >> 1); return ((kk >> 3) * 4 + (c >> 5)) * 512 + ((kk & 7) * 32 + (c & 31)) * 2; }
__device__ __forceinline__ int v_rd_base(int lane) { return ((lane & 3) << 3) | (((lane >> 2) & 3) << 6) | (((lane >> 4) & 1) << 5) | (((lane >> 5) & 1) << 8); }
constexpr int v_rd_off(int d0, int ks, int half) { return d0 * 512 + ks * 4096 + half * 2048; }
__device__ __forceinline__ int crow(int r, int hi) { return (r & 3) + 8 * (r >> 2) + 4 * hi; }
__device__ __forceinline__ unsigned cvtpk(float lo, float hi) { unsigned r; asm volatile("v_cvt_pk_bf16_f32 %0, %1, %2" : "=v"(r) : "v"(lo), "v"(hi)); return r; }
template <int M> __device__ __forceinline__ float swz_xor(float v) { return __int_as_float(__builtin_amdgcn_ds_swizzle(__float_as_int(v), 0x1F | (M << 10))); }
__device__ __forceinline__ bf16x8 load8(const bf16* p) { return *reinterpret_cast<const bf16x8*>(p); }
__device__ __forceinline__ void mask_tile(f32x16& p0, f32x16& p1, int dq) {
    const float NEG = -__builtin_inff();
#pragma unroll
    for (int r = 0; r < 16; ++r) { const int c = (r & 3) + 8 * (r >> 2); if (dq - c < 0) p0[r] = NEG; if (dq - c - 32 < 0) p1[r] = NEG; }
}
__device__ __forceinline__ void partialSM(f32x16& p0, f32x16& p1, float& m_reg, float& mn, float& alpha, float dB) {
    float pmax = p0[0]; for (int r = 1; r < 16; ++r) pmax = fmaxf(pmax, p0[r]); for (int r = 0; r < 16; ++r) pmax = fmaxf(pmax, p1[r]);
    { auto rr = __builtin_amdgcn_permlane32_swap(__float_as_uint(pmax), __float_as_uint(pmax), false, false);
      pmax = fmaxf(__uint_as_float(rr[0]), __uint_as_float(rr[1])); }
    const float pm = pmax + dB;
    if (__builtin_expect(__all(pm - m_reg <= THR2), 1)) { mn = m_reg; alpha = 1.f; }
    else { mn = fmaxf(m_reg, pm); alpha = __builtin_amdgcn_exp2f(m_reg - mn); m_reg = mn; }
    const float sub = mn - dB;
    for (int r = 0; r < 16; ++r) p0[r] = p0[r] - sub; for (int r = 0; r < 16; ++r) p1[r] = p1[r] - sub;
    for (int r = 0; r < 16; ++r) p0[r] = __builtin_amdgcn_exp2f(p0[r]);
}
__device__ __forceinline__ void finishSM(f32x16& p0, f32x16& p1, float alpha, float& l_reg, bf16x8& pa0, bf16x8& pa1, bf16x8& pa2, bf16x8& pa3) {
    for (int r = 0; r < 16; ++r) p1[r] = __builtin_amdgcn_exp2f(p1[r]);
    float ps = 0; for (int r = 0; r < 16; ++r) ps += p0[r]; for (int r = 0; r < 16; ++r) ps += p1[r];
    { auto rr = __builtin_amdgcn_permlane32_swap(__float_as_uint(ps), __float_as_uint(ps), false, false);
      ps = __uint_as_float(rr[0]) + __uint_as_float(rr[1]); }
    l_reg = l_reg * alpha + ps;
#define PK4(P, B_, OUT) do { unsigned a0 = cvtpk(P[B_+0], P[B_+1]), a1 = cvtpk(P[B_+2], P[B_+3]);                          \
        unsigned b0 = cvtpk(P[B_+4], P[B_+5]), b1 = cvtpk(P[B_+6], P[B_+7]);                                             \
        auto r0 = __builtin_amdgcn_permlane32_swap(a0, b0, false, false); auto r1 = __builtin_amdgcn_permlane32_swap(a1, b1, false, false); \
        u32x4 w = {r0[0], r1[0], r0[1], r1[1]}; OUT = *reinterpret_cast<bf16x8*>(&w); } while (0)
    PK4(p0, 0, pa0); PK4(p0, 8, pa1); PK4(p1, 0, pa2); PK4(p1, 8, pa3);
#undef PK4
}
template <int KB>
__device__ __forceinline__ void qkt(f32x16& p0, f32x16& p1, const char* K_lds, int r32, int hi, const bf16x8* qr) {
    const char* kb[4];
#pragma unroll
    for (int dd = 0; dd < 4; ++dd) kb[dd] = K_lds + KB * SHM_K + KSWZ(r32, (dd * 16 + hi * 8) * 2);
#pragma unroll
    for (int d0 = 0; d0 < 8; ++d0) { const char* a = kb[d0 & 3] + (d0 >> 2) * 128;
        bf16x8 b0 = *reinterpret_cast<const bf16x8*>(a);
        bf16x8 b1 = *reinterpret_cast<const bf16x8*>(a + 32 * 256);
        p0 = __builtin_amdgcn_mfma_f32_32x32x16_bf16(b0, qr[d0], p0, 0, 0, 0);
        p1 = __builtin_amdgcn_mfma_f32_32x32x16_bf16(b1, qr[d0], p1, 0, 0, 0); }
}
template <int VB>
__device__ __forceinline__ void pv_tile(f32x16* o, int vb0, bf16x8 pa0, bf16x8 pa1, bf16x8 pa2, bf16x8 pa3) {
#define TRRD(dst, off) asm volatile("ds_read_b64_tr_b16 %0, %1 offset:%2" : "=&v"(dst) : "v"(vb0), "i"(off) : "memory")
#define PV_D0(d0) do { s16x4 l0, l1, l2, l3, h0, h1, h2, h3; constexpr int b_ = VB * SHM_V + v_rd_off(d0, 0, 0);   \
        TRRD(l0, b_); TRRD(h0, b_ + 2048); TRRD(l1, b_ + 4096); TRRD(h1, b_ + 6144); TRRD(l2, b_ + 8192); TRRD(h2, b_ + 10240); TRRD(l3, b_ + 12288); TRRD(h3, b_ + 14336); \
        asm volatile("s_waitcnt lgkmcnt(0)" ::: "memory"); SBAR();   \
        o[d0] = __builtin_amdgcn_mfma_f32_32x32x16_bf16(pa0, (bf16x8){l0[0], l0[1], l0[2], l0[3], h0[0], h0[1], h0[2], h0[3]}, o[d0], 0, 0, 0);   \
        o[d0] = __builtin_amdgcn_mfma_f32_32x32x16_bf16(pa1, (bf16x8){l1[0], l1[1], l1[2], l1[3], h1[0], h1[1], h1[2], h1[3]}, o[d0], 0, 0, 0);   \
        o[d0] = __builtin_amdgcn_mfma_f32_32x32x16_bf16(pa2, (bf16x8){l2[0], l2[1], l2[2], l2[3], h2[0], h2[1], h2[2], h2[3]}, o[d0], 0, 0, 0);   \
        o[d0] = __builtin_amdgcn_mfma_f32_32x32x16_bf16(pa3, (bf16x8){l3[0], l3[1], l3[2], l3[3], h3[0], h3[1], h3[2], h3[3]}, o[d0], 0, 0, 0); } while (0)
    PV_D0(0); PV_D0(1); PV_D0(2); PV_D0(3);
#undef PV_D0
#undef TRRD
}
typedef __amdgpu_buffer_rsrc_t rsrc_t;
__device__ __forceinline__ rsrc_t mk_rsrc(const void* p, unsigned bytes) { return __builtin_amdgcn_make_buffer_rsrc((void*)p, (short)0, (int)bytes, 0x00020000); }
__device__ __forceinline__ bf16x8 bload8(rsrc_t r, unsigned voff, unsigned soff) { const u32x4 w = __builtin_bit_cast(u32x4, __builtin_amdgcn_raw_buffer_load_b128(r, (int)voff, (int)soff, 0)); return __builtin_bit_cast(bf16x8, w); }
__device__ __forceinline__ f32x4 bloadf4(rsrc_t r, unsigned voff, unsigned soff) { return __builtin_bit_cast(f32x4, __builtin_amdgcn_raw_buffer_load_b128(r, (int)voff, (int)soff, 0)); }
struct AttnPtrs { rsrc_t rsP, rsN, rsG, rsM; const float* dBt; };
struct BlockRef { int h; int P0; int jlo; };
struct Seam { bf16x8 qr[8]; bf16x8 st_v0, st_v1, st_k0, st_k1; };
#define ROWS(typ, hh, k0, add) ((unsigned)((((typ) * NH + (hh)) * T + (k0) + (add)) * (DH * 2)))
#define VMW() asm volatile("s_waitcnt vmcnt(0)" ::: "memory")
#define VMWN(n) asm volatile("s_waitcnt vmcnt(%0)" :: "i"(n) : "memory")
#define SLOAD_H(hh, k0) do { S.st_v0 = bload8(P.rsP, stoff, ROWS(2, hh, k0, 0)); S.st_v1 = bload8(P.rsP, stoff, ROWS(2, hh, k0, 32));              \
                         S.st_k0 = bload8(P.rsP, stoff, ROWS(1, hh, k0, 0)); S.st_k1 = bload8(P.rsP, stoff, ROWS(1, hh, k0, 32)); } while (0)
#define SWRITE_HK(bf) do { *(bf16x8*)(K_lds + (bf) * SHM_K + kws) = S.st_k0; *(bf16x8*)(K_lds + (bf) * SHM_K + kws + 32 * 256) = S.st_k1; } while (0)
#define SWRITE_HV(bf) do { *(bf16x8*)(V_lds + (bf) * SHM_V + vst0) = S.st_v0; *(bf16x8*)(V_lds + (bf) * SHM_V + vst1) = S.st_v1; } while (0)
#define SWRITE_H(bf) do { SWRITE_HV(bf); SWRITE_HK(bf); } while (0)
__device__ __forceinline__ void fox_prime(const AttnPtrs& P, const BlockRef& cur, char* lds, Seam& S, int wid) {
    const int lane = lane_id(), tid = wid * 64 + lane, r32 = lane & 31, hi = lane >> 5;
    const unsigned stoff = (unsigned)(((tid >> 4) * DH + (tid & 15) * 8) * 2), qoff = (unsigned)((r32 * DH + hi * 8) * 2);
    const int sr = tid >> 4, sc = (tid & 15) * 8, kws = KSWZ(sr, sc * 2); char* K_lds = lds + 2 * SHM_V; (void)qoff;
    const int kb0 = cur.jlo * KVBLK;
    for (int d0 = 0; d0 < 8; ++d0) S.qr[d0] = bload8(P.rsP, qoff + d0 * 32, ROWS(0, cur.h, cur.P0 + wid * QBLK, 0));
    SLOAD_H(cur.h, kb0); VMW(); SWRITE_HK(0);
    __syncthreads();
}
__device__ __forceinline__ void fox_block(const AttnPtrs& P, const BlockRef& cur, const BlockRef& nxt, char* lds, Seam& S, int wid) {
    const int lane = lane_id(), tid = wid * 64 + lane, r32 = lane & 31, hi = lane >> 5;
    const unsigned stoff = (unsigned)(((tid >> 4) * DH + (tid & 15) * 8) * 2), qoff = (unsigned)((r32 * DH + hi * 8) * 2);
    const int j_lo = cur.jlo;
    const int j_hi = (cur.P0 + QB - 1) / KVBLK + 1;
    const int NT = j_hi - j_lo;
    const int kbn = nxt.jlo * KVBLK;
    const int qlo = cur.P0 + wid * QBLK, qm = qlo + r32 - 4 * hi;
    char* V_lds = lds; char* K_lds = lds + 2 * SHM_V;
    float* ws = (float*)(lds + 2 * SHM_V + 2 * SHM_K) + wid * 64; float* li_l = ws, * al_l = ws + 32;
    float m_reg = -1e30f, l_reg = 0; f32x16 o[4] = {};
    const int sr = tid >> 4, sc = (tid & 15) * 8, vst0 = v_st(sr, sc), vst1 = v_st(32 + sr, sc), kws = KSWZ(sr, sc * 2);
    const int vb0 = (int)(uintptr_t)V_lds + v_rd_base(lane);
    const float* dbrow = P.dBt + (cur.h * 32 + (cur.P0 >> 8)) * 32;
#define RESC(a) do { if (__any((a) < 1.f)) { if (hi == 0) al_l[r32] = (a); asm volatile("s_waitcnt lgkmcnt(0)" ::: "memory");              \
                     for (int d_ = 0; d_ < 4; ++d_) for (int r = 0; r < 16; ++r) o[d_][r] *= al_l[crow(r, hi)]; } } while (0)
#define KBASE(t) ((j_lo + (t)) * KVBLK)
#define DB(t) (__int_as_float(__builtin_amdgcn_readfirstlane(__float_as_int(dbrow[KBASE(t) >> 8]))))
#define MASKT(P0_, P1_, t) do { const int kb_ = KBASE(t); if (kb_ + KVBLK - 1 > qlo) mask_tile(P0_, P1_, qm - kb_); } while (0)
#define BIASLD(P0_, P1_, t) do { const unsigned so_ = (unsigned)((cur.h * T + KBASE(t)) * 4), vo_ = (unsigned)(hi * 16);                                             \
        _Pragma("unroll") for (int g_ = 0; g_ < 4; ++g_) { const f32x4 x_ = bloadf4(P.rsN, vo_ + 32 * g_, so_), y_ = bloadf4(P.rsN, vo_ + 128 + 32 * g_, so_);   \
            P0_[4 * g_] = x_.x; P0_[4 * g_ + 1] = x_.y; P0_[4 * g_ + 2] = x_.z; P0_[4 * g_ + 3] = x_.w; P1_[4 * g_] = y_.x; P1_[4 * g_ + 1] = y_.y; P1_[4 * g_ + 2] = y_.z; P1_[4 * g_ + 3] = y_.w; } } while (0)
    constexpr int NQL = 8;
#define SEAM_K0() do { VMWN(NQL); SWRITE_HK(0); SBAR(); } while (0)
    f32x16 pA0, pA1, pB0, pB1; float mnA, mnB, alA, alB; bf16x8 pa0, pa1, pa2, pa3;
    BIASLD(pA0, pA1, 0);
    SWRITE_HV(0); SBAR();
    SLOAD_H(cur.h, KBASE(1));
    SBAR(); qkt<0>(pA0, pA1, K_lds, r32, hi, S.qr);
    BIASLD(pB0, pB1, 1);
    MASKT(pA0, pA1, 0); partialSM(pA0, pA1, m_reg, mnA, alA, DB(0));
    VMW(); SWRITE_H(1);
    __syncthreads();
#define HALF_STEP(PX0, PX1, mnX, alX, PY0, PY1, alY, t, KB, VB, SB) do {                                                      \
        SBAR(); qkt<KB>(PX0, PX1, K_lds, r32, hi, S.qr);                                                                      \
        finishSM(PY0, PY1, alY, l_reg, pa0, pa1, pa2, pa3); SBAR();                                                           \
        if ((t) + 1 < NT) { BIASLD(PY0, PY1, (t) + 1); SLOAD_H(cur.h, KBASE((t) + 1)); SBAR(); }                              \
        pv_tile<VB>(o, vb0, pa0, pa1, pa2, pa3); MASKT(PX0, PX1, (t)); partialSM(PX0, PX1, m_reg, mnX, alX, DB(t));           \
        __syncthreads();                                                                                                      \
        if ((t) + 1 < NT) { VMW(); SWRITE_H(SB); }                                                                            \
        RESC(alX); __syncthreads(); } while (0)
    for (int t = 1; t + 1 < NT; t += 2) {
        HALF_STEP(pB0, pB1, mnB, alB, pA0, pA1, alA, t, 1, 0, 0);
        HALF_STEP(pA0, pA1, mnA, alA, pB0, pB1, alB, t + 1, 0, 1, 1);
    }
    const bool even = (NT & 1) == 0;
    if (even) { SBAR(); qkt<1>(pB0, pB1, K_lds, r32, hi, S.qr); SBAR(); }
    SLOAD_H(nxt.h, kbn); SBAR();
#pragma unroll
    for (int d0 = 0; d0 < 8; ++d0) S.qr[d0] = bload8(P.rsP, qoff + d0 * 32, ROWS(0, nxt.h, nxt.P0 + wid * QBLK, 0));
    SBAR();
    finishSM(pA0, pA1, alA, l_reg, pa0, pa1, pa2, pa3); SBAR();
    pv_tile<0>(o, vb0, pa0, pa1, pa2, pa3);
    if (even) { MASKT(pB0, pB1, NT - 1); partialSM(pB0, pB1, m_reg, mnB, alB, DB(NT - 1)); __syncthreads(); RESC(alB);
        finishSM(pB0, pB1, alB, l_reg, pa0, pa1, pa2, pa3); SBAR(); pv_tile<1>(o, vb0, pa0, pa1, pa2, pa3); }
    SBAR(); SEAM_K0();
    if (hi == 0) li_l[r32] = l_reg; asm volatile("s_waitcnt lgkmcnt(0)" ::: "memory");
    float rs[16];
#pragma unroll
    for (int r = 0; r < 16; ++r) { const float rl = __builtin_amdgcn_rcpf(li_l[crow(r, hi)]); float ss = 0.f;
#pragma unroll
        for (int d0 = 0; d0 < 4; ++d0) { o[d0][r] *= rl; ss += o[d0][r] * o[d0][r]; }
        rs[r] = ss; }
#pragma unroll
    for (int r = 0; r < 16; ++r) { rs[r] += swz_xor<1>(rs[r]); rs[r] += swz_xor<2>(rs[r]); rs[r] += swz_xor<4>(rs[r]); rs[r] += swz_xor<8>(rs[r]); rs[r] += swz_xor<16>(rs[r]); }
    float gv[4];
#pragma unroll
    for (int d0 = 0; d0 < 4; ++d0) gv[d0] = __builtin_bit_cast(float, __builtin_amdgcn_raw_buffer_load_b32(P.rsG, (int)(r32 * 4 + d0 * 128), (int)(cur.h * DH * 4), 0));
    const unsigned olane = (unsigned)((4 * hi * D + r32) * 2);
#pragma unroll
    for (int r = 0; r < 16; ++r) { const int orow_u = (r & 3) + 8 * (r >> 2); const float rn = 1.0f / sqrtf(rs[r] * (1.0f / 128.0f) + EPS);
#pragma unroll
        for (int d0 = 0; d0 < 4; ++d0) { const float v = o[d0][r] * rn * gv[d0]; const float vn = swz_xor<1>(v);
            if ((r32 & 1) == 0) __builtin_amdgcn_raw_buffer_store_b32(cvtpk(v, vn), P.rsM, (int)olane, (int)((((cur.P0 + wid * QBLK + orow_u) * D) + cur.h * DH + d0 * 32) * 2), 0); } }
    __syncthreads();
#undef RESC
#undef KBASE
#undef DB
#undef MASKT
#undef BIASLD
#undef SEAM_K0
#undef HALF_STEP
}
#undef ROWS
#undef VMW
#undef VMWN
#undef SLOAD_H
#undef SWRITE_HK
#undef SWRITE_HV
#undef SWRITE_H
}

constexpr float SKIPT = 64.0f;
__device__ __forceinline__ float nrm_of(const float* n4, int tile) { const f32x4 v = *(const GAS f32x4*)(n4 + 4 * tile); return sqrtf((v.x + v.y) + (v.z + v.w)); }
__device__ __forceinline__ int fox_jlo(const Args* ka, int h, int qb, int lane) {
    const float* nrm = (const float*)(ka->ws + WS_NRM); const float* ncl = (const float*)(ka->ws + WS_CL) + (size_t)h * T; const float* dbrow = (const float*)(ka->ws + WS_DBT) + (h * 32 + qb) * 32;
    const float* qn = nrm + (size_t)h * 128 * 4; const float* kn = nrm + (size_t)(16 + h) * 128 * 4;
    const float Qn = fmaxf(fmaxf(nrm_of(qn, 4 * qb), nrm_of(qn, 4 * qb + 1)), fmaxf(nrm_of(qn, 4 * qb + 2), nrm_of(qn, 4 * qb + 3)));
    const float Knb = fmaxf(fmaxf(nrm_of(kn, 4 * qb), nrm_of(kn, 4 * qb + 1)), fmaxf(nrm_of(kn, 4 * qb + 2), nrm_of(kn, 4 * qb + 3)));
    const float c0 = ncl[qb * 256];
    bool ns[2];
#pragma unroll
    for (int q = 0; q < 2; ++q) { const int j = lane + 64 * q; bool keep = true;
        if (j < 4 * qb) { const float bm = dbrow[j >> 2] - c0 + ncl[64 * j + 63]; const float bound = Qn * (nrm_of(kn, j) + Knb) + bm; keep = !(bound < -SKIPT); }
        ns[q] = keep; }
    const unsigned long long m0 = __ballot(ns[0]), m1 = __ballot(ns[1]);
    const int j0 = m0 ? (int)__builtin_ctzll(m0) : 64 + (int)__builtin_ctzll(m1);
    return __builtin_amdgcn_readfirstlane(j0 < 4 * qb ? j0 : 4 * qb);
}
__device__ __forceinline__ fa::BlockRef mk_ref(int item, int pass_, int L0, int jl0, int jl1) { const int x = item & 15, qb = pass_ ? 31 - x : x; fa::BlockRef r; r.h = item >> 4; r.P0 = qb * 256; r.jlo = item == L0 ? (pass_ ? jl1 : jl0) : 0; return r; }
__device__ __forceinline__ void ph_attn(const Args* ka, LAS unsigned char* lds_las, int vcu, int G, int wave) {
    char* lds = (char*)lds_las;
    unsigned char* ws = ka->ws;
    fa::AttnPtrs P; P.rsP = fa::mk_rsrc(ws + WS_PROJ, (unsigned)(3 * HEADBUF * 2)); P.rsN = fa::mk_rsrc(ws + WS_CL, (unsigned)(NH * T * 4)); P.rsG = fa::mk_rsrc(ka->in[8], 2048u * 4u);
    P.rsM = fa::mk_rsrc(ws + WS_MIX, (unsigned)((size_t)T * D * 2)); P.dBt = (const float*)(ws + WS_DBT);
    const int total = NH * 16;
    int L = vcu; if (L >= total) return;
    const int L0 = L; int jl0, jl1; { const int lane = lane_id(); jl0 = fox_jlo(ka, L >> 4, L & 15, lane); jl1 = fox_jlo(ka, L >> 4, 31 - (L & 15), lane); }
    int pass = 0; fa::BlockRef cur = mk_ref(L, 0, L0, jl0, jl1); fa::Seam S;
    fa::fox_prime(P, cur, lds, S, wave);
    for (;;) {
        const bool more_pass = pass == 0, more_item = L + G < total, last = !more_pass && !more_item;
        int passn = pass + 1, Ln = L; if (!more_pass) { passn = 0; Ln = more_item ? L + G : L; }
        const fa::BlockRef nxt = last ? cur : mk_ref(Ln, passn, L0, jl0, jl1);
        fa::fox_block(P, cur, nxt, lds, S, wave);
        if (last) break;
        cur = nxt; pass = passn; L = Ln;
    }
}

#ifndef HG_DLIM
#define HG_DLIM 100.0f
#endif
namespace hg {
typedef short bf16x8 __attribute__((ext_vector_type(8)));
typedef float f32x16 __attribute__((ext_vector_type(16)));
typedef float f32x4 __attribute__((ext_vector_type(4)));
typedef float f32x2 __attribute__((ext_vector_type(2)));
template <int M> __device__ __forceinline__ float swzx(float v) { return __int_as_float(__builtin_amdgcn_ds_swizzle(__float_as_int(v), 0x1F | (M << 10))); }
__device__ __forceinline__ float b2f(bf16 v) { return __uint_as_float((unsigned)v << 16); }
__device__ __forceinline__ float ex2(float v) { return __builtin_amdgcn_exp2f(v); }
__device__ __forceinline__ int crow(int r, int hi) { return (r & 3) + 8 * (r >> 2) + 4 * hi; }
__device__ __forceinline__ void gate(float f, float lbk, float omlb, float& g2, float& kk) {
    const float e = ex2(f * LOG2E);
    const float sg = __builtin_amdgcn_rcpf(1.0f + __builtin_amdgcn_rcpf(e)), sgn = __builtin_amdgcn_rcpf(1.0f + e);
    g2 = __builtin_amdgcn_logf(lbk + omlb * sg); kk = omlb * sgn;
}
}

__device__ __forceinline__ void ph_hgA(const Args* ka, LAS unsigned char* lds, int vcu, int G, int wave) {
    using namespace hg;
    const int lane = lane_id(), tid = wave * 64 + lane;
    unsigned char* ws = ka->ws;
    const bf16* HF = (const bf16*)(ws + WS_PROJ) + 4 * HEADBUF; const bf16* HI = (const bf16*)(ws + WS_PROJ) + 5 * HEADBUF;
    bf16* UT = (bf16*)(ws + WS_HU); float* dv = (float*)(ws + WS_HD); const float* lb = (const float*)(ws + WS_LB);
    LAS bf16* kdT = (LAS bf16*)lds; LAS bf16* iT = (LAS bf16*)(lds + 18432); LAS float* qt = (LAS float*)(lds + 36864);
    const int k = tid & 127, rq = tid >> 7;
    bf16 fraw[16]; v4u ivn0 = {0u, 0u, 0u, 0u}, ivn1 = ivn0;
    if (vcu < NH * 128) { const size_t rb = ((size_t)(vcu >> 7) * T + (vcu & 127) * 64 + 16 * rq) * 128 + k;
#pragma unroll
        for (int j = 0; j < 16; ++j) fraw[j] = HF[rb + j * 128];
        const bf16* ipn = HI + ((size_t)(vcu >> 7) * T + (vcu & 127) * 64 + (tid >> 4)) * 128 + (tid & 15) * 8; ivn0 = *(const GAS v4u*)ipn; ivn1 = *(const GAS v4u*)(ipn + 32 * 128); }
    for (int u = vcu; u < NH * 128; u += G) {
        const int h = u >> 7, n = u & 127, t0 = n * 64;
        const float lbk = lb[h * 128 + k], omlb = 1.0f - lbk;
        float c[16], kk[16]; float run = 0.f;
#pragma unroll
        for (int j = 0; j < 16; ++j) { float g2; gate(b2f(fraw[j]), lbk, omlb, g2, kk[j]); run += g2; c[j] = run; }
        qt[rq * 128 + k] = run;
        const v4u iv0 = ivn0, iv1 = ivn1;
        { const int un = u + G < NH * 128 ? u + G : u; const size_t rb = ((size_t)(un >> 7) * T + (un & 127) * 64 + 16 * rq) * 128 + k;
#pragma unroll
          for (int j = 0; j < 16; ++j) fraw[j] = HF[rb + j * 128];
          const bf16* ipn = HI + ((size_t)(un >> 7) * T + (un & 127) * 64 + (tid >> 4)) * 128 + (tid & 15) * 8; ivn0 = *(const GAS v4u*)ipn; ivn1 = *(const GAS v4u*)(ipn + 32 * 128); }
        __syncthreads();
        float off = 0.f, tot = 0.f;
#pragma unroll
        for (int q = 0; q < 4; ++q) { const float xq = qt[q * 128 + k]; if (q < rq) off += xq; tot += xq; }
#pragma unroll
        for (int j = 0; j < 16; ++j) (kdT + k * 72 + 16 * rq)[j] = (bf16)f2bf(kk[j] * ex2(tot - (off + c[j])));
        if (rq == 0) dv[(size_t)u * 128 + k] = ex2(tot);
        { const int tt = tid >> 4, v0 = (tid & 15) * 8;
#pragma unroll
          for (int e = 0; e < 4; ++e) { iT[(v0 + 2 * e) * 72 + tt] = (bf16)(iv0[e] & 0xffffu); iT[(v0 + 2 * e + 1) * 72 + tt] = (bf16)(iv0[e] >> 16);
                                        iT[(v0 + 2 * e) * 72 + tt + 32] = (bf16)(iv1[e] & 0xffffu); iT[(v0 + 2 * e + 1) * 72 + tt + 32] = (bf16)(iv1[e] >> 16); } }
        __syncthreads();
        const int mb = wave >> 1, nh = wave & 1, r = lane & 31, hh = lane >> 5;
        f32x16 acc0 = {}, acc1 = {};
#pragma unroll
        for (int s = 0; s < 4; ++s) { const bf16x8 av = *(const LAS bf16x8*)(iT + (mb * 32 + r) * 72 + 16 * s + 8 * hh);
            const bf16x8 b0 = *(const LAS bf16x8*)(kdT + (nh * 64 + r) * 72 + 16 * s + 8 * hh), b1 = *(const LAS bf16x8*)(kdT + (nh * 64 + 32 + r) * 72 + 16 * s + 8 * hh);
            acc0 = __builtin_amdgcn_mfma_f32_32x32x16_bf16(av, b0, acc0, 0, 0, 0); acc1 = __builtin_amdgcn_mfma_f32_32x32x16_bf16(av, b1, acc1, 0, 0, 0); }
        bf16* up = UT + (size_t)u * 16384 + nh * 64 + r;
#pragma unroll
        for (int r_ = 0; r_ < 16; ++r_) { const int v = mb * 32 + crow(r_, hh); const float n0 = swzx<1>(acc0[r_]), n1 = swzx<1>(acc1[r_]);
            if ((r & 1) == 0) { *(unsigned*)(up + v * 128) = pk2(acc0[r_], n0); *(unsigned*)(up + v * 128 + 32) = pk2(acc1[r_], n1); } }
        __syncthreads();
    }
}

__device__ __forceinline__ void ph_hgB(const Args* ka, int vcu, int G, int wave) {
    using namespace hg;
    const int lane = lane_id(), tid = wave * 64 + lane;
    unsigned char* ws = ka->ws;
    const bf16* UT = (const bf16*)(ws + WS_HU); const float* dv = (const float*)(ws + WS_HD); bf16* ST = (bf16*)(ws + WS_HS);
    for (int idx = vcu * 512 + tid; idx < NH * 128 * 64; idx += G * 512) {
        const int h = idx >> 13, v = (idx >> 6) & 127, kp = idx & 63;
        const unsigned* up = (const unsigned*)(UT + (size_t)h * 128 * 16384 + v * 128 + 2 * kp);
        const float* dp = dv + (size_t)h * 128 * 128 + 2 * kp;
        unsigned* sp = (unsigned*)(ST + (size_t)h * 128 * 16384 + v * 128 + 2 * kp);
        float s0 = 0.f, s1 = 0.f;
#pragma unroll 8
        for (int n = 0; n < 128; ++n) { const unsigned uw = __builtin_nontemporal_load(up + (size_t)n * 8192); const f32x2 dd = *(const GAS f32x2*)(dp + n * 128);
            sp[(size_t)n * 8192] = pk2(s0, s1); s0 = dd.x * s0 + __uint_as_float(uw << 16); s1 = dd.y * s1 + __uint_as_float(uw & 0xffff0000u); }
    }
}

__device__ __forceinline__ void ph_hgC(const Args* ka, LAS unsigned char* lds, int vcu, int G, int wave) {
    using namespace hg;
    const int lane = lane_id(), tid = wave * 64 + lane;
    unsigned char* ws = ka->ws;
    const bf16* PR = (const bf16*)(ws + WS_PROJ);
    const bf16* HQ = PR + 3 * HEADBUF; const bf16* HF = PR + 4 * HEADBUF; const bf16* HI = PR + 5 * HEADBUF; const bf16* HGb = PR + 6 * HEADBUF;
    const bf16* ST = (const bf16*)(ws + WS_HS); const float* lb = (const float*)(ws + WS_LB); bf16* MIX = (bf16*)(ws + WS_MIX); const float* ghg = ka->in[9];
    constexpr int OFF_QM = 0, OFF_KM = 17408, OFF_QR = 34816, OFF_KD = 52224, OFF_AM = 78336, OFF_QT = 87552, OFF_FLAG = 89600, OFF_FBQ = 89856, OFF_FBK = 107264;
    constexpr int BST = 132, HST = 136, AST = 72; constexpr float DLIM = HG_DLIM;
    LAS bf16* qmS = (LAS bf16*)(lds + OFF_QM); LAS bf16* kmS = (LAS bf16*)(lds + OFF_KM); LAS bf16* qrS = (LAS bf16*)(lds + OFF_QR); LAS bf16* kdS = (LAS bf16*)(lds + OFF_KD);
    LAS bf16* Am = (LAS bf16*)(lds + OFF_AM); LAS float* qt = (LAS float*)(lds + OFF_QT); volatile LAS unsigned* flag = (volatile LAS unsigned*)(lds + OFF_FLAG);
    LAS float* bS = (LAS float*)(lds + OFF_QM); LAS bf16* qS = (LAS bf16*)(lds + OFF_FBQ); LAS bf16* kkS = (LAS bf16*)(lds + OFF_FBK);
    LAS bf16* qdS = (LAS bf16*)(lds + OFF_QM); LAS bf16* iT = (LAS bf16*)(lds + OFF_KD); LAS bf16* STl = (LAS bf16*)(lds + OFF_KM); LAS float* oS = (LAS float*)(lds + OFF_KM);
    const int k = tid & 127, rq = tid >> 7;
    bf16 fraw[16], qraw[16];
    if (vcu < NH * 128) { const size_t rb = ((size_t)(vcu >> 7) * T + (vcu & 127) * 64 + 16 * rq) * 128 + k;
#pragma unroll
        for (int j = 0; j < 16; ++j) { fraw[j] = HF[rb + j * 128]; qraw[j] = HQ[rb + j * 128]; } }
    if (tid < 2) flag[tid] = 0u;
    __syncthreads();
    int par = 0;
    for (int u = vcu; u < NH * 128; u += G, par ^= 1) {
        const int h = u >> 7, n = u & 127, t0 = n * 64;
        const float lbk = lb[h * 128 + k], omlb = 1.0f - lbk;
        float c[16], kk[16], qv[16]; float run = 0.f;
#pragma unroll
        for (int j = 0; j < 16; ++j) { float g2; gate(b2f(fraw[j]), lbk, omlb, g2, kk[j]); run += g2; c[j] = run; qv[j] = b2f(qraw[j]); }
        { const int un = u + G < NH * 128 ? u + G : u; const size_t rb = ((size_t)(un >> 7) * T + (un & 127) * 64 + 16 * rq) * 128 + k;
#pragma unroll
          for (int j = 0; j < 16; ++j) { fraw[j] = HF[rb + j * 128]; qraw[j] = HQ[rb + j * 128]; } }
        qt[rq * 128 + k] = run;
        if (!(fmaxf(c[7] - c[15], c[0] - c[7]) <= DLIM)) flag[par] = 1u;
        for (int i = tid; i < 64 * AST / 2; i += 512) ((LAS unsigned*)Am)[i] = 0u;
        __syncthreads();
        const bool exact = flag[par] != 0u;
        if (tid == 0) flag[par ^ 1] = 0u;
        const float P1 = qt[k], P2 = P1 + qt[128 + k], P3 = P2 + qt[256 + k];
        const float off = rq == 0 ? 0.f : (rq == 1 ? P1 : (rq == 2 ? P2 : P3));
        { const int rbq = rq * (16 * HST) + k;
          LAS bf16* qr0 = qrS + rbq; LAS bf16* kd1 = kdS + rbq; LAS bf16* kd2 = kdS + 16 * HST + rbq; LAS bf16* kd3 = kdS + 48 * HST + rbq;
#pragma unroll
          for (int j = 0; j < 16; ++j) { const float bv = off + c[j];
            if (rq >= 1) qr0[j * HST] = (bf16)f2bf(qv[j] * ex2(c[j]));
            if (rq < 1) kd1[j * HST] = (bf16)f2bf(kk[j] * ex2(P1 - bv));
            if (rq < 2) kd2[j * HST] = (bf16)f2bf(kk[j] * ex2(P2 - bv));
            if (rq < 3) kd3[j * HST] = (bf16)f2bf(kk[j] * ex2(P3 - bv)); }
          if (!exact) { LAS bf16* qm0 = qmS + rbq; LAS bf16* km0 = kmS + rbq;
#pragma unroll
            for (int j = 0; j < 16; ++j) { qm0[j * HST] = (bf16)f2bf(qv[j] * ex2(c[j] - c[7])); km0[j * HST] = (bf16)f2bf(kk[j] * ex2(c[7] - c[j])); } }
          else { LAS float* bS0 = bS + rq * (16 * BST) + k; LAS bf16* kk0 = kkS + rbq; LAS bf16* q0 = qS + rbq;
#pragma unroll
            for (int j = 0; j < 16; ++j) { bS0[j * BST] = off + c[j]; kk0[j * HST] = (bf16)f2bf(kk[j]); q0[j * HST] = (bf16)f2bf(qv[j]); } } }
        __syncthreads();
        if (wave < 6) {
            const int I = wave < 1 ? 1 : (wave < 3 ? 2 : 3), J = wave < 1 ? 0 : (wave < 3 ? wave - 1 : wave - 3), kb = I == 1 ? 0 : (I == 2 ? 16 : 48);
            const int r16 = lane & 15, kq = lane >> 4; f32x4 acc = {0.f, 0.f, 0.f, 0.f};
#pragma unroll
            for (int ks = 0; ks < 4; ++ks) { const bf16x8 av = *(const LAS bf16x8*)(qrS + (16 * I + r16) * HST + 32 * ks + 8 * kq), bv = *(const LAS bf16x8*)(kdS + (kb + 16 * J + r16) * HST + 32 * ks + 8 * kq);
                acc = __builtin_amdgcn_mfma_f32_16x16x32_bf16(av, bv, acc, 0, 0, 0); }
#pragma unroll
            for (int e = 0; e < 4; ++e) Am[(16 * I + kq * 4 + e) * AST + 16 * J + r16] = (bf16)f2bf(acc[e]);
        }
        if (!exact && wave < 4) {
            const int I = wave, r16 = lane & 15, kq = lane >> 4; f32x4 acc = {0.f, 0.f, 0.f, 0.f};
#pragma unroll
            for (int ks = 0; ks < 4; ++ks) { const bf16x8 av = *(const LAS bf16x8*)(qmS + (16 * I + r16) * HST + 32 * ks + 8 * kq), bv = *(const LAS bf16x8*)(kmS + (16 * I + r16) * HST + 32 * ks + 8 * kq);
                acc = __builtin_amdgcn_mfma_f32_16x16x32_bf16(av, bv, acc, 0, 0, 0); }
#pragma unroll
            for (int e = 0; e < 4; ++e) if (r16 <= kq * 4 + e) Am[(16 * I + kq * 4 + e) * AST + 16 * I + r16] = (bf16)f2bf(acc[e]);
        }
        const bf16* ip = HI + ((size_t)h * T + t0 + (tid >> 4)) * 128 + (tid & 15) * 8;
        const v4u iv0 = *(const GAS v4u*)ip, iv1 = *(const GAS v4u*)(ip + 32 * 128);
        const bf16* sp = ST + (size_t)u * 16384 + (size_t)tid * 8;
        const v4u sv0 = __builtin_nontemporal_load((const GAS v4u*)sp), sv1 = __builtin_nontemporal_load((const GAS v4u*)(sp + 4096)), sv2 = __builtin_nontemporal_load((const GAS v4u*)(sp + 8192)), sv3 = __builtin_nontemporal_load((const GAS v4u*)(sp + 12288));
        if (exact) {
          const int ks = tid & 7, sq = (tid >> 3) & 3, tq = (tid >> 5) & 3, bI = tid >> 7;
          if (sq <= tq) {
            float acc[4][4];
#pragma unroll
            for (int i = 0; i < 4; ++i)
#pragma unroll
                for (int j = 0; j < 4; ++j) acc[i][j] = 0.f;
            const int tb = 16 * bI + 4 * tq, sb = 16 * bI + 4 * sq;
#pragma unroll 1
            for (int k4 = 0; k4 < 4; ++k4) { const int kc = ks * 16 + 4 * k4;
                f32x4 bt[4], bs[4]; float qf[4][4], kf[4][4];
#pragma unroll
                for (int i = 0; i < 4; ++i) { bt[i] = *(const LAS f32x4*)(bS + (tb + i) * BST + kc); const f32x2 qw = *(const LAS f32x2*)(qS + (tb + i) * HST + kc);
                    const unsigned w0 = __float_as_uint(qw.x), w1 = __float_as_uint(qw.y); qf[i][0] = __uint_as_float(w0 << 16); qf[i][1] = __uint_as_float(w0 & 0xffff0000u); qf[i][2] = __uint_as_float(w1 << 16); qf[i][3] = __uint_as_float(w1 & 0xffff0000u); }
#pragma unroll
                for (int j = 0; j < 4; ++j) { bs[j] = *(const LAS f32x4*)(bS + (sb + j) * BST + kc); const f32x2 kw = *(const LAS f32x2*)(kkS + (sb + j) * HST + kc);
                    const unsigned w0 = __float_as_uint(kw.x), w1 = __float_as_uint(kw.y); kf[j][0] = __uint_as_float(w0 << 16); kf[j][1] = __uint_as_float(w0 & 0xffff0000u); kf[j][2] = __uint_as_float(w1 << 16); kf[j][3] = __uint_as_float(w1 & 0xffff0000u); }
#pragma unroll
                for (int i = 0; i < 4; ++i)
#pragma unroll
                    for (int j = 0; j < 4; ++j)
#pragma unroll
                        for (int e = 0; e < 4; ++e) acc[i][j] += qf[i][e] * kf[j][e] * ex2(fminf(bt[i][e] - bs[j][e], 0.f));
            }
#pragma unroll
            for (int i = 0; i < 4; ++i)
#pragma unroll
                for (int j = 0; j < 4; ++j) { float a_ = acc[i][j]; a_ += swzx<1>(a_); a_ += swzx<2>(a_); a_ += swzx<4>(a_);
                    if (ks == 0 && sb + j <= tb + i) Am[(tb + i) * AST + sb + j] = (bf16)f2bf(a_); }
          }
        }
        __syncthreads();
        { LAS bf16* qd0 = qdS + rq * (16 * HST) + k;
#pragma unroll
          for (int j = 0; j < 16; ++j) qd0[j * HST] = (bf16)f2bf(qv[j] * ex2(off + c[j])); }
        { const int tt = tid >> 4, v0 = (tid & 15) * 8;
#pragma unroll
          for (int e = 0; e < 4; ++e) { iT[(v0 + 2 * e) * AST + tt] = (bf16)(iv0[e] & 0xffffu); iT[(v0 + 2 * e + 1) * AST + tt] = (bf16)(iv0[e] >> 16);
                                        iT[(v0 + 2 * e) * AST + tt + 32] = (bf16)(iv1[e] & 0xffffu); iT[(v0 + 2 * e + 1) * AST + tt + 32] = (bf16)(iv1[e] >> 16); }
          *(LAS v4u*)(STl + ((tid >> 4)) * HST + (tid & 15) * 8) = sv0; *(LAS v4u*)(STl + ((tid >> 4) + 32) * HST + (tid & 15) * 8) = sv1;
          *(LAS v4u*)(STl + ((tid >> 4) + 64) * HST + (tid & 15) * 8) = sv2; *(LAS v4u*)(STl + ((tid >> 4) + 96) * HST + (tid & 15) * 8) = sv3; }
        __syncthreads();
        const int mb = wave >> 2, nb = wave & 3, r = lane & 31, hh = lane >> 5;
        f32x16 oacc = {};
#pragma unroll
        for (int s = 0; s < 8; ++s) { const bf16x8 av = *(const LAS bf16x8*)(qdS + (mb * 32 + r) * HST + 16 * s + 8 * hh), bv = *(const LAS bf16x8*)(STl + (nb * 32 + r) * HST + 16 * s + 8 * hh);
            oacc = __builtin_amdgcn_mfma_f32_32x32x16_bf16(av, bv, oacc, 0, 0, 0); }
#pragma unroll
        for (int s = 0; s < 4; ++s) { const bf16x8 av = *(const LAS bf16x8*)(Am + (mb * 32 + r) * AST + 16 * s + 8 * hh), bv = *(const LAS bf16x8*)(iT + (nb * 32 + r) * AST + 16 * s + 8 * hh);
            oacc = __builtin_amdgcn_mfma_f32_32x32x16_bf16(av, bv, oacc, 0, 0, 0); }
        __syncthreads();
#pragma unroll
        for (int r_ = 0; r_ < 16; ++r_) oS[(mb * 32 + crow(r_, hh)) * BST + nb * 32 + r] = oacc[r_];
        __syncthreads();
        { const int t = tid >> 3, seg = tid & 7; float ov[16]; float ss = 0.f;
#pragma unroll
          for (int q = 0; q < 4; ++q) { const f32x4 x4 = *(const LAS f32x4*)(oS + t * BST + seg * 16 + 4 * q); ov[4 * q] = x4.x; ov[4 * q + 1] = x4.y; ov[4 * q + 2] = x4.z; ov[4 * q + 3] = x4.w;
              ss += (x4.x * x4.x + x4.y * x4.y) + (x4.z * x4.z + x4.w * x4.w); }
          ss += swzx<1>(ss); ss += swzx<2>(ss); ss += swzx<4>(ss);
          const float rn = 1.0f / sqrtf(ss * (1.0f / 128.0f) + EPS);
          const bf16* gp = HGb + ((size_t)h * T + t0 + t) * 128 + seg * 16;
          const v4u g0 = *(const GAS v4u*)gp, g1 = *(const GAS v4u*)(gp + 8);
          float gf[16];
#pragma unroll
          for (int e = 0; e < 4; ++e) { gf[2 * e] = __uint_as_float(g0[e] << 16); gf[2 * e + 1] = __uint_as_float(g0[e] & 0xffff0000u); gf[8 + 2 * e] = __uint_as_float(g1[e] << 16); gf[8 + 2 * e + 1] = __uint_as_float(g1[e] & 0xffff0000u); }
          float yv[16];
#pragma unroll
          for (int q = 0; q < 4; ++q) { const f32x4 gg = *(const GAS f32x4*)(ghg + h * 128 + seg * 16 + 4 * q);
              yv[4 * q] = ov[4 * q] * rn * gg.x * gf[4 * q]; yv[4 * q + 1] = ov[4 * q + 1] * rn * gg.y * gf[4 * q + 1]; yv[4 * q + 2] = ov[4 * q + 2] * rn * gg.z * gf[4 * q + 2]; yv[4 * q + 3] = ov[4 * q + 3] * rn * gg.w * gf[4 * q + 3]; }
          bf16* mp = MIX + (size_t)(t0 + t) * D + 2048 + h * 128 + seg * 16;
          v4u w0, w1;
#pragma unroll
          for (int e = 0; e < 4; ++e) { w0[e] = pk2(yv[2 * e], yv[2 * e + 1]); w1[e] = pk2(yv[8 + 2 * e], yv[8 + 2 * e + 1]); }
          *(GAS v4u*)mp = w0; *(GAS v4u*)(mp + 8) = w1; }
        __syncthreads();
    }
}

__global__ void __launch_bounds__(512, 2) fwd(Args a) {
    const Args* ka = (const Args*)__builtin_amdgcn_kernarg_segment_ptr();
    extern __shared__ __attribute__((aligned(16))) unsigned char lds_[];
    LAS unsigned char* lds = (LAS unsigned char*)lds_;
    volatile LAS unsigned* MISC = (volatile LAS unsigned*)(lds + MISC_OFF);
    const int wave = __builtin_amdgcn_readfirstlane(threadIdx.x >> 6);
#define lane lane_id()
#define tid (wave * 64 + lane_id())
    const int G = gridDim.x; const int bx = blockIdx.x; const int vcu = (G % 8 == 0) ? (bx % 8) * (G / 8) + bx / 8 : bx;
    for (int u = tid; u < (LDS_BYTES - LDSCTL_OFF) / 4; u += 512) ((LAS unsigned*)(lds + LDSCTL_OFF))[u] = 0u;
    __syncthreads();
#define ws (ka->ws)
    gu32* ctl = (gu32*)(ws + WS_CTL);
    XcdBarrier bar = xcd_barrier_post((unsigned*)(ctl + CW_BAR), MISC + 8);
    const unsigned mask = ka->mask;
#ifndef GEMM_SP2
#define GEMM_SP2 true
#endif
#define HAS(p) (mask & (1u << (p)))
#ifndef REPEAT_MASK
#define REPEAT_MASK 0u
#endif
#define REP(p) for (int rep_ = 0; rep_ < 1 + (int)((REPEAT_MASK >> (p)) & 1u); ++rep_) if (rep_ ? (__syncthreads(), true) : true)
#define SEAM(k) do { if ((mask & ((1u << (k)) - 1u)) && (mask >> (k))) xcd_barrier(bar); } while (0)
#define x (ka->in[0])
#define mod ((float*)(ws + WS_MOD))
#define Hb ((bf16*)(ws + WS_H))
#define PROJ ((bf16*)(ws + WS_PROJ))
#define MIX ((bf16*)(ws + WS_MIX))
#define D1b ((bf16*)(ws + WS_D1))
#define D2b ((bf16*)(ws + WS_D2))

    const int G1 = (G == 256) ? 224 : G;
    if (HAS(PC_PRO)) REP(PC_PRO) { if (G1 < G) ph_prologue<1>(ka, lds, vcu, G, tid, lane, wave); else ph_prologue<3>(ka, lds, vcu, G, tid, lane, wave); }
    SEAM(PC_NORM1);
    if (HAS(PC_NORM1)) REP(PC_NORM1) ph_norm<true>(x, nullptr, ka->in[4], (const float*)(ws + WS_PART), ka->in[3], Hb, (const bf16*)(ws + WS_WF), ka->in[6], (float*)(ws + WS_LF), mod, G1 < G ? 2 * D : NMOD, lds, vcu, G, tid, lane, wave);
    SEAM(PC_CUM);
    if (HAS(PC_GEMM1)) REP(PC_GEMM1) {
        pg8::Gemm g{Hb, (const bf16*)(ws + WS_WIN), T, NPROJ, D}; pg8::StaticOrder S; S.init(T, NPROJ, G1, bx);
        pg8::EpiProj E{PROJ, HEADBUF, T, QSCALE, (float*)(ws + WS_NRM)};
        if (bx < G1) pg8::gemm_phase<pg8::EpiProj, pg8::StaticOrder, true, GEMM_SP2>(lds, g, S, E, wave);
#ifndef STREAM_REP
#define STREAM_REP 1
#endif
        else { if (HAS(PC_CUM)) ph_cum(ka, lds, bx - G1, tid, lane);
            for (int sr_ = 0; sr_ < STREAM_REP; ++sr_) { if (sr_) __syncthreads(); ph_prologue<2>(ka, lds, bx - G1, G - G1, tid, lane, wave); }
#ifdef STREAM_DELAY_US
            { const unsigned long long t0_ = wall_clock64(); while (wall_clock64() - t0_ < 100ull * STREAM_DELAY_US) __builtin_amdgcn_s_sleep(8); }
#endif
        }
    }
    SEAM(PC_HGA);
    if (HAS(PC_GEMM1) && G1 < G) ph_modreduce(ka, 2 * D, vcu, G, tid);
    if (HAS(PC_CUM) && G1 == G) REP(PC_CUM) ph_cum(ka, lds, vcu, tid, lane);
    if (HAS(PC_HGA)) REP(PC_HGA) ph_hgA(ka, lds, vcu, G, wave);
    SEAM(PC_HGB);
    if (HAS(PC_HGB)) REP(PC_HGB) ph_hgB(ka, vcu, G, wave);
    SEAM(PC_HGC);
    if (HAS(PC_HGC)) REP(PC_HGC) ph_hgC(ka, lds, vcu, G, wave);
    if (HAS(PC_ATTN)) REP(PC_ATTN) ph_attn(ka, lds, vcu, G, wave);
    SEAM(PC_GEMM2);
    if (HAS(PC_GEMM2)) REP(PC_GEMM2) {
        pg8::Gemm g{MIX, (const bf16*)(ws + WS_WO), T, D, D}; pg8::StaticOrder S; S.init(T, D, G, bx);
        pg8::EpiGate E{D1b, D, mod + 2 * D};
        pg8::gemm_phase<pg8::EpiGate, pg8::StaticOrder, true, GEMM_SP2>(lds, g, S, E, wave);
    }
    SEAM(PC_NORM2);
    if (HAS(PC_NORM2)) REP(PC_NORM2) ph_norm<false>(x, D1b, ka->in[11], mod + 3 * D, mod + 4 * D, Hb, nullptr, nullptr, nullptr, nullptr, 0, lds, vcu, G, tid, lane, wave);
    SEAM(PC_GEMM3);
    if (HAS(PC_GEMM3)) REP(PC_GEMM3) {
        pg8::Gemm g{Hb, (const bf16*)(ws + WS_WUP), T, FF2, D}; pg8::StaticOrder S; S.init(T, FF2, G, bx);
        pg8::EpiConv E{(bf16*)(ws + WS_ACT), ka->in[13], ka->in[14], (float*)(ws + WS_UH), lds + HALO_OFF, FF};
        pg8::gemm_phase<pg8::EpiConv, pg8::StaticOrder, true, GEMM_SP2>(lds, g, S, E, wave);
#ifndef WD_DYN
        { const int nun = (T / 256) * (FF2 / 256), rem = nun % G;
          const int rank = rem ? bx - rem : bx, nrank = rem ? G - rem : G;
          if (rank >= 0) ph_convert_wd(ka, lds, rank, nrank, wave); }
#else
        ph_convert_wd_dyn(ka, lds, wave);
#endif
    }
    SEAM(PC_CONV);
    if (HAS(PC_CONV)) REP(PC_CONV) ph_convfix(ka, vcu, G, tid);
    SEAM(PC_GEMM4);
    if (HAS(PC_GEMM4)) REP(PC_GEMM4) {
        pg8::Gemm g{(const bf16*)(ws + WS_ACT), (const bf16*)(ws + WS_WD), T, D, FF}; pg8::StaticOrder S; S.init(T, D, G, bx);
        pg8::EpiGate E{D2b, D, mod + 5 * D};
        pg8::gemm_phase<pg8::EpiGate, pg8::StaticOrder, true, GEMM_SP2>(lds, g, S, E, wave);
    }
    SEAM(PC_FNORM);
    if (HAS(PC_FNORM)) REP(PC_FNORM) ph_fnorm(x, D1b, D2b, ka->out, ka->in[16], vcu, G, lane, wave);
#undef HAS
#undef lane
#undef tid
#undef SEAM
#undef ws
#undef x
#undef mod
#undef Hb
#undef PROJ
#undef MIX
#undef D1b
#undef D2b
}

extern "C" void kernel_launch(void* const* d_in, const int* in_sizes, int n_in, void* d_out, int out_size, void* d_ws, size_t ws_size, hipStream_t stream) {
    static int grid = 0;
    if (grid == 0) {
        if (n_in != 17 || in_sizes[0] != T * D || out_size != T * D || ws_size < WS_END) { fprintf(stderr, "kernel_launch: unexpected shapes / workspace (n_in %d, ws %zu)\n", n_in, ws_size); grid = -1; return; }
        int dev = 0, cus = 0, per_cu = 0;
        if (hipGetDevice(&dev) != hipSuccess || hipDeviceGetAttribute(&cus, hipDeviceAttributeMultiprocessorCount, dev) != hipSuccess) { grid = -1; return; }
        if (hipFuncSetAttribute((const void*)fwd, hipFuncAttributeMaxDynamicSharedMemorySize, LDS_BYTES) != hipSuccess) { fprintf(stderr, "kernel_launch: hipFuncSetAttribute failed\n"); grid = -1; return; }
        if (hipOccupancyMaxActiveBlocksPerMultiprocessor(&per_cu, (const void*)fwd, 512, LDS_BYTES) != hipSuccess || per_cu < 1) fprintf(stderr, "kernel_launch: occupancy query reports %d\n", per_cu);
        (void)hipGetLastError();
        grid = cus;
    }
    if (grid < 0) return;
    (void)hipMemsetAsync((char*)d_ws + WS_CTL, 0, CTL_ZERO_BYTES, stream);
    Args a{};
    for (int i = 0; i < 17; ++i) a.in[i] = (const float*)d_in[i];
    a.out = (float*)d_out; a.ws = (unsigned char*)d_ws; a.mask = (1u << PC_N) - 1u; a.pad = 0u;
    hipLaunchKernelGGL(fwd, dim3(grid), dim3(512), LDS_BYTES, stream, a);
}
```

```cpp
#include <hip/hip_runtime.h>
#include <cstdio>
#include <cstdint>

constexpr int T = 8192, D = 4096, NMOD = 6 * D, INC = 14352, FF = 11008, FF2 = 22016, NH = 16, HD = 128;
constexpr int FOX_F0 = 6144, HG_Q0 = 6160, HG_F0 = HG_Q0 + 2048, HG_I0 = HG_F0 + 2048, HG_G0 = HG_I0 + 2048;
constexpr int NPROJ = 14336;
constexpr float EPS = 1e-6f;
constexpr float LOG2E = 1.4426950408889634f;
constexpr float QSCALE = 0.08838834764831845f * 1.4426950408889634f;
constexpr size_t HEADBUF = (size_t)NH * T * HD;
__device__ __forceinline__ int lane_id() { int l; asm volatile("v_mbcnt_lo_u32_b32 %0, -1, 0\n\tv_mbcnt_hi_u32_b32 %0, -1, %0" : "=v"(l)); return l; }


#ifndef PG8_WGM
#define PG8_WGM 8
#endif
namespace pg8 {
#define PG8_LAS __attribute__((address_space(3)))
typedef unsigned short bf16_t;
typedef short bf16x8 __attribute__((ext_vector_type(8)));
typedef float f32x4 __attribute__((ext_vector_type(4)));
typedef float f32x2 __attribute__((ext_vector_type(2)));
typedef unsigned u32x4 __attribute__((ext_vector_type(4)));
constexpr int BM = 256, BK = 64, HALF = 128, HTB = HALF * BK * 2  , STAGE_BYTES = 8 * HTB, NXCD = 8, WGM = PG8_WGM;

__host__ __device__ __forceinline__ int lds_byte(int r, int c) { const int st = (r >> 4) * 2 + (c >> 5), rr = r & 15, cc = c & 31, ob = rr * 64 + cc * 2; return st * 1024 + (ob ^ (((ob >> 9) & 1) << 5)); }
__host__ __device__ __forceinline__ void stage_rc(int b, int& R, int& C) { const int st = b / 1024, sb = b % 1024, swz = sb ^ (((sb >> 9) & 1) << 5); R = (st >> 1) * 16 + swz / 64; C = (st & 1) * 32 + (swz % 64) / 2; }
__host__ __device__ __forceinline__ int perm32(int rho) { const int n = rho >> 4, i = rho & 15; return 8 * (i >> 2) + 4 * n + (i & 3); }

struct Unit { int pm, pn; };
struct Gemm { const bf16_t* A; const bf16_t* Bt; int M, N, K; };

struct StaticOrder {
    int nM, nN, nwg, G, c;
    __host__ __device__ void init(int M, int N, int G_, int c_) { nM = M / BM; nN = N / BM; nwg = nM * nN; G = G_; c = c_; }
    __host__ __device__ bool next(int i, Unit& u) const {
        const long L = (long)i * G + c; if (L >= nwg) return false;
        int wgid = (int)L; { const int q = nwg / NXCD, r = nwg % NXCD, xcd = wgid % NXCD, off = wgid / NXCD; wgid = (xcd < r ? xcd * (q + 1) : r * (q + 1) + (xcd - r) * q) + off; }
        const int nig = WGM * nN, gid = wgid / nig, fm = gid * WGM, gsz = (nM - fm) < WGM ? (nM - fm) : WGM;
        u.pm = fm + ((wgid % nig) % gsz); u.pn = (wgid % nig) / gsz; return true;
    }
    __device__ __forceinline__ void a_ready(const Unit&) const {}
    __device__ __forceinline__ void done(const Unit&) const {}
};


__device__ __forceinline__ unsigned cvt_pk_bf16(float lo, float hi) { unsigned r; asm volatile("v_cvt_pk_bf16_f32 %0, %1, %2" : "=v"(r) : "v"(lo), "v"(hi)); return r; }
__device__ __forceinline__ float silu_f(float v) { return v * __builtin_amdgcn_rcpf(1.0f + __builtin_amdgcn_exp2f(-1.4426950408889634f * v)); }
struct EpiBf16 {
    static constexpr bool PERM = true, AFTER_DRAIN = false;
    bf16_t* O; int ldc;
    __device__ __forceinline__ void operator()(const f32x4 (&acc)[2][2][4][2], const Unit& u, int wr, int wc, int fr, int fq) const {
        const int row0 = u.pm * BM + wr * 64 + fr, col0 = u.pn * BM + wc * 32 + 8 * fq;
#pragma unroll
        for (int ai = 0; ai < 2; ++ai)
#pragma unroll
            for (int m = 0; m < 4; ++m) { bf16_t* rowp = O + (size_t)(row0 + ai * HALF + m * 16) * ldc + col0;
#pragma unroll
                for (int bj = 0; bj < 2; ++bj) { const f32x4 v0 = acc[ai][bj][m][0], v1 = acc[ai][bj][m][1];
                    u32x4 w; w.x = cvt_pk_bf16(v0[0], v0[1]); w.y = cvt_pk_bf16(v0[2], v0[3]); w.z = cvt_pk_bf16(v1[0], v1[1]); w.w = cvt_pk_bf16(v1[2], v1[3]);
                    *(u32x4*)(rowp + bj * HALF) = w; } }
    }
};
struct EpiProj {
    static constexpr bool PERM = true, AFTER_DRAIN = false;
    bf16_t* base; size_t bufsz; int tlen; float qscale; float* nrm4;
    __device__ __forceinline__ void operator()(const f32x4 (&acc)[2][2][4][2], const Unit& u, int wr, int wc, int fr, int fq) const {
        const int type = u.pn >> 3, hp = u.pn & 7;
        const int row0 = u.pm * BM + wr * 64 + fr, cin = wc * 32 + 8 * fq;
        bf16_t* tb = base + (size_t)type * bufsz;
        const bool act = (type == 3) || (type == 6); const float sc = (type == 0) ? qscale : 1.0f;
#pragma unroll
        for (int ai = 0; ai < 2; ++ai)
#pragma unroll
            for (int m = 0; m < 4; ++m) { const int row = row0 + ai * HALF + m * 16;
#pragma unroll
                for (int bj = 0; bj < 2; ++bj) { f32x4 v0 = acc[ai][bj][m][0], v1 = acc[ai][bj][m][1];
                    if (act) {
#pragma unroll
                        for (int e = 0; e < 4; ++e) { v0[e] = silu_f(v0[e]); v1[e] = silu_f(v1[e]); } }
                    v0 = v0 * sc; v1 = v1 * sc;
                    u32x4 w; w.x = cvt_pk_bf16(v0[0], v0[1]); w.y = cvt_pk_bf16(v0[2], v0[3]); w.z = cvt_pk_bf16(v1[0], v1[1]); w.w = cvt_pk_bf16(v1[2], v1[3]);
                    *(u32x4*)(tb + ((size_t)(2 * hp + bj) * tlen + row) * 128 + cin) = w; } }
        if (type <= 1) {
#pragma unroll
            for (int ai = 0; ai < 2; ++ai)
#pragma unroll
                for (int bj = 0; bj < 2; ++bj) { float mx = 0.f;
#pragma unroll
                    for (int m = 0; m < 4; ++m) { const f32x4 v0 = acc[ai][bj][m][0] * sc, v1 = acc[ai][bj][m][1] * sc;
                        float ss = (v0[0] * v0[0] + v0[1] * v0[1]) + (v0[2] * v0[2] + v0[3] * v0[3]) + (v1[0] * v1[0] + v1[1] * v1[1]) + (v1[2] * v1[2] + v1[3] * v1[3]);
                        ss += __shfl_xor(ss, 16); ss += __shfl_xor(ss, 32); mx = fmaxf(mx, ss); }
                    mx = fmaxf(mx, __shfl_xor(mx, 1)); mx = fmaxf(mx, __shfl_xor(mx, 2)); mx = fmaxf(mx, __shfl_xor(mx, 4)); mx = fmaxf(mx, __shfl_xor(mx, 8));
                    if (fr == 0 && fq == 0) nrm4[(((size_t)type * 16 + 2 * hp + bj) * (tlen / 64) + (u.pm * 4 + 2 * ai + wr)) * 4 + wc] = mx * 1.01f; }
        }
    }
};
struct EpiGate {
    static constexpr bool PERM = true, AFTER_DRAIN = false;
    bf16_t* O; int ldc; const float* gate;
    __device__ __forceinline__ void operator()(const f32x4 (&acc)[2][2][4][2], const Unit& u, int wr, int wc, int fr, int fq) const {
        const int row0 = u.pm * BM + wr * 64 + fr, col0 = u.pn * BM + wc * 32 + 8 * fq;
        f32x4 gv[2][2];
#pragma unroll
        for (int bj = 0; bj < 2; ++bj)
#pragma unroll
            for (int n = 0; n < 2; ++n) gv[bj][n] = *(const f32x4*)(gate + col0 + bj * HALF + 4 * n);
#pragma unroll
        for (int ai = 0; ai < 2; ++ai)
#pragma unroll
            for (int m = 0; m < 4; ++m) { bf16_t* rowp = O + (size_t)(row0 + ai * HALF + m * 16) * ldc + col0;
#pragma unroll
                for (int bj = 0; bj < 2; ++bj) { const f32x4 v0 = acc[ai][bj][m][0] * gv[bj][0], v1 = acc[ai][bj][m][1] * gv[bj][1];
                    u32x4 w; w.x = cvt_pk_bf16(v0[0], v0[1]); w.y = cvt_pk_bf16(v0[2], v0[3]); w.z = cvt_pk_bf16(v1[0], v1[1]); w.w = cvt_pk_bf16(v1[2], v1[3]);
                    *(u32x4*)(rowp + bj * HALF) = w; } }
    }
};
struct EpiRes {
    static constexpr bool PERM = false, AFTER_DRAIN = false;
    const float* R; float* out; int ldc; const float* gate;
    __device__ __forceinline__ void operator()(const f32x4 (&acc)[2][2][4][2], const Unit& u, int wr, int wc, int fr, int fq) const {
        const int col0 = u.pn * BM + wc * 32 + 4 * fq;
        f32x4 gv[2][2];
#pragma unroll
        for (int bj = 0; bj < 2; ++bj)
#pragma unroll
            for (int n = 0; n < 2; ++n) gv[bj][n] = *(const f32x4*)(gate + col0 + bj * HALF + n * 16);
#pragma unroll
        for (int ai = 0; ai < 2; ++ai)
#pragma unroll
            for (int m = 0; m < 4; ++m) { const size_t off = (size_t)(u.pm * BM + ai * HALF + wr * 64 + m * 16 + fr) * ldc + col0;
#pragma unroll
                for (int bj = 0; bj < 2; ++bj)
#pragma unroll
                    for (int n = 0; n < 2; ++n) { const f32x4 rs = *(const f32x4*)(R + off + bj * HALF + n * 16);
                        *(f32x4*)(out + off + bj * HALF + n * 16) = rs + gv[bj][n] * acc[ai][bj][m][n]; } }
    }
};


__device__ __forceinline__ float dpp_f(float oldv, float src, const int ctrl_sel) {
    return ctrl_sel == 0 ? __int_as_float(__builtin_amdgcn_update_dpp(__float_as_int(oldv), __float_as_int(src), 0x111, 0xF, 0xF, false))
         : ctrl_sel == 1 ? __int_as_float(__builtin_amdgcn_update_dpp(__float_as_int(oldv), __float_as_int(src), 0x112, 0xF, 0xF, false))
         : ctrl_sel == 2 ? __int_as_float(__builtin_amdgcn_update_dpp(__float_as_int(oldv), __float_as_int(src), 0x15F, 0xF, 0xF, false))
         :                 __int_as_float(__builtin_amdgcn_update_dpp(__float_as_int(oldv), __float_as_int(src), 0x15E, 0xF, 0xF, false));
}
struct EpiConv {
    static constexpr bool PERM = true, AFTER_DRAIN = false;
    bf16_t* ACT; const float* cw; const float* cb; float* UH; PG8_LAS unsigned char* halo; int ff;
    __device__ __forceinline__ void operator()(const f32x4 (&acc)[2][2][4][2], const Unit& u, int wr, int wc, int fr, int fq) const {
        const int cin = wc * 32 + 8 * fq, j0 = u.pn * 128 + cin, ff2 = 2 * ff;
        PG8_LAS f32x4* hl = (PG8_LAS f32x4*)halo;
        if (fr >= 14) {
#pragma unroll
            for (int ai = 0; ai < 2; ++ai)
#pragma unroll
                for (int bj = 0; bj < 2; ++bj)
#pragma unroll
                    for (int n = 0; n < 2; ++n) hl[(((2 * ai + wr) * 2 + (fr - 14)) * 2 + bj) * 32 + (cin >> 2) + n] = acc[ai][bj][3][n];
            if (wr == 1) {
#pragma unroll
                for (int bj = 0; bj < 2; ++bj)
#pragma unroll
                    for (int n = 0; n < 2; ++n) *(f32x4*)(UH + (size_t)(u.pm * 4 + 2 + (fr - 14)) * ff2 + bj * ff + j0 + 4 * n) = acc[1][bj][3][n];
            }
        }
        if (wr == 0 && fr < 2) {
#pragma unroll
            for (int bj = 0; bj < 2; ++bj)
#pragma unroll
                for (int n = 0; n < 2; ++n) *(f32x4*)(UH + (size_t)(u.pm * 4 + fr) * ff2 + bj * ff + j0 + 4 * n) = acc[0][bj][0][n];
        }
        f32x4 wA[3][2], wV[3][2], bA[2], bV[2];
#pragma unroll
        for (int n = 0; n < 2; ++n) {
#pragma unroll
            for (int tp = 0; tp < 3; ++tp) { wA[tp][n] = *(const f32x4*)(cw + (size_t)tp * ff2 + j0 + 4 * n); wV[tp][n] = *(const f32x4*)(cw + (size_t)tp * ff2 + ff + j0 + 4 * n); }
            bA[n] = *(const f32x4*)(cb + j0 + 4 * n); bV[n] = *(const f32x4*)(cb + ff + j0 + 4 * n); }
        asm volatile("s_waitcnt lgkmcnt(0)" ::: "memory"); __builtin_amdgcn_s_barrier(); asm volatile("" ::: "memory");
#pragma unroll
        for (int ai = 0; ai < 2; ++ai) {
            const int g = 2 * ai + wr;
#pragma unroll
            for (int m = 0; m < 4; ++m) {
                const int row = u.pm * BM + ai * HALF + wr * 64 + m * 16 + fr;
                f32x4 y[2][2];
#pragma unroll
                for (int bj = 0; bj < 2; ++bj)
#pragma unroll
                    for (int n = 0; n < 2; ++n) {
                        const f32x4 cur = acc[ai][bj][m][n];
                        const f32x4 w0 = bj ? wV[0][n] : wA[0][n], w1 = bj ? wV[1][n] : wA[1][n], w2 = bj ? wV[2][n] : wA[2][n], bb = bj ? bV[n] : bA[n];
                        f32x4 o;
                        if (m == 0) {
                            f32x4 p62, p63;
                            if (g == 0) { p62 = (f32x4){0.f, 0.f, 0.f, 0.f}; p63 = p62; }
                            else { p62 = hl[(((g - 1) * 2 + 0) * 2 + bj) * 32 + (cin >> 2) + n]; p63 = hl[(((g - 1) * 2 + 1) * 2 + bj) * 32 + (cin >> 2) + n]; }
#pragma unroll
                            for (int e = 0; e < 4; ++e) { const float xx = dpp_f(p62[e], p63[e], 0);
                                const float pr1 = dpp_f(p63[e], cur[e], 0), pr2 = dpp_f(xx, cur[e], 1);
                                o[e] = bb[e] + w0[e] * pr2 + w1[e] * pr1 + w2[e] * cur[e]; }
                        } else {
#pragma unroll
                            for (int h = 0; h < 2; ++h) {
                                f32x2 pr1, pr2;
#pragma unroll
                                for (int q = 0; q < 2; ++q) { const int pv = __float_as_int(acc[ai][bj][m - 1][n][2 * h + q]), cv = __float_as_int(cur[2 * h + q]);
                                    pr1[q] = __int_as_float(__builtin_amdgcn_update_dpp(__builtin_amdgcn_mov_dpp(pv, 0x121, 0xF, 0xF, false), cv, 0x111, 0xF, 0xF, false));
                                    pr2[q] = __int_as_float(__builtin_amdgcn_update_dpp(__builtin_amdgcn_mov_dpp(pv, 0x122, 0xF, 0xF, false), cv, 0x112, 0xF, 0xF, false)); }
                                const f32x2 c2 = {cur[2 * h], cur[2 * h + 1]}, w02 = {w0[2 * h], w0[2 * h + 1]}, w12 = {w1[2 * h], w1[2 * h + 1]}, w22 = {w2[2 * h], w2[2 * h + 1]}, bb2 = {bb[2 * h], bb[2 * h + 1]};
                                const f32x2 o2 = bb2 + w02 * pr2 + w12 * pr1 + w22 * c2;
                                o[2 * h] = o2[0]; o[2 * h + 1] = o2[1]; }
                        }
                        y[bj][n] = o;
                    }
                u32x4 w;
                { const f32x4 a0 = y[0][0], a1 = y[0][1], v0 = y[1][0], v1 = y[1][1];
                  w.x = cvt_pk_bf16(silu_f(a0[0]) * v0[0], silu_f(a0[1]) * v0[1]); w.y = cvt_pk_bf16(silu_f(a0[2]) * v0[2], silu_f(a0[3]) * v0[3]);
                  w.z = cvt_pk_bf16(silu_f(a1[0]) * v1[0], silu_f(a1[1]) * v1[1]); w.w = cvt_pk_bf16(silu_f(a1[2]) * v1[2], silu_f(a1[3]) * v1[3]); }
                const bool skip = (g == 0) && (m == 0) && (fr < 2) && (u.pm > 0);
                if (!skip) *(u32x4*)(ACT + (size_t)row * ff + j0) = w;
            }
        }
    }
};

template <class Epi, class Sched, bool ALIGN_EPI = false, bool SP2 = false>
__device__ __forceinline__ void gemm_phase(PG8_LAS unsigned char* lds, const Gemm g, const Sched& S, const Epi& E, int wid) {
    const int lane = lane_id(), tid = wid * 64 + lane, wr = wid >> 2, wc = wid & 3, fr = lane & 15, fq = lane >> 4;
    const int K = g.K, nt = K / BK;
    unsigned voffA[2], voffB[2];
#pragma unroll
    for (int i = 0; i < 2; ++i) { int R, C; stage_rc(tid * 16 + i * 8192, R, C); const int Rb = Epi::PERM ? ((R & ~31) + perm32(R & 31)) : R;
        voffA[i] = (unsigned)(R * K + C) * 2u; voffB[i] = (unsigned)(Rb * K + C) * 2u; }
    const size_t kstep = (size_t)(BK * 2);
    const size_t hstep = (size_t)HALF * K * 2;
    const size_t tstep = 2 * hstep;
    const unsigned ldsw = (unsigned)wid * 1024u;
    const int aoff = lds_byte(wr * 64 + fr, fq * 8), boff = lds_byte(wc * 32 + fr, fq * 8);
#define PG8_SA(b, h) (((b) * 2 + (h)) * HTB)
#define PG8_SB(b, h) ((4 + (b) * 2 + (h)) * HTB)
#define PG8_STAGE(bufoff, gbase, voff) do { _Pragma("unroll") for (int _i = 0; _i < 2; ++_i) \
        __builtin_amdgcn_global_load_lds((const unsigned*)((const char*)(gbase) + (voff)[_i]), (PG8_LAS unsigned*)(lds + (bufoff) + ldsw + _i * 8192), 16, 0, 0); } while (0)
#define PG8_LDA(dst, b, h) do { _Pragma("unroll") for (int m = 0; m < 4; ++m) _Pragma("unroll") for (int k = 0; k < 2; ++k) dst[m][k] = *(const PG8_LAS bf16x8*)(lds + PG8_SA(b, h) + aoff + m * 2048 + k * 1024); } while (0)
#define PG8_LDB(dst, b, h) do { _Pragma("unroll") for (int n = 0; n < 2; ++n) _Pragma("unroll") for (int k = 0; k < 2; ++k) dst[n][k] = *(const PG8_LAS bf16x8*)(lds + PG8_SB(b, h) + boff + n * 2048 + k * 1024); } while (0)
#define PG8_MMA(ai, bj, At, Bt) do { __builtin_amdgcn_s_setprio(1); _Pragma("unroll") for (int m = 0; m < 4; ++m) _Pragma("unroll") for (int n = 0; n < 2; ++n) _Pragma("unroll") for (int k = 0; k < 2; ++k) \
        acc[ai][bj][m][n] = __builtin_amdgcn_mfma_f32_16x16x32_bf16(Bt[n][k], At[m][k], acc[ai][bj][m][n], 0, 0, 0); __builtin_amdgcn_s_setprio(0); } while (0)
#define PG8_WAIT_V(n) asm volatile("s_waitcnt vmcnt(" #n ")" ::: "memory")
#define PG8_WAIT_L(n) asm volatile("s_waitcnt lgkmcnt(" #n ")" ::: "memory")
#define PG8_BAR __builtin_amdgcn_s_barrier()
#define PG8_SCHED __builtin_amdgcn_sched_barrier(0)
    Unit cur, nxt; int ui = 0;
    if (!S.next(0, cur)) return;
    f32x4 acc[2][2][4][2];
#pragma unroll
    for (int a = 0; a < 2; ++a)
#pragma unroll
        for (int b = 0; b < 2; ++b)
#pragma unroll
            for (int m = 0; m < 4; ++m)
#pragma unroll
                for (int n = 0; n < 2; ++n) acc[a][b][m][n] = (f32x4){0.f, 0.f, 0.f, 0.f};
    bf16x8 At[4][2], B0[2][2], B1[2][2];
    const char* cA = (const char*)g.A + (size_t)cur.pm * tstep; const char* cB = (const char*)g.Bt + (size_t)cur.pn * tstep;
    S.a_ready(cur);
    if constexpr (SP2) {
        PG8_STAGE(PG8_SB(0, 0), cB, voffB); PG8_STAGE(PG8_SB(0, 1), cB + hstep, voffB); PG8_STAGE(PG8_SA(0, 0), cA, voffA); PG8_STAGE(PG8_SA(0, 1), cA + hstep, voffA);
        if (wr == 1) PG8_BAR;
        PG8_WAIT_V(2); PG8_BAR;
        PG8_STAGE(PG8_SB(1, 0), cB + kstep, voffB); PG8_STAGE(PG8_SA(1, 0), cA + kstep, voffA); PG8_STAGE(PG8_SB(1, 1), cB + hstep + kstep, voffB);
        PG8_WAIT_V(6); PG8_BAR;
    } else {
        PG8_STAGE(PG8_SB(0, 0), cB, voffB); PG8_STAGE(PG8_SA(0, 0), cA, voffA); PG8_STAGE(PG8_SB(0, 1), cB + hstep, voffB); PG8_STAGE(PG8_SA(0, 1), cA + hstep, voffA);
        if (wr == 1) PG8_BAR;
        PG8_WAIT_V(4); PG8_BAR;
        PG8_STAGE(PG8_SB(1, 0), cB + kstep, voffB); PG8_STAGE(PG8_SA(1, 0), cA + kstep, voffA); PG8_STAGE(PG8_SB(1, 1), cB + hstep + kstep, voffB);
        PG8_WAIT_V(6); PG8_BAR;
    }
    for (;;) {
        const bool has_next = S.next(ui + 1, nxt);
        const char* nA = has_next ? (const char*)g.A + (size_t)nxt.pm * tstep : cA; const char* nB = has_next ? (const char*)g.Bt + (size_t)nxt.pn * tstep : cB;
        for (int t = 0; t < nt; t += 2) {
            const bool last = (t == nt - 2);
            const char* a1 = cA + (size_t)(t + 1) * kstep;
            const char* a2 = last ? nA : cA + (size_t)(t + 2) * kstep; const char* b2 = last ? nB : cB + (size_t)(t + 2) * kstep;
            const char* a3 = a2 + kstep; const char* b3 = b2 + kstep;
            if (last && has_next) S.a_ready(nxt);
            if constexpr (SP2) {
            PG8_LDB(B0, 0, 0); PG8_LDB(B1, 0, 1); PG8_SCHED; PG8_LDA(At, 0, 0); PG8_STAGE(PG8_SA(1, 1), a1 + hstep, voffA);
            PG8_WAIT_V(8); PG8_WAIT_L(0); PG8_BAR; PG8_MMA(0, 0, At, B0); PG8_MMA(0, 1, At, B1); PG8_BAR; PG8_SCHED;
            PG8_LDA(At, 0, 1); PG8_STAGE(PG8_SB(0, 0), b2, voffB); PG8_STAGE(PG8_SB(0, 1), b2 + hstep, voffB); PG8_STAGE(PG8_SA(0, 0), a2, voffA);
            PG8_WAIT_V(8); PG8_WAIT_L(0); PG8_BAR; PG8_MMA(1, 0, At, B0); PG8_MMA(1, 1, At, B1); PG8_BAR; PG8_SCHED;
            PG8_LDB(B0, 1, 0); PG8_LDB(B1, 1, 1); PG8_SCHED; PG8_LDA(At, 1, 0); PG8_STAGE(PG8_SA(0, 1), a2 + hstep, voffA);
            PG8_WAIT_V(8); PG8_WAIT_L(0); PG8_BAR; PG8_MMA(0, 0, At, B0); PG8_MMA(0, 1, At, B1); PG8_BAR; PG8_SCHED;
            PG8_LDA(At, 1, 1); PG8_STAGE(PG8_SB(1, 0), b3, voffB); PG8_STAGE(PG8_SB(1, 1), b3 + hstep, voffB); PG8_STAGE(PG8_SA(1, 0), a3, voffA);
            PG8_WAIT_V(8); PG8_WAIT_L(0); PG8_BAR; PG8_MMA(1, 0, At, B0); PG8_MMA(1, 1, At, B1); PG8_BAR; PG8_SCHED;
            } else {
            PG8_LDB(B0, 0, 0); PG8_SCHED; PG8_LDA(At, 0, 0); PG8_STAGE(PG8_SA(1, 1), a1 + hstep, voffA);
            PG8_WAIT_L(8); PG8_BAR; PG8_WAIT_L(0); PG8_MMA(0, 0, At, B0); PG8_BAR; PG8_SCHED;
            PG8_LDB(B1, 0, 1); PG8_STAGE(PG8_SB(0, 0), b2, voffB);
            PG8_BAR; PG8_WAIT_L(0); PG8_MMA(0, 1, At, B1); PG8_BAR;
            PG8_LDA(At, 0, 1); PG8_STAGE(PG8_SA(0, 0), a2, voffA);
            PG8_BAR; PG8_WAIT_L(0); PG8_MMA(1, 0, At, B0); PG8_BAR; PG8_SCHED;
            PG8_STAGE(PG8_SB(0, 1), b2 + hstep, voffB);
            PG8_WAIT_V(6); PG8_BAR; PG8_MMA(1, 1, At, B1); PG8_BAR;
            PG8_LDB(B0, 1, 0); PG8_SCHED; PG8_LDA(At, 1, 0); PG8_STAGE(PG8_SA(0, 1), a2 + hstep, voffA);
            PG8_WAIT_L(8); PG8_BAR; PG8_WAIT_L(0); PG8_MMA(0, 0, At, B0); PG8_BAR; PG8_SCHED;
            PG8_LDB(B1, 1, 1); PG8_STAGE(PG8_SB(1, 0), b3, voffB);
            PG8_BAR; PG8_WAIT_L(0); PG8_MMA(0, 1, At, B1); PG8_BAR;
            PG8_LDA(At, 1, 1); PG8_STAGE(PG8_SA(1, 0), a3, voffA);
            PG8_BAR; PG8_WAIT_L(0); PG8_MMA(1, 0, At, B0); PG8_BAR; PG8_SCHED;
            PG8_STAGE(PG8_SB(1, 1), b3 + hstep, voffB);
            PG8_WAIT_V(6); PG8_BAR; PG8_MMA(1, 1, At, B1); PG8_BAR;
            }
        }
        if constexpr (ALIGN_EPI) { if (wr == 0) PG8_BAR; }
        if constexpr (!Epi::AFTER_DRAIN) { E(acc, cur, wr, wc, fr, fq); S.done(cur); }
        if (!has_next) break;
#pragma unroll
        for (int a = 0; a < 2; ++a)
#pragma unroll
            for (int b = 0; b < 2; ++b)
#pragma unroll
                for (int m = 0; m < 4; ++m)
#pragma unroll
                    for (int n = 0; n < 2; ++n) acc[a][b][m][n] = (f32x4){0.f, 0.f, 0.f, 0.f};
        cur = nxt; cA = nA; cB = nB; ++ui;
        if constexpr (ALIGN_EPI) { if (wr == 1) PG8_BAR; }
    }
    PG8_WAIT_V(0);
    if constexpr (!ALIGN_EPI) { if (wr == 0) PG8_BAR; }
    PG8_BAR;
    if constexpr (Epi::AFTER_DRAIN) { E.fused(acc, cur, wr, wc, fr, fq, lds, wid, lane); S.done(cur); }
#undef PG8_SA
#undef PG8_SB
#undef PG8_STAGE
#undef PG8_LDA
#undef PG8_LDB
#undef PG8_MMA
#undef PG8_WAIT_V
#undef PG8_WAIT_L
#undef PG8_BAR
#undef PG8_SCHED
}
}


#define GAS __attribute__((address_space(1)))
#define LAS __attribute__((address_space(3)))
typedef unsigned short bf16;
typedef unsigned v4u __attribute__((ext_vector_type(4)));
typedef float f32x4 __attribute__((ext_vector_type(4)));
typedef short bf16x8 __attribute__((ext_vector_type(8)));
typedef GAS unsigned gu32;
typedef GAS unsigned long long gu64;
#define RLX_AGENT __ATOMIC_RELAXED, __HIP_MEMORY_SCOPE_AGENT
#define LDS_WAIT() asm volatile("s_waitcnt lgkmcnt(0)" ::: "memory")
#define VM_WAIT() asm volatile("s_waitcnt vmcnt(0)" ::: "memory")
__device__ __forceinline__ unsigned long long rt() { return __builtin_amdgcn_s_memrealtime(); }
__device__ __forceinline__ unsigned f2bf(float f) { unsigned u = __builtin_bit_cast(unsigned, f); return (u + 0x7fffu + ((u >> 16) & 1u)) >> 16; }
__device__ __forceinline__ unsigned pk2(float lo, float hi) { return f2bf(lo) | (f2bf(hi) << 16); }

#define XB_TMO      128
#define XB_XCNT(j)  (256  + 64 * (j))
#define XB_XSUB(j)  (1280 + 64 * (j))
#define XB_XGEN(j)  (2304 + 64 * (j))
#define XB_TOP      3328
#define XB_TOPGEN   3392
#define XCD_BAR_WORDS 3456
#define XB_SPIN_CAP (1u << 18)

__device__ __forceinline__ unsigned xb_ld(unsigned* p)              { return __hip_atomic_load(p, __ATOMIC_RELAXED, __HIP_MEMORY_SCOPE_AGENT); }
__device__ __forceinline__ unsigned xb_add(unsigned* p, unsigned v) { return __hip_atomic_fetch_add(p, v, __ATOMIC_RELAXED, __HIP_MEMORY_SCOPE_AGENT); }
__device__ __forceinline__ unsigned xb_xcc_id() { return (unsigned)__builtin_amdgcn_s_getreg((3 << 11) | 20) & 0xFu; }
#define XB_SPIN(cond, bar) do { unsigned _sp = 0; while (cond) { __builtin_amdgcn_s_sleep(1); \
    if ((++_sp & 255u) == 0u) { if (xb_ld(&(bar)[XB_TMO])) break; if (_sp > XB_SPIN_CAP) { atomicAdd(&(bar)[XB_TMO], 1u); break; } } } } while (0)

struct XcdBarrier {
    unsigned* bar; unsigned x;
    volatile LAS unsigned* st;
};

__device__ __forceinline__ XcdBarrier xcd_barrier_post(unsigned* bar, volatile LAS unsigned* st) {
    XcdBarrier b; b.bar = bar; b.x = xb_xcc_id(); b.st = st;
    if (threadIdx.x == 0) (void)xb_add(&bar[XB_XCNT(b.x)], 1u);
    return b;
}
__device__ __forceinline__ void xcd_barrier_complete(unsigned* bar, unsigned x, unsigned& nloc, unsigned& nx) {
    const unsigned G = gridDim.x * gridDim.y * gridDim.z;
    unsigned sum, cnt, mine, sp = 0u;
    for (;;) {
        sum = 0u; cnt = 0u; mine = 0u;
#pragma unroll
        for (unsigned j = 0; j < 16; ++j) { const unsigned c = xb_ld(&bar[XB_XCNT(j)]); sum += c; cnt += (c > 0u) ? 1u : 0u; mine = (j == x) ? c : mine; }
        if (sum == G) break;
        __builtin_amdgcn_s_sleep(1);
        if ((++sp & 255u) == 0u) { if (xb_ld(&bar[XB_TMO])) break; if (sp > XB_SPIN_CAP) { atomicAdd(&bar[XB_TMO], 1u); break; } }
    }
    nloc = mine > 0u ? mine : 1u; nx = cnt > 0u ? cnt : 1u;
}

__device__ __forceinline__ void xcd_barrier(const XcdBarrier& b) {
    asm volatile("s_waitcnt vmcnt(0)" ::: "memory");
    __syncthreads();
    if (threadIdx.x == 0) {
        unsigned* bar = b.bar;
        __builtin_amdgcn_s_waitcnt(0);
        unsigned nloc = b.st[0], nx = b.st[1];
        if (nloc == 0u) { xcd_barrier_complete(bar, b.x, nloc, nx); b.st[0] = nloc; b.st[1] = nx; }
        const unsigned old = xb_add(&bar[XB_XSUB(b.x)], 1u);
        const unsigned gen = old / nloc;
        if (old + 1u == (gen + 1u) * nloc) {
            __builtin_amdgcn_fence(__ATOMIC_RELEASE, "agent");
            asm volatile("s_waitcnt vmcnt(0)" ::: "memory");
            const unsigned og = xb_add(&bar[XB_TOP], 1u);
            const unsigned tg = og / nx;
            if (og + 1u == (tg + 1u) * nx) xb_add(&bar[XB_TOPGEN], 1u);
            else XB_SPIN(xb_ld(&bar[XB_TOPGEN]) == tg, bar);
            __builtin_amdgcn_fence(__ATOMIC_ACQUIRE, "agent");
            xb_add(&bar[XB_XGEN(b.x)], 1u);
            asm volatile("s_waitcnt vmcnt(0)" ::: "memory");
        } else {
            XB_SPIN(xb_ld(&bar[XB_XGEN(b.x)]) == gen, bar);
            __builtin_amdgcn_fence(__ATOMIC_ACQUIRE, "agent");
            asm volatile("s_waitcnt vmcnt(0)" ::: "memory");
        }
    }
    __syncthreads();
}


constexpr size_t MiB = 1u << 20;
constexpr size_t WS_CTL = 0, CTL_ZERO_BYTES = 32 * 1024;
constexpr size_t WS_PART = 1 * MiB;
constexpr size_t WS_MOD = 3 * MiB, WS_LB = 3 * MiB + 128 * 1024;
constexpr size_t WS_LF = 4 * MiB, WS_CL = 5 * MiB, WS_BB = 6 * MiB;
constexpr size_t WS_DBT = 6 * MiB + 65536;
constexpr size_t WS_NRM = 7 * MiB;
constexpr size_t WS_WF = 8 * MiB;
constexpr size_t WS_WIN = 16 * MiB, WS_WO = 128 * MiB, WS_WUP = 160 * MiB, WS_WD = 332 * MiB;
constexpr size_t WS_H = 418 * MiB;
constexpr size_t WS_PROJ = 482 * MiB;
constexpr size_t WS_MIX = 706 * MiB;
constexpr size_t WS_D1 = 770 * MiB, WS_D2 = 834 * MiB;
constexpr size_t WS_HU = 898 * MiB, WS_HS = 1026 * MiB, WS_HD = 1090 * MiB;
constexpr size_t WS_UH = 898 * MiB;
constexpr size_t WS_ACT = 482 * MiB;
constexpr size_t WS_OFOX = 1100 * MiB, WS_OHG = 1164 * MiB, WS_END = 1228 * MiB;
constexpr int CW_BAR = 4096;
constexpr int CW_WD = 128;
constexpr int KSPLIT = 16;

constexpr int RING_BYTES = 133120  , LDSCTL_OFF = RING_BYTES, MISC_OFF = LDSCTL_OFF + 320, HALO_OFF = RING_BYTES + 1024  , LDS_BYTES = 147456;

enum { PC_PRO = 0, PC_MODR = 1, PC_NORM1 = 2, PC_CUM = 3, PC_GEMM1 = 4, PC_HGA = 5, PC_HGB = 6, PC_HGC = 7, PC_ATTN = 8, PC_GEMM2 = 9, PC_NORM2 = 10, PC_GEMM3 = 11, PC_CONV = 12, PC_GEMM4 = 13, PC_FNORM = 14, PC_N = 15 };

struct Args { const float* in[17]; float* out; unsigned char* ws; unsigned mask; unsigned pad; };

__device__ __forceinline__ float wave_sum(float v) {
#pragma unroll
    for (int o = 1; o < 64; o <<= 1) v += __shfl_xor(v, o);
    return v;
}
__device__ __forceinline__ float sigm_f(float z) { return __builtin_amdgcn_rcpf(1.0f + __builtin_amdgcn_exp2f(-LOG2E * z)); }
__device__ __forceinline__ float silu2_f(float z) { return z * sigm_f(z); }

#ifndef WD_PRO_KB
#define WD_PRO_KB 0
#endif
constexpr int WD_PRO_ITEMS = WD_PRO_KB * (D / 64), WD_DEFER_ITEMS = (FF / 64) * (D / 64) - WD_PRO_ITEMS;
struct TrItem { const float* src; bf16* dst; int ldw, ldt; int nt; };
__device__ __forceinline__ void tr_load(const TrItem& it, f32x4 (&r)[16], int lane) {
    const int a4 = (lane & 15) * 4, kr = lane >> 4;
#pragma unroll
#ifdef TRLOAD_PLAIN
    for (int i = 0; i < 16; ++i) r[i] = *((const GAS f32x4*)(it.src + (size_t)(4 * i + kr) * it.ldw + a4));
#else
    for (int i = 0; i < 16; ++i) r[i] = __builtin_nontemporal_load((const GAS f32x4*)(it.src + (size_t)(4 * i + kr) * it.ldw + a4));
#endif
}
__device__ __forceinline__ void tr_store(const TrItem& it, const f32x4 (&r)[16], LAS float* scr, int lane) {
    const int a4 = (lane & 15) * 4, kr = lane >> 4;
#pragma unroll
    for (int i = 0; i < 16; ++i) { LAS float* d = scr + (4 * i + kr) * 65 + a4; d[0] = r[i].x; d[1] = r[i].y; d[2] = r[i].z; d[3] = r[i].w; }
    LDS_WAIT(); asm volatile("" ::: "memory");
    const int c = lane & 7;
#pragma unroll
    for (int j = 0; j < 8; ++j) { const int n = (lane >> 3) + 8 * j; const LAS float* s = scr + (8 * c) * 65 + n;
        v4u o; o.x = pk2(s[0 * 65], s[1 * 65]); o.y = pk2(s[2 * 65], s[3 * 65]); o.z = pk2(s[4 * 65], s[5 * 65]); o.w = pk2(s[6 * 65], s[7 * 65]);
        GAS v4u* dp = (GAS v4u*)(it.dst + (size_t)n * it.ldt + 8 * c); if (it.nt) __builtin_nontemporal_store(o, dp); else *dp = o; }
    LDS_WAIT(); asm volatile("" ::: "memory");
}
__device__ __forceinline__ TrItem tr_mk(const float* W, int ldw, int c0, int k0, bf16* WT, int ldt, int drow0, int nt = 0) { TrItem t; t.src = W + (size_t)k0 * ldw + c0; t.dst = WT + (size_t)drow0 * ldt + k0; t.ldw = ldw; t.ldt = ldt; t.nt = nt; return t; }
__device__ __forceinline__ void tr_item(const float* W, int ldw, int c0, int k0, bf16* WT, int ldt, int drow0, LAS float* scr, int lane) {
    const TrItem t = tr_mk(W, ldw, c0, k0, WT, ldt, drow0); f32x4 r[16]; tr_load(t, r, lane); tr_store(t, r, scr, lane);
}
template <int PARTS>
__device__ __forceinline__ void ph_prologue(const Args* ka, LAS unsigned char* lds, int vcu, int G, int tid, int lane, int wave) {
    unsigned char* ws = ka->ws;
    const float* c = ka->in[1]; const float* w_ada = ka->in[2]; const float* w_in = ka->in[5]; const float* lbl = ka->in[7];
    const float* w_out = ka->in[10]; const float* w_up = ka->in[12]; const float* w_down = ka->in[15];
    LAS float* sc_ = (LAS float*)lds;
    for (int i = tid; i < D; i += 512) sc_[i] = silu2_f(c[i]);
    __syncthreads();
    float* part = (float*)(ws + WS_PART);
    constexpr int NCG = NMOD / 4, KROWS = D / KSPLIT, CG0 = (PARTS & 1) ? 0 : 2 * D / 4, CG1 = (PARTS & 2) ? NCG : 2 * D / 4, NCGP = CG1 - CG0;
    for (int it = vcu * 512 + tid; it < KSPLIT * NCGP; it += G * 512) {
        const int ks = it / NCGP, cg = CG0 + it % NCGP;
        const GAS f32x4* wp = (const GAS f32x4*)(w_ada + (size_t)(ks * KROWS) * NMOD) + cg;
        f32x4 acc = {0.f, 0.f, 0.f, 0.f};
#pragma unroll 8
        for (int k = 0; k < KROWS; ++k) { const f32x4 w = __builtin_nontemporal_load(wp + (size_t)k * NCG); acc += w * sc_[ks * KROWS + k]; }
        ((GAS f32x4*)(part + (size_t)ks * NMOD))[cg] = acc;
    }
    if constexpr (PARTS & 1) {
    float* lb = (float*)(ws + WS_LB);
    for (int i = vcu * 512 + tid; i < 2048; i += G * 512) lb[i] = 1.0f / (1.0f + __expf(-(lbl[i] - lbl[2048 + i])));
    bf16* WfT = (bf16*)(ws + WS_WF);
    for (int i = vcu * 512 + tid; i < 16 * D; i += G * 512) { const int k = i >> 4, n = i & 15; WfT[(size_t)n * D + k] = (bf16)f2bf(w_in[(size_t)k * INC + FOX_F0 + n]); }
    }
    __syncthreads();
    LAS float* scr = (LAS float*)(lds + wave * 16640);
    const int gw = vcu * 8 + wave, NGW = G * 8;
    constexpr int NB_A = FOX_F0 / 64, NB_B = (NPROJ - FOX_F0) / 64, NB_C = D / 64, NB_D = FF2 / 64, NB_E = D / 64;
    constexpr int I_A = 64 * NB_A, I_B = 64 * NB_B, I_C = 64 * NB_C, I_D = 64 * NB_D, I_E = WD_PRO_ITEMS  , NITEMS = I_A + I_B + I_C + I_D + I_E;
    bf16* WinT = (bf16*)(ws + WS_WIN); bf16* WoT = (bf16*)(ws + WS_WO); bf16* WupT = (bf16*)(ws + WS_WUP); bf16* WdT = (bf16*)(ws + WS_WD);
    auto decode = [&](int it) -> TrItem { int r = it;
        if (r < I_A) { const int kb = 8 * ((r >> 3) / NB_A) + (r & 7), nb = (r >> 3) % NB_A; return tr_mk(w_in, INC, 64 * nb, 64 * kb, WinT, D, 64 * nb); } r -= I_A;
        if (r < I_B) { const int kb = 8 * ((r >> 3) / NB_B) + (r & 7), nb = (r >> 3) % NB_B; return tr_mk(w_in, INC, HG_Q0 + 64 * nb, 64 * kb, WinT, D, FOX_F0 + 64 * nb); } r -= I_B;
        if (r < I_C) { const int kb = 8 * ((r >> 3) / NB_C) + (r & 7), nb = (r >> 3) % NB_C; return tr_mk(w_out, D, 64 * nb, 64 * kb, WoT, D, 64 * nb, 1); } r -= I_C;
        if (r < I_D) { const int kb = 8 * ((r >> 3) / NB_D) + (r & 7), nb = (r >> 3) % NB_D; const int c0 = 64 * nb, cc = c0 < FF ? c0 : c0 - FF; return tr_mk(w_up, FF2, c0, 64 * kb, WupT, D, 256 * (cc >> 7) + (c0 < FF ? 0 : 128) + (cc & 127), 1); } r -= I_D;
        { const int kb = r / NB_E, nb = r % NB_E; return tr_mk(w_down, D, 64 * nb, 64 * kb, WdT, FF, 64 * nb); } };
    f32x4 ra[16], rb[16];
    constexpr int IT0 = (PARTS & 1) ? 0 : I_A + I_B, IT1 = (PARTS & 2) ? NITEMS : I_A + I_B;
    static_assert(I_E == 0, "the w_down items sit behind the deferred ones");
    int it = IT0 + gw;
    if (it < IT1) { TrItem ta = decode(it); tr_load(ta, ra, lane);
        for (;;) {
            const int itb = it + NGW; const bool hb = itb < IT1; TrItem tb = ta; if (hb) { tb = decode(itb); tr_load(tb, rb, lane); }
            tr_store(ta, ra, scr, lane);
            if (!hb) break;
            const int itc = itb + NGW; const bool hc = itc < IT1; if (hc) { ta = decode(itc); tr_load(ta, ra, lane); }
            tr_store(tb, rb, scr, lane);
            if (!hc) break;
            it = itc;
        }
    }
}
__device__ __forceinline__ void ph_convert_wd(const Args* ka, LAS unsigned char* lds, int rank, int nrank, int wave) {
    const int lane = lane_id(); const float* w_down = ka->in[15]; bf16* WdT = (bf16*)(ka->ws + WS_WD);
    LAS float* scr = (LAS float*)(lds + wave * 16640);
    for (int r0 = rank * 8 + wave; r0 < WD_DEFER_ITEMS; r0 += nrank * 8) { const int r = r0 + WD_PRO_ITEMS, kb = r / (D / 64), nb = r % (D / 64); tr_item(w_down, D, 64 * nb, 64 * kb, WdT, FF, 64 * nb, scr, lane); }
}
__device__ __forceinline__ void ph_convert_wd_dyn(const Args* ka, LAS unsigned char* lds, int wave) {
    const int lane = lane_id(); const float* w_down = ka->in[15]; bf16* WdT = (bf16*)(ka->ws + WS_WD);
    unsigned* ctr = (unsigned*)(ka->ws + WS_CTL) + CW_WD;
    LAS float* scr = (LAS float*)(lds + wave * 16640);
#ifndef WD_CHUNK
#define WD_CHUNK 8
#endif
    int cur = 0, end = 0;
    auto next = [&]() -> int { if (cur == end) { unsigned v = 0u; if (lane == 0) v = xb_add(ctr, 1u); cur = (int)__builtin_amdgcn_readfirstlane(v) * WD_CHUNK; end = cur + WD_CHUNK; } return cur++; };
    auto mk = [&](int r0) -> TrItem { const int r = r0 + WD_PRO_ITEMS, kb = r / (D / 64), nb = r % (D / 64); return tr_mk(w_down, D, 64 * nb, 64 * kb, WdT, FF, 64 * nb); };
    static_assert(WD_DEFER_ITEMS % WD_CHUNK == 0, "whole chunks");
    f32x4 ra[16], rb[16];
    const int ia = next();
    if (ia >= WD_DEFER_ITEMS) return;
    TrItem ta = mk(ia); tr_load(ta, ra, lane);
    for (;;) {
        const int ib = next(); const bool hb = ib < WD_DEFER_ITEMS; TrItem tb = ta; if (hb) { tb = mk(ib); tr_load(tb, rb, lane); }
        tr_store(ta, ra, scr, lane);
        if (!hb) break;
        const int ic = next(); const bool hc = ic < WD_DEFER_ITEMS; if (hc) { ta = mk(ic); tr_load(ta, ra, lane); }
        tr_store(tb, rb, scr, lane);
        if (!hc) break;
    }
}
__device__ __forceinline__ void ph_modreduce(const Args* ka, int i0, int vcu, int G, int tid) {
    const float* part = (const float*)(ka->ws + WS_PART); const float* b = ka->in[3]; float* mod = (float*)(ka->ws + WS_MOD);
    for (int i = i0 + vcu * 512 + tid; i < NMOD; i += G * 512) { float s = b[i];
#pragma unroll
        for (int ks = 0; ks < KSPLIT; ++ks) s += part[(size_t)ks * NMOD + i];
        mod[i] = s; }
}
template <bool FGATE>
__device__ __forceinline__ void ph_norm(const float* x, const bf16* d1, const float* g, const float* sh, const float* sc, bf16* H, const bf16* WfT, const float* bfox, float* lf, float* modout, int modn,
                                        LAS unsigned char* lds, int vcu, int G, int tid, int lane, int wave) {
    LAS float* A_ = (LAS float*)lds; LAS float* B_ = A_ + D;
    if constexpr (FGATE) {
        const float* part = sh; const float* bada = sc;
#ifndef RED_REP
#define RED_REP 1
#endif
#ifndef FG_REP
#define FG_REP 1
#endif
        for (int rr_ = 0; rr_ < RED_REP; ++rr_)
        for (int i4 = tid; i4 < D / 4; i4 += 512) { f32x4 s0 = *(const GAS f32x4*)(bada + 4 * i4), s1 = *(const GAS f32x4*)(bada + D + 4 * i4);
#pragma unroll
            for (int ks = 0; ks < KSPLIT; ++ks) { s0 += *(const GAS f32x4*)(part + (size_t)ks * NMOD + 4 * i4); s1 += *(const GAS f32x4*)(part + (size_t)ks * NMOD + D + 4 * i4); }
            const f32x4 gv = *(const GAS f32x4*)(g + 4 * i4);
            *(LAS f32x4*)(A_ + 4 * i4) = gv * (s1 + 1.0f); *(LAS f32x4*)(B_ + 4 * i4) = s0; }
        const int nred = modn, per = (nred + G - 1) / G, iend = (vcu + 1) * per < nred ? (vcu + 1) * per : nred;
        for (int i = vcu * per + tid; i < iend; i += 512) { float s = bada[i];
#pragma unroll
            for (int ks = 0; ks < KSPLIT; ++ks) s += part[(size_t)ks * NMOD + i];
            modout[i] = s; }
    } else {
        for (int i = tid; i < D; i += 512) { A_[i] = g[i] * (1.0f + sc[i]); B_[i] = sh[i]; }
    }
    __syncthreads();
    for (int blk = vcu; blk < T / 32; blk += G) {
        const int row0 = blk * 32;
#pragma unroll 1
        for (int j = 0; j < 4; ++j) {
            const int row = row0 + wave * 4 + j;
            const GAS f32x4* xr = (const GAS f32x4*)(x + (size_t)row * D) + lane;
            f32x4 v[16]; float s = 0.f;
#pragma unroll
            for (int jj = 0; jj < 16; ++jj) { v[jj] = __builtin_nontemporal_load(xr + 64 * jj);
                if constexpr (!FGATE) { const unsigned long long dw = ((const GAS unsigned long long*)(d1 + (size_t)row * D) + lane)[64 * jj]; const unsigned w0 = (unsigned)dw, w1 = (unsigned)(dw >> 32);
                    v[jj].x += __uint_as_float(w0 << 16); v[jj].y += __uint_as_float(w0 & 0xffff0000u); v[jj].z += __uint_as_float(w1 << 16); v[jj].w += __uint_as_float(w1 & 0xffff0000u); }
                s += (v[jj].x * v[jj].x + v[jj].y * v[jj].y) + (v[jj].z * v[jj].z + v[jj].w * v[jj].w); }
            const float r = 1.0f / sqrtf(wave_sum(s) * (1.0f / D) + EPS);
            GAS unsigned long long* o8 = (GAS unsigned long long*)(H + (size_t)row * D) + lane;
#pragma unroll
            for (int jj = 0; jj < 16; ++jj) { const f32x4 av = *(const LAS f32x4*)(A_ + 4 * (lane + 64 * jj)), bv = *(const LAS f32x4*)(B_ + 4 * (lane + 64 * jj));
                const f32x4 hv = v[jj] * r * av + bv;
                o8[64 * jj] = (unsigned long long)pk2(hv.x, hv.y) | ((unsigned long long)pk2(hv.z, hv.w) << 32); }
        }
        if constexpr (FGATE) for (int fr_ = 0; fr_ < FG_REP; ++fr_) {
            __syncthreads();
            const int g_ = wave >> 2, kq = wave & 3; f32x4 acc = {0.f, 0.f, 0.f, 0.f};
            const bf16* ap = H + (size_t)(row0 + 16 * g_ + (lane & 15)) * D + kq * 1024 + (lane >> 4) * 8;
            const bf16* bp = WfT + (size_t)(lane & 15) * D + kq * 1024 + (lane >> 4) * 8;
#pragma unroll 16
            for (int s = 0; s < 32; ++s) { const bf16x8 av = *(const GAS bf16x8*)(ap + 32 * s), bv = *(const GAS bf16x8*)(bp + 32 * s); acc = __builtin_amdgcn_mfma_f32_16x16x32_bf16(av, bv, acc, 0, 0, 0); }
            LAS f32x4* red = (LAS f32x4*)(lds + 32768);
            red[wave * 64 + lane] = acc;
            __syncthreads();
            if (kq == 0) { const f32x4 t = (red[(g_ * 4 + 0) * 64 + lane] + red[(g_ * 4 + 1) * 64 + lane]) + (red[(g_ * 4 + 2) * 64 + lane] + red[(g_ * 4 + 3) * 64 + lane]);
                const int head = lane & 15; const float bias = bfox[head];
#pragma unroll
                for (int e = 0; e < 4; ++e) { const float z = t[e] + bias; lf[(size_t)head * T + row0 + 16 * g_ + (lane >> 4) * 4 + e] = fminf(z, 0.f) - log1pf(__expf(-fabsf(z))); } }
            __syncthreads();
        }
    }
}
__device__ __forceinline__ void ph_cum(const Args* ka, LAS unsigned char* lds, int vcu, int tid, int lane) {
    if (vcu >= NH) return;
    const int h = vcu; const float* lf = (const float*)(ka->ws + WS_LF) + (size_t)h * T + tid * 16; float* cl = (float*)(ka->ws + WS_CL) + (size_t)h * T + tid * 16;
    double* Bb = (double*)(ka->ws + WS_BB) + h * 32;
    float v[16];
#pragma unroll
    for (int q = 0; q < 4; ++q) { const f32x4 t = ((const GAS f32x4*)lf)[q]; v[4 * q] = t.x; v[4 * q + 1] = t.y; v[4 * q + 2] = t.z; v[4 * q + 3] = t.w; }
    float run = 0.f;
#pragma unroll
    for (int j = 0; j < 16; ++j) { run += v[j] * LOG2E; v[j] = run; }
    float s = run;
#pragma unroll
    for (int d = 1; d < 16; d <<= 1) { const float y = __shfl_up(s, d, 16); if ((lane & 15) >= d) s += y; }
    const float excl = s - run;
#pragma unroll
    for (int q = 0; q < 4; ++q) ((GAS f32x4*)cl)[q] = (f32x4){-(v[4 * q] + excl), -(v[4 * q + 1] + excl), -(v[4 * q + 2] + excl), -(v[4 * q + 3] + excl)};
    LAS double* bt = (LAS double*)lds;
    if ((lane & 15) == 15) bt[tid >> 4] = (double)s;
    __syncthreads();
    if (tid == 0) { double c = 0.0; for (int b = 0; b < 32; ++b) { Bb[b] = c; c += bt[b]; } }
    __syncthreads();
    if (tid < 32) { double c = 0.0; for (int b = 0; b < tid; ++b) c += bt[b]; bt[32 + tid] = c; }
    __syncthreads();
    { float* dBt = (float*)(ka->ws + WS_DBT) + h * 1024;
      for (int e = tid; e < 1024; e += 512) dBt[e] = (float)(bt[32 + (e >> 5)] - bt[32 + (e & 31)]); }
    __syncthreads();
}
__device__ __forceinline__ void ph_convfix(const Args* ka, int vcu, int G, int tid) {
    const float* UH = (const float*)(ka->ws + WS_UH); bf16* ACT = (bf16*)(ka->ws + WS_ACT); const float* cw = ka->in[13]; const float* cb = ka->in[14];
    constexpr int NCG = FF / 4, NIT = 31 * NCG;
    for (int it = vcu * 512 + tid; it < NIT; it += G * 512) {
        const int pm = 1 + it / NCG, j0 = (it % NCG) * 4;
        f32x4 act[2];
        f32x4 ua[4], uv[4];
#pragma unroll
        for (int q = 0; q < 4; ++q) { const size_t rowoff = (size_t)((q < 2 ? (pm - 1) * 4 + 2 + q : pm * 4 + (q - 2))) * FF2;
            ua[q] = *(const GAS f32x4*)(UH + rowoff + j0); uv[q] = *(const GAS f32x4*)(UH + rowoff + FF + j0); }
        f32x4 wa[3], wv[3];
#pragma unroll
        for (int tp = 0; tp < 3; ++tp) { wa[tp] = *(const GAS f32x4*)(cw + (size_t)tp * FF2 + j0); wv[tp] = *(const GAS f32x4*)(cw + (size_t)tp * FF2 + FF + j0); }
        const f32x4 ba = *(const GAS f32x4*)(cb + j0), bv = *(const GAS f32x4*)(cb + FF + j0);
#pragma unroll
        for (int rr = 0; rr < 2; ++rr) { const f32x4 ya = ba + wa[0] * ua[rr] + wa[1] * ua[rr + 1] + wa[2] * ua[rr + 2], yv = bv + wv[0] * uv[rr] + wv[1] * uv[rr + 1] + wv[2] * uv[rr + 2];
            act[rr] = (f32x4){silu2_f(ya.x) * yv.x, silu2_f(ya.y) * yv.y, silu2_f(ya.z) * yv.z, silu2_f(ya.w) * yv.w};
            *(GAS unsigned long long*)(ACT + (size_t)(pm * 256 + rr) * FF + j0) = (unsigned long long)pk2(act[rr].x, act[rr].y) | ((unsigned long long)pk2(act[rr].z, act[rr].w) << 32); }
    }
}
__device__ __forceinline__ void ph_fnorm(const float* x, const bf16* d1, const bf16* d2, float* out, const float* g, int vcu, int G, int lane, int wave) {
    const int gw = vcu * 8 + wave, NGW = G * 8;
    for (int row = gw; row < T; row += NGW) {
        const GAS f32x4* xr = (const GAS f32x4*)(x + (size_t)row * D) + lane;
        const GAS unsigned long long* p1 = (const GAS unsigned long long*)(d1 + (size_t)row * D) + lane; const GAS unsigned long long* p2 = (const GAS unsigned long long*)(d2 + (size_t)row * D) + lane;
        f32x4 v[16]; float s = 0.f;
#pragma unroll
        for (int jj = 0; jj < 16; ++jj) { v[jj] = __builtin_nontemporal_load(xr + 64 * jj); const unsigned long long a1 = __builtin_nontemporal_load(p1 + 64 * jj), a2 = __builtin_nontemporal_load(p2 + 64 * jj);
            const unsigned w0 = (unsigned)a1, w1 = (unsigned)(a1 >> 32), y0 = (unsigned)a2, y1 = (unsigned)(a2 >> 32);
            v[jj].x += __uint_as_float(w0 << 16) + __uint_as_float(y0 << 16); v[jj].y += __uint_as_float(w0 & 0xffff0000u) + __uint_as_float(y0 & 0xffff0000u);
            v[jj].z += __uint_as_float(w1 << 16) + __uint_as_float(y1 << 16); v[jj].w += __uint_as_float(w1 & 0xffff0000u) + __uint_as_float(y1 & 0xffff0000u);
            s += (v[jj].x * v[jj].x + v[jj].y * v[jj].y) + (v[jj].z * v[jj].z + v[jj].w * v[jj].w); }
        const float r = 1.0f / sqrtf(wave_sum(s) * (1.0f / D) + EPS);
        GAS f32x4* orow = (GAS f32x4*)(out + (size_t)row * D) + lane;
#pragma unroll
        for (int jj = 0; jj < 16; ++jj) { const f32x4 gv = *(const GAS f32x4*)(g + 4 * (lane + 64 * jj)); __builtin_nontemporal_store(v[jj] * r * gv, orow + 64 * jj); }
    }
}

namespace fa {
typedef short bf16x8 __attribute__((ext_vector_type(8)));
typedef short s16x4 __attribute__((ext_vector_type(4)));
typedef float f32x16 __attribute__((ext_vector_type(16)));
typedef float f32x4 __attribute__((ext_vector_type(4)));
typedef unsigned u32x4 __attribute__((ext_vector_type(4)));
constexpr int NW = 8, QBLK = 32, KVBLK = 64, QB = NW * QBLK, DH = 128;
constexpr int SHM_V = KVBLK * DH * 2, SHM_K = KVBLK * DH * 2;
constexpr int LDS_BYTES = 2 * SHM_V + 2 * SHM_K + NW * 64 * 4;
constexpr float THR2 = 11.5f;
#define KSWZ(row, colB) ((row) * 256 + ((colB) ^ (((row) & 7) << 4)))
#define SBAR() __builtin_amdgcn_sched_barrier(0)
__device__ __forceinline__ int v_st(int k, int c) { const int kk = (k & ~0xC) | ((k & 4) << 1) | ((k & 8) >> 1); return ((kk >> 3) * 4 + (c >> 5)) * 512 + ((kk & 7) * 32 + (c & 31)) * 2; }
__device__ __forceinline__ int v_rd_base(int lane) { return ((lane & 3) << 3) | (((lane >> 2) & 3) << 6) | (((lane >> 4) & 1) << 5) | (((lane >> 5) & 1) << 8); }
constexpr int v_rd_off(int d0, int ks, int half) { return d0 * 512 + ks * 4096 + half * 2048; }
__device__ __forceinline__ int crow(int r, int hi) { return (r & 3) + 8 * (r >> 2) + 4 * hi; }
__device__ __forceinline__ unsigned cvtpk(float lo, float hi) { unsigned r; asm volatile("v_cvt_pk_bf16_f32 %0, %1, %2" : "=v"(r) : "v"(lo), "v"(hi)); return r; }
template <int M> __device__ __forceinline__ float swz_xor(float v) { return __int_as_float(__builtin_amdgcn_ds_swizzle(__float_as_int(v), 0x1F | (M << 10))); }
__device__ __forceinline__ bf16x8 load8(const bf16* p) { return *reinterpret_cast<const bf16x8*>(p); }
__device__ __forceinline__ void mask_tile(f32x16& p0, f32x16& p1, int dq) {
    const float NEG = -__builtin_inff();
#pragma unroll
    for (int r = 0; r < 16; ++r) { const int c = (r & 3) + 8 * (r >> 2); if (dq - c < 0) p0[r] = NEG; if (dq - c - 32 < 0) p1[r] = NEG; }
}
__device__ __forceinline__ void partialSM(f32x16& p0, f32x16& p1, float& m_reg, float& mn, float& alpha, float dB) {
    float pmax = p0[0]; for (int r = 1; r < 16; ++r) pmax = fmaxf(pmax, p0[r]); for (int r = 0; r < 16; ++r) pmax = fmaxf(pmax, p1[r]);
    { auto rr = __builtin_amdgcn_permlane32_swap(__float_as_uint(pmax), __float_as_uint(pmax), false, false);
      pmax = fmaxf(__uint_as_float(rr[0]), __uint_as_float(rr[1])); }
    const float pm = pmax + dB;
    if (__builtin_expect(__all(pm - m_reg <= THR2), 1)) { mn = m_reg; alpha = 1.f; }
    else { mn = fmaxf(m_reg, pm); alpha = __builtin_amdgcn_exp2f(m_reg - mn); m_reg = mn; }
    const float sub = mn - dB;
    for (int r = 0; r < 16; ++r) p0[r] = p0[r] - sub; for (int r = 0; r < 16; ++r) p1[r] = p1[r] - sub;
    for (int r = 0; r < 16; ++r) p0[r] = __builtin_amdgcn_exp2f(p0[r]);
}
__device__ __forceinline__ void finishSM(f32x16& p0, f32x16& p1, float alpha, float& l_reg, bf16x8& pa0, bf16x8& pa1, bf16x8& pa2, bf16x8& pa3) {
    for (int r = 0; r < 16; ++r) p1[r] = __builtin_amdgcn_exp2f(p1[r]);
    float ps = 0; for (int r = 0; r < 16; ++r) ps += p0[r]; for (int r = 0; r < 16; ++r) ps += p1[r];
    { auto rr = __builtin_amdgcn_permlane32_swap(__float_as_uint(ps), __float_as_uint(ps), false, false);
      ps = __uint_as_float(rr[0]) + __uint_as_float(rr[1]); }
    l_reg = l_reg * alpha + ps;
#define PK4(P, B_, OUT) do { unsigned a0 = cvtpk(P[B_+0], P[B_+1]), a1 = cvtpk(P[B_+2], P[B_+3]);                          \
        unsigned b0 = cvtpk(P[B_+4], P[B_+5]), b1 = cvtpk(P[B_+6], P[B_+7]);                                             \
        auto r0 = __builtin_amdgcn_permlane32_swap(a0, b0, false, false); auto r1 = __builtin_amdgcn_permlane32_swap(a1, b1, false, false); \
        u32x4 w = {r0[0], r1[0], r0[1], r1[1]}; OUT = *reinterpret_cast<bf16x8*>(&w); } while (0)
    PK4(p0, 0, pa0); PK4(p0, 8, pa1); PK4(p1, 0, pa2); PK4(p1, 8, pa3);
#undef PK4
}
template <int KB>
__device__ __forceinline__ void qkt(f32x16& p0, f32x16& p1, const char* K_lds, int r32, int hi, const bf16x8* qr) {
    const char* kb[4];
#pragma unroll
    for (int dd = 0; dd < 4; ++dd) kb[dd] = K_lds + KB * SHM_K + KSWZ(r32, (dd * 16 + hi * 8) * 2);
#pragma unroll
    for (int d0 = 0; d0 < 8; ++d0) { const char* a = kb[d0 & 3] + (d0 >> 2) * 128;
        bf16x8 b0 = *reinterpret_cast<const bf16x8*>(a);
        bf16x8 b1 = *reinterpret_cast<const bf16x8*>(a + 32 * 256);
        p0 = __builtin_amdgcn_mfma_f32_32x32x16_bf16(b0, qr[d0], p0, 0, 0, 0);
        p1 = __builtin_amdgcn_mfma_f32_32x32x16_bf16(b1, qr[d0], p1, 0, 0, 0); }
}
template <int VB>
__device__ __forceinline__ void pv_tile(f32x16* o, int vb0, bf16x8 pa0, bf16x8 pa1, bf16x8 pa2, bf16x8 pa3) {
#define TRRD(dst, off) asm volatile("ds_read_b64_tr_b16 %0, %1 offset:%2" : "=&v"(dst) : "v"(vb0), "i"(off) : "memory")
#define PV_D0(d0) do { s16x4 l0, l1, l2, l3, h0, h1, h2, h3; constexpr int b_ = VB * SHM_V + v_rd_off(d0, 0, 0);   \
        TRRD(l0, b_); TRRD(h0, b_ + 2048); TRRD(l1, b_ + 4096); TRRD(h1, b_ + 6144); TRRD(l2, b_ + 8192); TRRD(h2, b_ + 10240); TRRD(l3, b_ + 12288); TRRD(h3, b_ + 14336); \
        asm volatile("s_waitcnt lgkmcnt(0)" ::: "memory"); SBAR();   \
        o[d0] = __builtin_amdgcn_mfma_f32_32x32x16_bf16(pa0, (bf16x8){l0[0], l0[1], l0[2], l0[3], h0[0], h0[1], h0[2], h0[3]}, o[d0], 0, 0, 0);   \
        o[d0] = __builtin_amdgcn_mfma_f32_32x32x16_bf16(pa1, (bf16x8){l1[0], l1[1], l1[2], l1[3], h1[0], h1[1], h1[2], h1[3]}, o[d0], 0, 0, 0);   \
        o[d0] = __builtin_amdgcn_mfma_f32_32x32x16_bf16(pa2, (bf16x8){l2[0], l2[1], l2[2], l2[3], h2[0], h2[1], h2[2], h2[3]}, o[d0], 0, 0, 0);   \
        o[d0] = __builtin_amdgcn_mfma_f32_32x32x16_bf16(pa3, (bf16x8){l3[0], l3[1], l3[2], l3[3], h3[0], h3[1], h3[2], h3[3]}, o[d0], 0, 0, 0); } while (0)
    PV_D0(0); PV_D0(1); PV_D0(2); PV_D0(3);
#undef PV_D0
#undef TRRD
}
typedef __amdgpu_buffer_rsrc_t rsrc_t;
__device__ __forceinline__ rsrc_t mk_rsrc(const void* p, unsigned bytes) { return __builtin_amdgcn_make_buffer_rsrc((void*)p, (short)0, (int)bytes, 0x00020000); }
__device__ __forceinline__ bf16x8 bload8(rsrc_t r, unsigned voff, unsigned soff) { const u32x4 w = __builtin_bit_cast(u32x4, __builtin_amdgcn_raw_buffer_load_b128(r, (int)voff, (int)soff, 0)); return __builtin_bit_cast(bf16x8, w); }
__device__ __forceinline__ f32x4 bloadf4(rsrc_t r, unsigned voff, unsigned soff) { return __builtin_bit_cast(f32x4, __builtin_amdgcn_raw_buffer_load_b128(r, (int)voff, (int)soff, 0)); }
struct AttnPtrs { rsrc_t rsP, rsN, rsG, rsM; const float* dBt; };
struct BlockRef { int h; int P0; int jlo; };
struct Seam { bf16x8 qr[8]; bf16x8 st_v0, st_v1, st_k0, st_k1; };
#define ROWS(typ, hh, k0, add) ((unsigned)((((typ) * NH + (hh)) * T + (k0) + (add)) * (DH * 2)))
#define VMW() asm volatile("s_waitcnt vmcnt(0)" ::: "memory")
#define VMWN(n) asm volatile("s_waitcnt vmcnt(%0)" :: "i"(n) : "memory")
#define SLOAD_H(hh, k0) do { S.st_v0 = bload8(P.rsP, stoff, ROWS(2, hh, k0, 0)); S.st_v1 = bload8(P.rsP, stoff, ROWS(2, hh, k0, 32));              \
                         S.st_k0 = bload8(P.rsP, stoff, ROWS(1, hh, k0, 0)); S.st_k1 = bload8(P.rsP, stoff, ROWS(1, hh, k0, 32)); } while (0)
#define SWRITE_HK(bf) do { *(bf16x8*)(K_lds + (bf) * SHM_K + kws) = S.st_k0; *(bf16x8*)(K_lds + (bf) * SHM_K + kws + 32 * 256) = S.st_k1; } while (0)
#define SWRITE_HV(bf) do { *(bf16x8*)(V_lds + (bf) * SHM_V + vst0) = S.st_v0; *(bf16x8*)(V_lds + (bf) * SHM_V + vst1) = S.st_v1; } while (0)
#define SWRITE_H(bf) do { SWRITE_HV(bf); SWRITE_HK(bf); } while (0)
__device__ __forceinline__ void fox_prime(const AttnPtrs& P, const BlockRef& cur, char* lds, Seam& S, int wid) {
    const int lane = lane_id(), tid = wid * 64 + lane, r32 = lane & 31, hi = lane >> 5;
    const unsigned stoff = (unsigned)(((tid >> 4) * DH + (tid & 15) * 8) * 2), qoff = (unsigned)((r32 * DH + hi * 8) * 2);
    const int sr = tid >> 4, sc = (tid & 15) * 8, kws = KSWZ(sr, sc * 2); char* K_lds = lds + 2 * SHM_V; (void)qoff;
    const int kb0 = cur.jlo * KVBLK;
    for (int d0 = 0; d0 < 8; ++d0) S.qr[d0] = bload8(P.rsP, qoff + d0 * 32, ROWS(0, cur.h, cur.P0 + wid * QBLK, 0));
    SLOAD_H(cur.h, kb0); VMW(); SWRITE_HK(0);
    __syncthreads();
}
__device__ __forceinline__ void fox_block(const AttnPtrs& P, const BlockRef& cur, const BlockRef& nxt, char* lds, Seam& S, int wid) {
    const int lane = lane_id(), tid = wid * 64 + lane, r32 = lane & 31, hi = lane >> 5;
    const unsigned stoff = (unsigned)(((tid >> 4) * DH + (tid & 15) * 8) * 2), qoff = (unsigned)((r32 * DH + hi * 8) * 2);
    const int j_lo = cur.jlo;
    const int j_hi = (cur.P0 + QB - 1) / KVBLK + 1;
    const int NT = j_hi - j_lo;
    const int kbn = nxt.jlo * KVBLK;
    const int qlo = cur.P0 + wid * QBLK, qm = qlo + r32 - 4 * hi;
    char* V_lds = lds; char* K_lds = lds + 2 * SHM_V;
    float* ws = (float*)(lds + 2 * SHM_V + 2 * SHM_K) + wid * 64; float* li_l = ws, * al_l = ws + 32;
    float m_reg = -1e30f, l_reg = 0; f32x16 o[4] = {};
    const int sr = tid >> 4, sc = (tid & 15) * 8, vst0 = v_st(sr, sc), vst1 = v_st(32 + sr, sc), kws = KSWZ(sr, sc * 2);
    const int vb0 = (int)(uintptr_t)V_lds + v_rd_base(lane);
    const float* dbrow = P.dBt + (cur.h * 32 + (cur.P0 >> 8)) * 32;
#define RESC(a) do { if (__any((a) < 1.f)) { if (hi == 0) al_l[r32] = (a); asm volatile("s_waitcnt lgkmcnt(0)" ::: "memory");              \
                     for (int d_ = 0; d_ < 4; ++d_) for (int r = 0; r < 16; ++r) o[d_][r] *= al_l[crow(r, hi)]; } } while (0)
#define KBASE(t) ((j_lo + (t)) * KVBLK)
#define DB(t) (__int_as_float(__builtin_amdgcn_readfirstlane(__float_as_int(dbrow[KBASE(t) >> 8]))))
#define MASKT(P0_, P1_, t) do { const int kb_ = KBASE(t); if (kb_ + KVBLK - 1 > qlo) mask_tile(P0_, P1_, qm - kb_); } while (0)
#define BIASLD(P0_, P1_, t) do { const unsigned so_ = (unsigned)((cur.h * T + KBASE(t)) * 4), vo_ = (unsigned)(hi * 16);                                             \
        _Pragma("unroll") for (int g_ = 0; g_ < 4; ++g_) { const f32x4 x_ = bloadf4(P.rsN, vo_ + 32 * g_, so_), y_ = bloadf4(P.rsN, vo_ + 128 + 32 * g_, so_);   \
            P0_[4 * g_] = x_.x; P0_[4 * g_ + 1] = x_.y; P0_[4 * g_ + 2] = x_.z; P0_[4 * g_ + 3] = x_.w; P1_[4 * g_] = y_.x; P1_[4 * g_ + 1] = y_.y; P1_[4 * g_ + 2] = y_.z; P1_[4 * g_ + 3] = y_.w; } } while (0)
    constexpr int NQL = 8;
#define SEAM_K0() do { VMWN(NQL); SWRITE_HK(0); SBAR(); } while (0)
    f32x16 pA0, pA1, pB0, pB1; float mnA, mnB, alA, alB; bf16x8 pa0, pa1, pa2, pa3;
    BIASLD(pA0, pA1, 0);
    SWRITE_HV(0); SBAR();
    SLOAD_H(cur.h, KBASE(1));
    SBAR(); qkt<0>(pA0, pA1, K_lds, r32, hi, S.qr);
    BIASLD(pB0, pB1, 1);
    MASKT(pA0, pA1, 0); partialSM(pA0, pA1, m_reg, mnA, alA, DB(0));
    VMW(); SWRITE_H(1);
    __syncthreads();
#define HALF_STEP(PX0, PX1, mnX, alX, PY0, PY1, alY, t, KB, VB, SB) do {                                                      \
        SBAR(); qkt<KB>(PX0, PX1, K_lds, r32, hi, S.qr);                                                                      \
        finishSM(PY0, PY1, alY, l_reg, pa0, pa1, pa2, pa3); SBAR();                                                           \
        if ((t) + 1 < NT) { BIASLD(PY0, PY1, (t) + 1); SLOAD_H(cur.h, KBASE((t) + 1)); SBAR(); }                              \
        pv_tile<VB>(o, vb0, pa0, pa1, pa2, pa3); MASKT(PX0, PX1, (t)); partialSM(PX0, PX1, m_reg, mnX, alX, DB(t));           \
        __syncthreads();                                                                                                      \
        if ((t) + 1 < NT) { VMW(); SWRITE_H(SB); }                                                                            \
        RESC(alX); __syncthreads(); } while (0)
    for (int t = 1; t + 1 < NT; t += 2) {
        HALF_STEP(pB0, pB1, mnB, alB, pA0, pA1, alA, t, 1, 0, 0);
        HALF_STEP(pA0, pA1, mnA, alA, pB0, pB1, alB, t + 1, 0, 1, 1);
    }
    const bool even = (NT & 1) == 0;
    if (even) { SBAR(); qkt<1>(pB0, pB1, K_lds, r32, hi, S.qr); SBAR(); }
    SLOAD_H(nxt.h, kbn); SBAR();
#pragma unroll
    for (int d0 = 0; d0 < 8; ++d0) S.qr[d0] = bload8(P.rsP, qoff + d0 * 32, ROWS(0, nxt.h, nxt.P0 + wid * QBLK, 0));
    SBAR();
    finishSM(pA0, pA1, alA, l_reg, pa0, pa1, pa2, pa3); SBAR();
    pv_tile<0>(o, vb0, pa0, pa1, pa2, pa3);
    if (even) { MASKT(pB0, pB1, NT - 1); partialSM(pB0, pB1, m_reg, mnB, alB, DB(NT - 1)); __syncthreads(); RESC(alB);
        finishSM(pB0, pB1, alB, l_reg, pa0, pa1, pa2, pa3); SBAR(); pv_tile<1>(o, vb0, pa0, pa1, pa2, pa3); }
    SBAR(); SEAM_K0();
    if (hi == 0) li_l[r32] = l_reg; asm volatile("s_waitcnt lgkmcnt(0)" ::: "memory");
    float rs[16];
#pragma unroll
    for (int r = 0; r < 16; ++r) { const float rl = __builtin_amdgcn_rcpf(li_l[crow(r, hi)]); float ss = 0.f;
#pragma unroll
        for (int d0 = 0; d0 < 4; ++d0) { o[d0][r] *= rl; ss += o[d0][r] * o[d0][r]; }
        rs[r] = ss; }
#pragma unroll
    for (int r = 0; r < 16; ++r) { rs[r] += swz_xor<1>(rs[r]); rs[r] += swz_xor<2>(rs[r]); rs[r] += swz_xor<4>(rs[r]); rs[r] += swz_xor<8>(rs[r]); rs[r] += swz_xor<16>(rs[r]); }
    float gv[4];
#pragma unroll
    for (int d0 = 0; d0 < 4; ++d0) gv[d0] = __builtin_bit_cast(float, __builtin_amdgcn_raw_buffer_load_b32(P.rsG, (int)(r32 * 4 + d0 * 128), (int)(cur.h * DH * 4), 0));
    const unsigned olane = (unsigned)((4 * hi * D + r32) * 2);
#pragma unroll
    for (int r = 0; r < 16; ++r) { const int orow_u = (r & 3) + 8 * (r >> 2); const float rn = 1.0f / sqrtf(rs[r] * (1.0f / 128.0f) + EPS);
#pragma unroll
        for (int d0 = 0; d0 < 4; ++d0) { const float v = o[d0][r] * rn * gv[d0]; const float vn = swz_xor<1>(v);
            if ((r32 & 1) == 0) __builtin_amdgcn_raw_buffer_store_b32(cvtpk(v, vn), P.rsM, (int)olane, (int)((((cur.P0 + wid * QBLK + orow_u) * D) + cur.h * DH + d0 * 32) * 2), 0); } }
    __syncthreads();
#undef RESC
#undef KBASE
#undef DB
#undef MASKT
#undef BIASLD
#undef SEAM_K0
#undef HALF_STEP
}
#undef ROWS
#undef VMW
#undef VMWN
#undef SLOAD_H
#undef SWRITE_HK
#undef SWRITE_HV
#undef SWRITE_H
}

constexpr float SKIPT = 64.0f;
__device__ __forceinline__ float nrm_of(const float* n4, int tile) { const f32x4 v = *(const GAS f32x4*)(n4 + 4 * tile); return sqrtf((v.x + v.y) + (v.z + v.w)); }
__device__ __forceinline__ int fox_jlo(const Args* ka, int h, int qb, int lane) {
    const float* nrm = (const float*)(ka->ws + WS_NRM); const float* ncl = (const float*)(ka->ws + WS_CL) + (size_t)h * T; const float* dbrow = (const float*)(ka->ws + WS_DBT) + (h * 32 + qb) * 32;
    const float* qn = nrm + (size_t)h * 128 * 4; const float* kn = nrm + (size_t)(16 + h) * 128 * 4;
    const float Qn = fmaxf(fmaxf(nrm_of(qn, 4 * qb), nrm_of(qn, 4 * qb + 1)), fmaxf(nrm_of(qn, 4 * qb + 2), nrm_of(qn, 4 * qb + 3)));
    const float Knb = fmaxf(fmaxf(nrm_of(kn, 4 * qb), nrm_of(kn, 4 * qb + 1)), fmaxf(nrm_of(kn, 4 * qb + 2), nrm_of(kn, 4 * qb + 3)));
    const float c0 = ncl[qb * 256];
    bool ns[2];
#pragma unroll
    for (int q = 0; q < 2; ++q) { const int j = lane + 64 * q; bool keep = true;
        if (j < 4 * qb) { const float bm = dbrow[j >> 2] - c0 + ncl[64 * j + 63]; const float bound = Qn * (nrm_of(kn, j) + Knb) + bm; keep = !(bound < -SKIPT); }
        ns[q] = keep; }
    const unsigned long long m0 = __ballot(ns[0]), m1 = __ballot(ns[1]);
    const int j0 = m0 ? (int)__builtin_ctzll(m0) : 64 + (int)__builtin_ctzll(m1);
    return __builtin_amdgcn_readfirstlane(j0 < 4 * qb ? j0 : 4 * qb);
}
__device__ __forceinline__ fa::BlockRef mk_ref(int item, int pass_, int L0, int jl0, int jl1) { const int x = item & 15, qb = pass_ ? 31 - x : x; fa::BlockRef r; r.h = item >> 4; r.P0 = qb * 256; r.jlo = item == L0 ? (pass_ ? jl1 : jl0) : 0; return r; }
__device__ __forceinline__ void ph_attn(const Args* ka, LAS unsigned char* lds_las, int vcu, int G, int wave) {
    char* lds = (char*)lds_las;
    unsigned char* ws = ka->ws;
    fa::AttnPtrs P; P.rsP = fa::mk_rsrc(ws + WS_PROJ, (unsigned)(3 * HEADBUF * 2)); P.rsN = fa::mk_rsrc(ws + WS_CL, (unsigned)(NH * T * 4)); P.rsG = fa::mk_rsrc(ka->in[8], 2048u * 4u);
    P.rsM = fa::mk_rsrc(ws + WS_MIX, (unsigned)((size_t)T * D * 2)); P.dBt = (const float*)(ws + WS_DBT);
    const int total = NH * 16;
    int L = vcu; if (L >= total) return;
    const int L0 = L; int jl0, jl1; { const int lane = lane_id(); jl0 = fox_jlo(ka, L >> 4, L & 15, lane); jl1 = fox_jlo(ka, L >> 4, 31 - (L & 15), lane); }
    int pass = 0; fa::BlockRef cur = mk_ref(L, 0, L0, jl0, jl1); fa::Seam S;
    fa::fox_prime(P, cur, lds, S, wave);
    for (;;) {
        const bool more_pass = pass == 0, more_item = L + G < total, last = !more_pass && !more_item;
        int passn = pass + 1, Ln = L; if (!more_pass) { passn = 0; Ln = more_item ? L + G : L; }
        const fa::BlockRef nxt = last ? cur : mk_ref(Ln, passn, L0, jl0, jl1);
        fa::fox_block(P, cur, nxt, lds, S, wave);
        if (last) break;
        cur = nxt; pass = passn; L = Ln;
    }
}

#ifndef HG_DLIM
#define HG_DLIM 100.0f
#endif
namespace hg {
typedef short bf16x8 __attribute__((ext_vector_type(8)));
typedef float f32x16 __attribute__((ext_vector_type(16)));
typedef float f32x4 __attribute__((ext_vector_type(4)));
typedef float f32x2 __attribute__((ext_vector_type(2)));
template <int M> __device__ __forceinline__ float swzx(float v) { return __int_as_float(__builtin_amdgcn_ds_swizzle(__float_as_int(v), 0x1F | (M << 10))); }
__device__ __forceinline__ float b2f(bf16 v) { return __uint_as_float((unsigned)v << 16); }
__device__ __forceinline__ float ex2(float v) { return __builtin_amdgcn_exp2f(v); }
__device__ __forceinline__ int crow(int r, int hi) { return (r & 3) + 8 * (r >> 2) + 4 * hi; }
__device__ __forceinline__ void gate(float f, float lbk, float omlb, float& g2, float& kk) {
    const float e = ex2(f * LOG2E);
    const float sg = __builtin_amdgcn_rcpf(1.0f + __builtin_amdgcn_rcpf(e)), sgn = __builtin_amdgcn_rcpf(1.0f + e);
    g2 = __builtin_amdgcn_logf(lbk + omlb * sg); kk = omlb * sgn;
}
}

__device__ __forceinline__ void ph_hgA(const Args* ka, LAS unsigned char* lds, int vcu, int G, int wave) {
    using namespace hg;
    const int lane = lane_id(), tid = wave * 64 + lane;
    unsigned char* ws = ka->ws;
    const bf16* HF = (const bf16*)(ws + WS_PROJ) + 4 * HEADBUF; const bf16* HI = (const bf16*)(ws + WS_PROJ) + 5 * HEADBUF;
    bf16* UT = (bf16*)(ws + WS_HU); float* dv = (float*)(ws + WS_HD); const float* lb = (const float*)(ws + WS_LB);
    LAS bf16* kdT = (LAS bf16*)lds; LAS bf16* iT = (LAS bf16*)(lds + 18432); LAS float* qt = (LAS float*)(lds + 36864);
    const int k = tid & 127, rq = tid >> 7;
    bf16 fraw[16]; v4u ivn0 = {0u, 0u, 0u, 0u}, ivn1 = ivn0;
    if (vcu < NH * 128) { const size_t rb = ((size_t)(vcu >> 7) * T + (vcu & 127) * 64 + 16 * rq) * 128 + k;
#pragma unroll
        for (int j = 0; j < 16; ++j) fraw[j] = HF[rb + j * 128];
        const bf16* ipn = HI + ((size_t)(vcu >> 7) * T + (vcu & 127) * 64 + (tid >> 4)) * 128 + (tid & 15) * 8; ivn0 = *(const GAS v4u*)ipn; ivn1 = *(const GAS v4u*)(ipn + 32 * 128); }
    for (int u = vcu; u < NH * 128; u += G) {
        const int h = u >> 7, n = u & 127, t0 = n * 64;
        const float lbk = lb[h * 128 + k], omlb = 1.0f - lbk;
        float c[16], kk[16]; float run = 0.f;
#pragma unroll
        for (int j = 0; j < 16; ++j) { float g2; gate(b2f(fraw[j]), lbk, omlb, g2, kk[j]); run += g2; c[j] = run; }
        qt[rq * 128 + k] = run;
        const v4u iv0 = ivn0, iv1 = ivn1;
        { const int un = u + G < NH * 128 ? u + G : u; const size_t rb = ((size_t)(un >> 7) * T + (un & 127) * 64 + 16 * rq) * 128 + k;
#pragma unroll
          for (int j = 0; j < 16; ++j) fraw[j] = HF[rb + j * 128];
          const bf16* ipn = HI + ((size_t)(un >> 7) * T + (un & 127) * 64 + (tid >> 4)) * 128 + (tid & 15) * 8; ivn0 = *(const GAS v4u*)ipn; ivn1 = *(const GAS v4u*)(ipn + 32 * 128); }
        __syncthreads();
        float off = 0.f, tot = 0.f;
#pragma unroll
        for (int q = 0; q < 4; ++q) { const float xq = qt[q * 128 + k]; if (q < rq) off += xq; tot += xq; }
#pragma unroll
        for (int j = 0; j < 16; ++j) (kdT + k * 72 + 16 * rq)[j] = (bf16)f2bf(kk[j] * ex2(tot - (off + c[j])));
        if (rq == 0) dv[(size_t)u * 128 + k] = ex2(tot);
        { const int tt = tid >> 4, v0 = (tid & 15) * 8;
#pragma unroll
          for (int e = 0; e < 4; ++e) { iT[(v0 + 2 * e) * 72 + tt] = (bf16)(iv0[e] & 0xffffu); iT[(v0 + 2 * e + 1) * 72 + tt] = (bf16)(iv0[e] >> 16);
                                        iT[(v0 + 2 * e) * 72 + tt + 32] = (bf16)(iv1[e] & 0xffffu); iT[(v0 + 2 * e + 1) * 72 + tt + 32] = (bf16)(iv1[e] >> 16); } }
        __syncthreads();
        const int mb = wave >> 1, nh = wave & 1, r = lane & 31, hh = lane >> 5;
        f32x16 acc0 = {}, acc1 = {};
#pragma unroll
        for (int s = 0; s < 4; ++s) { const bf16x8 av = *(const LAS bf16x8*)(iT + (mb * 32 + r) * 72 + 16 * s + 8 * hh);
            const bf16x8 b0 = *(const LAS bf16x8*)(kdT + (nh * 64 + r) * 72 + 16 * s + 8 * hh), b1 = *(const LAS bf16x8*)(kdT + (nh * 64 + 32 + r) * 72 + 16 * s + 8 * hh);
            acc0 = __builtin_amdgcn_mfma_f32_32x32x16_bf16(av, b0, acc0, 0, 0, 0); acc1 = __builtin_amdgcn_mfma_f32_32x32x16_bf16(av, b1, acc1, 0, 0, 0); }
        bf16* up = UT + (size_t)u * 16384 + nh * 64 + r;
#pragma unroll
        for (int r_ = 0; r_ < 16; ++r_) { const int v = mb * 32 + crow(r_, hh); const float n0 = swzx<1>(acc0[r_]), n1 = swzx<1>(acc1[r_]);
            if ((r & 1) == 0) { *(unsigned*)(up + v * 128) = pk2(acc0[r_], n0); *(unsigned*)(up + v * 128 + 32) = pk2(acc1[r_], n1); } }
        __syncthreads();
    }
}

__device__ __forceinline__ void ph_hgB(const Args* ka, int vcu, int G, int wave) {
    using namespace hg;
    const int lane = lane_id(), tid = wave * 64 + lane;
    unsigned char* ws = ka->ws;
    const bf16* UT = (const bf16*)(ws + WS_HU); const float* dv = (const float*)(ws + WS_HD); bf16* ST = (bf16*)(ws + WS_HS);
    for (int idx = vcu * 512 + tid; idx < NH * 128 * 64; idx += G * 512) {
        const int h = idx >> 13, v = (idx >> 6) & 127, kp = idx & 63;
        const unsigned* up = (const unsigned*)(UT + (size_t)h * 128 * 16384 + v * 128 + 2 * kp);
        const float* dp = dv + (size_t)h * 128 * 128 + 2 * kp;
        unsigned* sp = (unsigned*)(ST + (size_t)h * 128 * 16384 + v * 128 + 2 * kp);
        float s0 = 0.f, s1 = 0.f;
#pragma unroll 8
        for (int n = 0; n < 128; ++n) { const unsigned uw = __builtin_nontemporal_load(up + (size_t)n * 8192); const f32x2 dd = *(const GAS f32x2*)(dp + n * 128);
            sp[(size_t)n * 8192] = pk2(s0, s1); s0 = dd.x * s0 + __uint_as_float(uw << 16); s1 = dd.y * s1 + __uint_as_float(uw & 0xffff0000u); }
    }
}

__device__ __forceinline__ void ph_hgC(const Args* ka, LAS unsigned char* lds, int vcu, int G, int wave) {
    using namespace hg;
    const int lane = lane_id(), tid = wave * 64 + lane;
    unsigned char* ws = ka->ws;
    const bf16* PR = (const bf16*)(ws + WS_PROJ);
    const bf16* HQ = PR + 3 * HEADBUF; const bf16* HF = PR + 4 * HEADBUF; const bf16* HI = PR + 5 * HEADBUF; const bf16* HGb = PR + 6 * HEADBUF;
    const bf16* ST = (const bf16*)(ws + WS_HS); const float* lb = (const float*)(ws + WS_LB); bf16* MIX = (bf16*)(ws + WS_MIX); const float* ghg = ka->in[9];
    constexpr int OFF_QM = 0, OFF_KM = 17408, OFF_QR = 34816, OFF_KD = 52224, OFF_AM = 78336, OFF_QT = 87552, OFF_FLAG = 89600, OFF_FBQ = 89856, OFF_FBK = 107264;
    constexpr int BST = 132, HST = 136, AST = 72; constexpr float DLIM = HG_DLIM;
    LAS bf16* qmS = (LAS bf16*)(lds + OFF_QM); LAS bf16* kmS = (LAS bf16*)(lds + OFF_KM); LAS bf16* qrS = (LAS bf16*)(lds + OFF_QR); LAS bf16* kdS = (LAS bf16*)(lds + OFF_KD);
    LAS bf16* Am = (LAS bf16*)(lds + OFF_AM); LAS float* qt = (LAS float*)(lds + OFF_QT); volatile LAS unsigned* flag = (volatile LAS unsigned*)(lds + OFF_FLAG);
    LAS float* bS = (LAS float*)(lds + OFF_QM); LAS bf16* qS = (LAS bf16*)(lds + OFF_FBQ); LAS bf16* kkS = (LAS bf16*)(lds + OFF_FBK);
    LAS bf16* qdS = (LAS bf16*)(lds + OFF_QM); LAS bf16* iT = (LAS bf16*)(lds + OFF_KD); LAS bf16* STl = (LAS bf16*)(lds + OFF_KM); LAS float* oS = (LAS float*)(lds + OFF_KM);
    const int k = tid & 127, rq = tid >> 7;
    bf16 fraw[16], qraw[16];
    if (vcu < NH * 128) { const size_t rb = ((size_t)(vcu >> 7) * T + (vcu & 127) * 64 + 16 * rq) * 128 + k;
#pragma unroll
        for (int j = 0; j < 16; ++j) { fraw[j] = HF[rb + j * 128]; qraw[j] = HQ[rb + j * 128]; } }
    if (tid < 2) flag[tid] = 0u;
    __syncthreads();
    int par = 0;
    for (int u = vcu; u < NH * 128; u += G, par ^= 1) {
        const int h = u >> 7, n = u & 127, t0 = n * 64;
        const float lbk = lb[h * 128 + k], omlb = 1.0f - lbk;
        float c[16], kk[16], qv[16]; float run = 0.f;
#pragma unroll
        for (int j = 0; j < 16; ++j) { float g2; gate(b2f(fraw[j]), lbk, omlb, g2, kk[j]); run += g2; c[j] = run; qv[j] = b2f(qraw[j]); }
        { const int un = u + G < NH * 128 ? u + G : u; const size_t rb = ((size_t)(un >> 7) * T + (un & 127) * 64 + 16 * rq) * 128 + k;
#pragma unroll
          for (int j = 0; j < 16; ++j) { fraw[j] = HF[rb + j * 128]; qraw[j] = HQ[rb + j * 128]; } }
        qt[rq * 128 + k] = run;
        if (!(fmaxf(c[7] - c[15], c[0] - c[7]) <= DLIM)) flag[par] = 1u;
        for (int i = tid; i < 64 * AST / 2; i += 512) ((LAS unsigned*)Am)[i] = 0u;
        __syncthreads();
        const bool exact = flag[par] != 0u;
        if (tid == 0) flag[par ^ 1] = 0u;
        const float P1 = qt[k], P2 = P1 + qt[128 + k], P3 = P2 + qt[256 + k];
        const float off = rq == 0 ? 0.f : (rq == 1 ? P1 : (rq == 2 ? P2 : P3));
        { const int rbq = rq * (16 * HST) + k;
          LAS bf16* qr0 = qrS + rbq; LAS bf16* kd1 = kdS + rbq; LAS bf16* kd2 = kdS + 16 * HST + rbq; LAS bf16* kd3 = kdS + 48 * HST + rbq;
#pragma unroll
          for (int j = 0; j < 16; ++j) { const float bv = off + c[j];
            if (rq >= 1) qr0[j * HST] = (bf16)f2bf(qv[j] * ex2(c[j]));
            if (rq < 1) kd1[j * HST] = (bf16)f2bf(kk[j] * ex2(P1 - bv));
            if (rq < 2) kd2[j * HST] = (bf16)f2bf(kk[j] * ex2(P2 - bv));
            if (rq < 3) kd3[j * HST] = (bf16)f2bf(kk[j] * ex2(P3 - bv)); }
          if (!exact) { LAS bf16* qm0 = qmS + rbq; LAS bf16* km0 = kmS + rbq;
#pragma unroll
            for (int j = 0; j < 16; ++j) { qm0[j * HST] = (bf16)f2bf(qv[j] * ex2(c[j] - c[7])); km0[j * HST] = (bf16)f2bf(kk[j] * ex2(c[7] - c[j])); } }
          else { LAS float* bS0 = bS + rq * (16 * BST) + k; LAS bf16* kk0 = kkS + rbq; LAS bf16* q0 = qS + rbq;
#pragma unroll
            for (int j = 0; j < 16; ++j) { bS0[j * BST] = off + c[j]; kk0[j * HST] = (bf16)f2bf(kk[j]); q0[j * HST] = (bf16)f2bf(qv[j]); } } }
        __syncthreads();
        if (wave < 6) {
            const int I = wave < 1 ? 1 : (wave < 3 ? 2 : 3), J = wave < 1 ? 0 : (wave < 3 ? wave - 1 : wave - 3), kb = I == 1 ? 0 : (I == 2 ? 16 : 48);
            const int r16 = lane & 15, kq = lane >> 4; f32x4 acc = {0.f, 0.f, 0.f, 0.f};
#pragma unroll
            for (int ks = 0; ks < 4; ++ks) { const bf16x8 av = *(const LAS bf16x8*)(qrS + (16 * I + r16) * HST + 32 * ks + 8 * kq), bv = *(const LAS bf16x8*)(kdS + (kb + 16 * J + r16) * HST + 32 * ks + 8 * kq);
                acc = __builtin_amdgcn_mfma_f32_16x16x32_bf16(av, bv, acc, 0, 0, 0); }
#pragma unroll
            for (int e = 0; e < 4; ++e) Am[(16 * I + kq * 4 + e) * AST + 16 * J + r16] = (bf16)f2bf(acc[e]);
        }
        if (!exact && wave < 4) {
            const int I = wave, r16 = lane & 15, kq = lane >> 4; f32x4 acc = {0.f, 0.f, 0.f, 0.f};
#pragma unroll
            for (int ks = 0; ks < 4; ++ks) { const bf16x8 av = *(const LAS bf16x8*)(qmS + (16 * I + r16) * HST + 32 * ks + 8 * kq), bv = *(const LAS bf16x8*)(kmS + (16 * I + r16) * HST + 32 * ks + 8 * kq);
                acc = __builtin_amdgcn_mfma_f32_16x16x32_bf16(av, bv, acc, 0, 0, 0); }
#pragma unroll
            for (int e = 0; e < 4; ++e) if (r16 <= kq * 4 + e) Am[(16 * I + kq * 4 + e) * AST + 16 * I + r16] = (bf16)f2bf(acc[e]);
        }
        const bf16* ip = HI + ((size_t)h * T + t0 + (tid >> 4)) * 128 + (tid & 15) * 8;
        const v4u iv0 = *(const GAS v4u*)ip, iv1 = *(const GAS v4u*)(ip + 32 * 128);
        const bf16* sp = ST + (size_t)u * 16384 + (size_t)tid * 8;
        const v4u sv0 = __builtin_nontemporal_load((const GAS v4u*)sp), sv1 = __builtin_nontemporal_load((const GAS v4u*)(sp + 4096)), sv2 = __builtin_nontemporal_load((const GAS v4u*)(sp + 8192)), sv3 = __builtin_nontemporal_load((const GAS v4u*)(sp + 12288));
        if (exact) {
          const int ks = tid & 7, sq = (tid >> 3) & 3, tq = (tid >> 5) & 3, bI = tid >> 7;
          if (sq <= tq) {
            float acc[4][4];
#pragma unroll
            for (int i = 0; i < 4; ++i)
#pragma unroll
                for (int j = 0; j < 4; ++j) acc[i][j] = 0.f;
            const int tb = 16 * bI + 4 * tq, sb = 16 * bI + 4 * sq;
#pragma unroll 1
            for (int k4 = 0; k4 < 4; ++k4) { const int kc = ks * 16 + 4 * k4;
                f32x4 bt[4], bs[4]; float qf[4][4], kf[4][4];
#pragma unroll
                for (int i = 0; i < 4; ++i) { bt[i] = *(const LAS f32x4*)(bS + (tb + i) * BST + kc); const f32x2 qw = *(const LAS f32x2*)(qS + (tb + i) * HST + kc);
                    const unsigned w0 = __float_as_uint(qw.x), w1 = __float_as_uint(qw.y); qf[i][0] = __uint_as_float(w0 << 16); qf[i][1] = __uint_as_float(w0 & 0xffff0000u); qf[i][2] = __uint_as_float(w1 << 16); qf[i][3] = __uint_as_float(w1 & 0xffff0000u); }
#pragma unroll
                for (int j = 0; j < 4; ++j) { bs[j] = *(const LAS f32x4*)(bS + (sb + j) * BST + kc); const f32x2 kw = *(const LAS f32x2*)(kkS + (sb + j) * HST + kc);
                    const unsigned w0 = __float_as_uint(kw.x), w1 = __float_as_uint(kw.y); kf[j][0] = __uint_as_float(w0 << 16); kf[j][1] = __uint_as_float(w0 & 0xffff0000u); kf[j][2] = __uint_as_float(w1 << 16); kf[j][3] = __uint_as_float(w1 & 0xffff0000u); }
#pragma unroll
                for (int i = 0; i < 4; ++i)
#pragma unroll
                    for (int j = 0; j < 4; ++j)
#pragma unroll
                        for (int e = 0; e < 4; ++e) acc[i][j] += qf[i][e] * kf[j][e] * ex2(fminf(bt[i][e] - bs[j][e], 0.f));
            }
#pragma unroll
            for (int i = 0; i < 4; ++i)
#pragma unroll
                for (int j = 0; j < 4; ++j) { float a_ = acc[i][j]; a_ += swzx<1>(a_); a_ += swzx<2>(a_); a_ += swzx<4>(a_);
                    if (ks == 0 && sb + j <= tb + i) Am[(tb + i) * AST + sb + j] = (bf16)f2bf(a_); }
          }
        }
        __syncthreads();
        { LAS bf16* qd0 = qdS + rq * (16 * HST) + k;
#pragma unroll
          for (int j = 0; j < 16; ++j) qd0[j * HST] = (bf16)f2bf(qv[j] * ex2(off + c[j])); }
        { const int tt = tid >> 4, v0 = (tid & 15) * 8;
#pragma unroll
          for (int e = 0; e < 4; ++e) { iT[(v0 + 2 * e) * AST + tt] = (bf16)(iv0[e] & 0xffffu); iT[(v0 + 2 * e + 1) * AST + tt] = (bf16)(iv0[e] >> 16);
                                        iT[(v0 + 2 * e) * AST + tt + 32] = (bf16)(iv1[e] & 0xffffu); iT[(v0 + 2 * e + 1) * AST + tt + 32] = (bf16)(iv1[e] >> 16); }
          *(LAS v4u*)(STl + ((tid >> 4)) * HST + (tid & 15) * 8) = sv0; *(LAS v4u*)(STl + ((tid >> 4) + 32) * HST + (tid & 15) * 8) = sv1;
          *(LAS v4u*)(STl + ((tid >> 4) + 64) * HST + (tid & 15) * 8) = sv2; *(LAS v4u*)(STl + ((tid >> 4) + 96) * HST + (tid & 15) * 8) = sv3; }
        __syncthreads();
        const int mb = wave >> 2, nb = wave & 3, r = lane & 31, hh = lane >> 5;
        f32x16 oacc = {};
#pragma unroll
        for (int s = 0; s < 8; ++s) { const bf16x8 av = *(const LAS bf16x8*)(qdS + (mb * 32 + r) * HST + 16 * s + 8 * hh), bv = *(const LAS bf16x8*)(STl + (nb * 32 + r) * HST + 16 * s + 8 * hh);
            oacc = __builtin_amdgcn_mfma_f32_32x32x16_bf16(av, bv, oacc, 0, 0, 0); }
#pragma unroll
        for (int s = 0; s < 4; ++s) { const bf16x8 av = *(const LAS bf16x8*)(Am + (mb * 32 + r) * AST + 16 * s + 8 * hh), bv = *(const LAS bf16x8*)(iT + (nb * 32 + r) * AST + 16 * s + 8 * hh);
            oacc = __builtin_amdgcn_mfma_f32_32x32x16_bf16(av, bv, oacc, 0, 0, 0); }
        __syncthreads();
#pragma unroll
        for (int r_ = 0; r_ < 16; ++r_) oS[(mb * 32 + crow(r_, hh)) * BST + nb * 32 + r] = oacc[r_];
        __syncthreads();
        { const int t = tid >> 3, seg = tid & 7; float ov[16]; float ss = 0.f;
#pragma unroll
          for (int q = 0; q < 4; ++q) { const f32x4 x4 = *(const LAS f32x4*)(oS + t * BST + seg * 16 + 4 * q); ov[4 * q] = x4.x; ov[4 * q + 1] = x4.y; ov[4 * q + 2] = x4.z; ov[4 * q + 3] = x4.w;
              ss += (x4.x * x4.x + x4.y * x4.y) + (x4.z * x4.z + x4.w * x4.w); }
          ss += swzx<1>(ss); ss += swzx<2>(ss); ss += swzx<4>(ss);
          const float rn = 1.0f / sqrtf(ss * (1.0f / 128.0f) + EPS);
          const bf16* gp = HGb + ((size_t)h * T + t0 + t) * 128 + seg * 16;
          const v4u g0 = *(const GAS v4u*)gp, g1 = *(const GAS v4u*)(gp + 8);
          float gf[16];
#pragma unroll
          for (int e = 0; e < 4; ++e) { gf[2 * e] = __uint_as_float(g0[e] << 16); gf[2 * e + 1] = __uint_as_float(g0[e] & 0xffff0000u); gf[8 + 2 * e] = __uint_as_float(g1[e] << 16); gf[8 + 2 * e + 1] = __uint_as_float(g1[e] & 0xffff0000u); }
          float yv[16];
#pragma unroll
          for (int q = 0; q < 4; ++q) { const f32x4 gg = *(const GAS f32x4*)(ghg + h * 128 + seg * 16 + 4 * q);
              yv[4 * q] = ov[4 * q] * rn * gg.x * gf[4 * q]; yv[4 * q + 1] = ov[4 * q + 1] * rn * gg.y * gf[4 * q + 1]; yv[4 * q + 2] = ov[4 * q + 2] * rn * gg.z * gf[4 * q + 2]; yv[4 * q + 3] = ov[4 * q + 3] * rn * gg.w * gf[4 * q + 3]; }
          bf16* mp = MIX + (size_t)(t0 + t) * D + 2048 + h * 128 + seg * 16;
          v4u w0, w1;
#pragma unroll
          for (int e = 0; e < 4; ++e) { w0[e] = pk2(yv[2 * e], yv[2 * e + 1]); w1[e] = pk2(yv[8 + 2 * e], yv[8 + 2 * e + 1]); }
          *(GAS v4u*)mp = w0; *(GAS v4u*)(mp + 8) = w1; }
        __syncthreads();
    }
}

__global__ void __launch_bounds__(512, 2) fwd(Args a) {
    const Args* ka = (const Args*)__builtin_amdgcn_kernarg_segment_ptr();
    extern __shared__ __attribute__((aligned(16))) unsigned char lds_[];
    LAS unsigned char* lds = (LAS unsigned char*)lds_;
    volatile LAS unsigned* MISC = (volatile LAS unsigned*)(lds + MISC_OFF);
    const int wave = __builtin_amdgcn_readfirstlane(threadIdx.x >> 6);
#define lane lane_id()
#define tid (wave * 64 + lane_id())
    const int G = gridDim.x; const int bx = blockIdx.x; const int vcu = (G % 8 == 0) ? (bx % 8) * (G / 8) + bx / 8 : bx;
    for (int u = tid; u < (LDS_BYTES - LDSCTL_OFF) / 4; u += 512) ((LAS unsigned*)(lds + LDSCTL_OFF))[u] = 0u;
    __syncthreads();
#define ws (ka->ws)
    gu32* ctl = (gu32*)(ws + WS_CTL);
    XcdBarrier bar = xcd_barrier_post((unsigned*)(ctl + CW_BAR), MISC + 8);
    const unsigned mask = ka->mask;
#ifndef GEMM_SP2
#define GEMM_SP2 true
#endif
#define HAS(p) (mask & (1u << (p)))
#ifndef REPEAT_MASK
#define REPEAT_MASK 0u
#endif
#define REP(p) for (int rep_ = 0; rep_ < 1 + (int)((REPEAT_MASK >> (p)) & 1u); ++rep_) if (rep_ ? (__syncthreads(), true) : true)
#define SEAM(k) do { if ((mask & ((1u << (k)) - 1u)) && (mask >> (k))) xcd_barrier(bar); } while (0)
#define x (ka->in[0])
#define mod ((float*)(ws + WS_MOD))
#define Hb ((bf16*)(ws + WS_H))
#define PROJ ((bf16*)(ws + WS_PROJ))
#define MIX ((bf16*)(ws + WS_MIX))
#define D1b ((bf16*)(ws + WS_D1))
#define D2b ((bf16*)(ws + WS_D2))

    const int G1 = (G == 256) ? 224 : G;
    if (HAS(PC_PRO)) REP(PC_PRO) { if (G1 < G) ph_prologue<1>(ka, lds, vcu, G, tid, lane, wave); else ph_prologue<3>(ka, lds, vcu, G, tid, lane, wave); }
    SEAM(PC_NORM1);
    if (HAS(PC_NORM1)) REP(PC_NORM1) ph_norm<true>(x, nullptr, ka->in[4], (const float*)(ws + WS_PART), ka->in[3], Hb, (const bf16*)(ws + WS_WF), ka->in[6], (float*)(ws + WS_LF), mod, G1 < G ? 2 * D : NMOD, lds, vcu, G, tid, lane, wave);
    SEAM(PC_CUM);
    if (HAS(PC_GEMM1)) REP(PC_GEMM1) {
        pg8::Gemm g{Hb, (const bf16*)(ws + WS_WIN), T, NPROJ, D}; pg8::StaticOrder S; S.init(T, NPROJ, G1, bx);
        pg8::EpiProj E{PROJ, HEADBUF, T, QSCALE, (float*)(ws + WS_NRM)};
        if (bx < G1) pg8::gemm_phase<pg8::EpiProj, pg8::StaticOrder, true, GEMM_SP2>(lds, g, S, E, wave);
#ifndef STREAM_REP
#define STREAM_REP 1
#endif
        else { if (HAS(PC_CUM)) ph_cum(ka, lds, bx - G1, tid, lane);
            for (int sr_ = 0; sr_ < STREAM_REP; ++sr_) { if (sr_) __syncthreads(); ph_prologue<2>(ka, lds, bx - G1, G - G1, tid, lane, wave); }
#ifdef STREAM_DELAY_US
            { const unsigned long long t0_ = wall_clock64(); while (wall_clock64() - t0_ < 100ull * STREAM_DELAY_US) __builtin_amdgcn_s_sleep(8); }
#endif
        }
    }
    SEAM(PC_HGA);
    if (HAS(PC_GEMM1) && G1 < G) ph_modreduce(ka, 2 * D, vcu, G, tid);
    if (HAS(PC_CUM) && G1 == G) REP(PC_CUM) ph_cum(ka, lds, vcu, tid, lane);
    if (HAS(PC_HGA)) REP(PC_HGA) ph_hgA(ka, lds, vcu, G, wave);
    SEAM(PC_HGB);
    if (HAS(PC_HGB)) REP(PC_HGB) ph_hgB(ka, vcu, G, wave);
    SEAM(PC_HGC);
    if (HAS(PC_HGC)) REP(PC_HGC) ph_hgC(ka, lds, vcu, G, wave);
    if (HAS(PC_ATTN)) REP(PC_ATTN) ph_attn(ka, lds, vcu, G, wave);
    SEAM(PC_GEMM2);
    if (HAS(PC_GEMM2)) REP(PC_GEMM2) {
        pg8::Gemm g{MIX, (const bf16*)(ws + WS_WO), T, D, D}; pg8::StaticOrder S; S.init(T, D, G, bx);
        pg8::EpiGate E{D1b, D, mod + 2 * D};
        pg8::gemm_phase<pg8::EpiGate, pg8::StaticOrder, true, GEMM_SP2>(lds, g, S, E, wave);
    }
    SEAM(PC_NORM2);
    if (HAS(PC_NORM2)) REP(PC_NORM2) ph_norm<false>(x, D1b, ka->in[11], mod + 3 * D, mod + 4 * D, Hb, nullptr, nullptr, nullptr, nullptr, 0, lds, vcu, G, tid, lane, wave);
    SEAM(PC_GEMM3);
    if (HAS(PC_GEMM3)) REP(PC_GEMM3) {
        pg8::Gemm g{Hb, (const bf16*)(ws + WS_WUP), T, FF2, D}; pg8::StaticOrder S; S.init(T, FF2, G, bx);
        pg8::EpiConv E{(bf16*)(ws + WS_ACT), ka->in[13], ka->in[14], (float*)(ws + WS_UH), lds + HALO_OFF, FF};
        pg8::gemm_phase<pg8::EpiConv, pg8::StaticOrder, true, GEMM_SP2>(lds, g, S, E, wave);
#ifndef WD_DYN
        { const int nun = (T / 256) * (FF2 / 256), rem = nun % G;
          const int rank = rem ? bx - rem : bx, nrank = rem ? G - rem : G;
          if (rank >= 0) ph_convert_wd(ka, lds, rank, nrank, wave); }
#else
        ph_convert_wd_dyn(ka, lds, wave);
#endif
    }
    SEAM(PC_CONV);
    if (HAS(PC_CONV)) REP(PC_CONV) ph_convfix(ka, vcu, G, tid);
    SEAM(PC_GEMM4);
    if (HAS(PC_GEMM4)) REP(PC_GEMM4) {
        pg8::Gemm g{(const bf16*)(ws + WS_ACT), (const bf16*)(ws + WS_WD), T, D, FF}; pg8::StaticOrder S; S.init(T, D, G, bx);
        pg8::EpiGate E{D2b, D, mod + 5 * D};
        pg8::gemm_phase<pg8::EpiGate, pg8::StaticOrder, true, GEMM_SP2>(lds, g, S, E, wave);
    }
    SEAM(PC_FNORM);
    if (HAS(PC_FNORM)) REP(PC_FNORM) ph_fnorm(x, D1b, D2b, ka->out, ka->in[16], vcu, G, lane, wave);
#undef HAS
#undef lane
#undef tid
#undef SEAM
#undef ws
#undef x
#undef mod
#undef Hb
#undef PROJ
#undef MIX
#undef D1b
#undef D2b
}

extern "C" void kernel_launch(void* const* d_in, const int* in_sizes, int n_in, void* d_out, int out_size, void* d_ws, size_t ws_size, hipStream_t stream) {
    static int grid = 0;
    if (grid == 0) {
        if (n_in != 17 || in_sizes[0] != T * D || out_size != T * D || ws_size < WS_END) { fprintf(stderr, "kernel_launch: unexpected shapes / workspace (n_in %d, ws %zu)\n", n_in, ws_size); grid = -1; return; }
        int dev = 0, cus = 0, per_cu = 0;
        if (hipGetDevice(&dev) != hipSuccess || hipDeviceGetAttribute(&cus, hipDeviceAttributeMultiprocessorCount, dev) != hipSuccess) { grid = -1; return; }
        if (hipFuncSetAttribute((const void*)fwd, hipFuncAttributeMaxDynamicSharedMemorySize, LDS_BYTES) != hipSuccess) { fprintf(stderr, "kernel_launch: hipFuncSetAttribute failed\n"); grid = -1; return; }
        if (hipOccupancyMaxActiveBlocksPerMultiprocessor(&per_cu, (const void*)fwd, 512, LDS_BYTES) != hipSuccess || per_cu < 1) fprintf(stderr, "kernel_launch: occupancy query reports %d\n", per_cu);
        (void)hipGetLastError();
        grid = cus;
    }
    if (grid < 0) return;
    (void)hipMemsetAsync((char*)d_ws + WS_CTL, 0, CTL_ZERO_BYTES, stream);
    Args a{};
    for (int i = 0; i < 17; ++i) a.in[i] = (const float*)d_in[i];
    a.out = (float*)d_out; a.ws = (unsigned char*)d_ws; a.mask = (1u << PC_N) - 1u; a.pad = 0u;
    hipLaunchKernelGGL(fwd, dim3(grid), dim3(512), LDS_BYTES, stream, a);
}
```

```cpp
#include <hip/hip_runtime.h>
#include <cstdio>
#include <cstdint>

constexpr int T = 8192, D = 4096, NMOD = 6 * D, INC = 14352, FF = 11008, FF2 = 22016, NH = 16, HD = 128;
constexpr int FOX_F0 = 6144, HG_Q0 = 6160, HG_F0 = HG_Q0 + 2048, HG_I0 = HG_F0 + 2048, HG_G0 = HG_I0 + 2048;
constexpr int NPROJ = 14336;
constexpr float EPS = 1e-6f;
constexpr float LOG2E = 1.4426950408889634f;
constexpr float QSCALE = 0.08838834764831845f * 1.4426950408889634f;
constexpr size_t HEADBUF = (size_t)NH * T * HD;
__device__ __forceinline__ int lane_id() { int l; asm volatile("v_mbcnt_lo_u32_b32 %0, -1, 0\n\tv_mbcnt_hi_u32_b32 %0, -1, %0" : "=v"(l)); return l; }


#ifndef PG8_WGM
#define PG8_WGM 8
#endif
namespace pg8 {
#define PG8_LAS __attribute__((address_space(3)))
typedef unsigned short bf16_t;
typedef short bf16x8 __attribute__((ext_vector_type(8)));
typedef float f32x4 __attribute__((ext_vector_type(4)));
typedef float f32x2 __attribute__((ext_vector_type(2)));
typedef unsigned u32x4 __attribute__((ext_vector_type(4)));
constexpr int BM = 256, BK = 64, HALF = 128, HTB = HALF * BK * 2  , STAGE_BYTES = 8 * HTB, NXCD = 8, WGM = PG8_WGM;

__host__ __device__ __forceinline__ int lds_byte(int r, int c) { const int st = (r >> 4) * 2 + (c >> 5), rr = r & 15, cc = c & 31, ob = rr * 64 + cc * 2; return st * 1024 + (ob ^ (((ob >> 9) & 1) << 5)); }
__host__ __device__ __forceinline__ void stage_rc(int b, int& R, int& C) { const int st = b / 1024, sb = b % 1024, swz = sb ^ (((sb >> 9) & 1) << 5); R = (st >> 1) * 16 + swz / 64; C = (st & 1) * 32 + (swz % 64) / 2; }
__host__ __device__ __forceinline__ int perm32(int rho) { const int n = rho >> 4, i = rho & 15; return 8 * (i >> 2) + 4 * n + (i & 3); }

struct Unit { int pm, pn; };
struct Gemm { const bf16_t* A; const bf16_t* Bt; int M, N, K; };

struct StaticOrder {
    int nM, nN, nwg, G, c;
    __host__ __device__ void init(int M, int N, int G_, int c_) { nM = M / BM; nN = N / BM; nwg = nM * nN; G = G_; c = c_; }
    __host__ __device__ bool next(int i, Unit& u) const {
        const long L = (long)i * G + c; if (L >= nwg) return false;
        int wgid = (int)L; { const int q = nwg / NXCD, r = nwg % NXCD, xcd = wgid % NXCD, off = wgid / NXCD; wgid = (xcd < r ? xcd * (q + 1) : r * (q + 1) + (xcd - r) * q) + off; }
        const int nig = WGM * nN, gid = wgid / nig, fm = gid * WGM, gsz = (nM - fm) < WGM ? (nM - fm) : WGM;
        u.pm = fm + ((wgid % nig) % gsz); u.pn = (wgid % nig) / gsz; return true;
    }
    __device__ __forceinline__ void a_ready(const Unit&) const {}
    __device__ __forceinline__ void done(const Unit&) const {}
};


__device__ __forceinline__ unsigned cvt_pk_bf16(float lo, float hi) { unsigned r; asm volatile("v_cvt_pk_bf16_f32 %0, %1, %2" : "=v"(r) : "v"(lo), "v"(hi)); return r; }
__device__ __forceinline__ float silu_f(float v) { return v * __builtin_amdgcn_rcpf(1.0f + __builtin_amdgcn_exp2f(-1.4426950408889634f * v)); }
struct EpiBf16 {
    static constexpr bool PERM = true, AFTER_DRAIN = false;
    bf16_t* O; int ldc;
    __device__ __forceinline__ void operator()(const f32x4 (&acc)[2][2][4][2], const Unit& u, int wr, int wc, int fr, int fq) const {
        const int row0 = u.pm * BM + wr * 64 + fr, col0 = u.pn * BM + wc * 32 + 8 * fq;
#pragma unroll
        for (int ai = 0; ai < 2; ++ai)
#pragma unroll
            for (int m = 0; m < 4; ++m) { bf16_t* rowp = O + (size_t)(row0 + ai * HALF + m * 16) * ldc + col0;
#pragma unroll
                for (int bj = 0; bj < 2; ++bj) { const f32x4 v0 = acc[ai][bj][m][0], v1 = acc[ai][bj][m][1];
                    u32x4 w; w.x = cvt_pk_bf16(v0[0], v0[1]); w.y = cvt_pk_bf16(v0[2], v0[3]); w.z = cvt_pk_bf16(v1[0], v1[1]); w.w = cvt_pk_bf16(v1[2], v1[3]);
                    *(u32x4*)(rowp + bj * HALF) = w; } }
    }
};
struct EpiProj {
    static constexpr bool PERM = true, AFTER_DRAIN = false;
    bf16_t* base; size_t bufsz; int tlen; float qscale; float* nrm4;
    __device__ __forceinline__ void operator()(const f32x4 (&acc)[2][2][4][2], const Unit& u, int wr, int wc, int fr, int fq) const {
        const int type = u.pn >> 3, hp = u.pn & 7;
        const int row0 = u.pm * BM + wr * 64 + fr, cin = wc * 32 + 8 * fq;
        bf16_t* tb = base + (size_t)type * bufsz;
        const bool act = (type == 3) || (type == 6); const float sc = (type == 0) ? qscale : 1.0f;
#pragma unroll
        for (int ai = 0; ai < 2; ++ai)
#pragma unroll
            for (int m = 0; m < 4; ++m) { const int row = row0 + ai * HALF + m * 16;
#pragma unroll
                for (int bj = 0; bj < 2; ++bj) { f32x4 v0 = acc[ai][bj][m][0], v1 = acc[ai][bj][m][1];
                    if (act) {
#pragma unroll
                        for (int e = 0; e < 4; ++e) { v0[e] = silu_f(v0[e]); v1[e] = silu_f(v1[e]); } }
                    v0 = v0 * sc; v1 = v1 * sc;
                    u32x4 w; w.x = cvt_pk_bf16(v0[0], v0[1]); w.y = cvt_pk_bf16(v0[2], v0[3]); w.z = cvt_pk_bf16(v1[0], v1[1]); w.w = cvt_pk_bf16(v1[2], v1[3]);
                    *(u32x4*)(tb + ((size_t)(2 * hp + bj) * tlen + row) * 128 + cin) = w; } }
        if (type <= 1) {
#pragma unroll
            for (int ai = 0; ai < 2; ++ai)
#pragma unroll
                for (int bj = 0; bj < 2; ++bj) { float mx = 0.f;
#pragma unroll
                    for (int m = 0; m < 4; ++m) { const f32x4 v0 = acc[ai][bj][m][0] * sc, v1 = acc[ai][bj][m][1] * sc;
                        float ss = (v0[0] * v0[0] + v0[1] * v0[1]) + (v0[2] * v0[2] + v0[3] * v0[3]) + (v1[0] * v1[0] + v1[1] * v1[1]) + (v1[2] * v1[2] + v1[3] * v1[3]);
                        ss += __shfl_xor(ss, 16); ss += __shfl_xor(ss, 32); mx = fmaxf(mx, ss); }
                    mx = fmaxf(mx, __shfl_xor(mx, 1)); mx = fmaxf(mx, __shfl_xor(mx, 2)); mx = fmaxf(mx, __shfl_xor(mx, 4)); mx = fmaxf(mx, __shfl_xor(mx, 8));
                    if (fr == 0 && fq == 0) nrm4[(((size_t)type * 16 + 2 * hp + bj) * (tlen / 64) + (u.pm * 4 + 2 * ai + wr)) * 4 + wc] = mx * 1.01f; }
        }
    }
};
struct EpiGate {
    static constexpr bool PERM = true, AFTER_DRAIN = false;
    bf16_t* O; int ldc; const float* gate;
    __device__ __forceinline__ void operator()(const f32x4 (&acc)[2][2][4][2], const Unit& u, int wr, int wc, int fr, int fq) const {
        const int row0 = u.pm * BM + wr * 64 + fr, col0 = u.pn * BM + wc * 32 + 8 * fq;
        f32x4 gv[2][2];
#pragma unroll
        for (int bj = 0; bj < 2; ++bj)
#pragma unroll
            for (int n = 0; n < 2; ++n) gv[bj][n] = *(const f32x4*)(gate + col0 + bj * HALF + 4 * n);
#pragma unroll
        for (int ai = 0; ai < 2; ++ai)
#pragma unroll
            for (int m = 0; m < 4; ++m) { bf16_t* rowp = O + (size_t)(row0 + ai * HALF + m * 16) * ldc + col0;
#pragma unroll
                for (int bj = 0; bj < 2; ++bj) { const f32x4 v0 = acc[ai][bj][m][0] * gv[bj][0], v1 = acc[ai][bj][m][1] * gv[bj][1];
                    u32x4 w; w.x = cvt_pk_bf16(v0[0], v0[1]); w.y = cvt_pk_bf16(v0[2], v0[3]); w.z = cvt_pk_bf16(v1[0], v1[1]); w.w = cvt_pk_bf16(v1[2], v1[3]);
                    *(u32x4*)(rowp + bj * HALF) = w; } }
    }
};
struct EpiRes {
    static constexpr bool PERM = false, AFTER_DRAIN = false;
    const float* R; float* out; int ldc; const float* gate;
    __device__ __forceinline__ void operator()(const f32x4 (&acc)[2][2][4][2], const Unit& u, int wr, int wc, int fr, int fq) const {
        const int col0 = u.pn * BM + wc * 32 + 4 * fq;
        f32x4 gv[2][2];
#pragma unroll
        for (int bj = 0; bj < 2; ++bj)
#pragma unroll
            for (int n = 0; n < 2; ++n) gv[bj][n] = *(const f32x4*)(gate + col0 + bj * HALF + n * 16);
#pragma unroll
        for (int ai = 0; ai < 2; ++ai)
#pragma unroll
            for (int m = 0; m < 4; ++m) { const size_t off = (size_t)(u.pm * BM + ai * HALF + wr * 64 + m * 16 + fr) * ldc + col0;
#pragma unroll
                for (int bj = 0; bj < 2; ++bj)
#pragma unroll
                    for (int n = 0; n < 2; ++n) { const f32x4 rs = *(const f32x4*)(R + off + bj * HALF + n * 16);
                        *(f32x4*)(out + off + bj * HALF + n * 16) = rs + gv[bj][n] * acc[ai][bj][m][n]; } }
    }
};


__device__ __forceinline__ float dpp_f(float oldv, float src, const int ctrl_sel) {
    return ctrl_sel == 0 ? __int_as_float(__builtin_amdgcn_update_dpp(__float_as_int(oldv), __float_as_int(src), 0x111, 0xF, 0xF, false))
         : ctrl_sel == 1 ? __int_as_float(__builtin_amdgcn_update_dpp(__float_as_int(oldv), __float_as_int(src), 0x112, 0xF, 0xF, false))
         : ctrl_sel == 2 ? __int_as_float(__builtin_amdgcn_update_dpp(__float_as_int(oldv), __float_as_int(src), 0x15F, 0xF, 0xF, false))
         :                 __int_as_float(__builtin_amdgcn_update_dpp(__float_as_int(oldv), __float_as_int(src), 0x15E, 0xF, 0xF, false));
}
struct EpiConv {
    static constexpr bool PERM = true, AFTER_DRAIN = false;
    bf16_t* ACT; const float* cw; const float* cb; float* UH; PG8_LAS unsigned char* halo; int ff;
    __device__ __forceinline__ void operator()(const f32x4 (&acc)[2][2][4][2], const Unit& u, int wr, int wc, int fr, int fq) const {
        const int cin = wc * 32 + 8 * fq, j0 = u.pn * 128 + cin, ff2 = 2 * ff;
        PG8_LAS f32x4* hl = (PG8_LAS f32x4*)halo;
        if (fr >= 14) {
#pragma unroll
            for (int ai = 0; ai < 2; ++ai)
#pragma unroll
                for (int bj = 0; bj < 2; ++bj)
#pragma unroll
                    for (int n = 0; n < 2; ++n) hl[(((2 * ai + wr) * 2 + (fr - 14)) * 2 + bj) * 32 + (cin >> 2) + n] = acc[ai][bj][3][n];
            if (wr == 1) {
#pragma unroll
                for (int bj = 0; bj < 2; ++bj)
#pragma unroll
                    for (int n = 0; n < 2; ++n) *(f32x4*)(UH + (size_t)(u.pm * 4 + 2 + (fr - 14)) * ff2 + bj * ff + j0 + 4 * n) = acc[1][bj][3][n];
            }
        }
        if (wr == 0 && fr < 2) {
#pragma unroll
            for (int bj = 0; bj < 2; ++bj)
#pragma unroll
                for (int n = 0; n < 2; ++n) *(f32x4*)(UH + (size_t)(u.pm * 4 + fr) * ff2 + bj * ff + j0 + 4 * n) = acc[0][bj][0][n];
        }
        f32x4 wA[3][2], wV[3][2], bA[2], bV[2];
#pragma unroll
        for (int n = 0; n < 2; ++n) {
#pragma unroll
            for (int tp = 0; tp < 3; ++tp) { wA[tp][n] = *(const f32x4*)(cw + (size_t)tp * ff2 + j0 + 4 * n); wV[tp][n] = *(const f32x4*)(cw + (size_t)tp * ff2 + ff + j0 + 4 * n); }
            bA[n] = *(const f32x4*)(cb + j0 + 4 * n); bV[n] = *(const f32x4*)(cb + ff + j0 + 4 * n); }
        asm volatile("s_waitcnt lgkmcnt(0)" ::: "memory"); __builtin_amdgcn_s_barrier(); asm volatile("" ::: "memory");
#pragma unroll
        for (int ai = 0; ai < 2; ++ai) {
            const int g = 2 * ai + wr;
#pragma unroll
            for (int m = 0; m < 4; ++m) {
                const int row = u.pm * BM + ai * HALF + wr * 64 + m * 16 + fr;
                f32x4 y[2][2];
#pragma unroll
                for (int bj = 0; bj < 2; ++bj)
#pragma unroll
                    for (int n = 0; n < 2; ++n) {
                        const f32x4 cur = acc[ai][bj][m][n];
                        const f32x4 w0 = bj ? wV[0][n] : wA[0][n], w1 = bj ? wV[1][n] : wA[1][n], w2 = bj ? wV[2][n] : wA[2][n], bb = bj ? bV[n] : bA[n];
                        f32x4 o;
                        if (m == 0) {
                            f32x4 p62, p63;
                            if (g == 0) { p62 = (f32x4){0.f, 0.f, 0.f, 0.f}; p63 = p62; }
                            else { p62 = hl[(((g - 1) * 2 + 0) * 2 + bj) * 32 + (cin >> 2) + n]; p63 = hl[(((g - 1) * 2 + 1) * 2 + bj) * 32 + (cin >> 2) + n]; }
#pragma unroll
                            for (int e = 0; e < 4; ++e) { const float xx = dpp_f(p62[e], p63[e], 0);
                                const float pr1 = dpp_f(p63[e], cur[e], 0), pr2 = dpp_f(xx, cur[e], 1);
                                o[e] = bb[e] + w0[e] * pr2 + w1[e] * pr1 + w2[e] * cur[e]; }
                        } else {
#pragma unroll
                            for (int h = 0; h < 2; ++h) {
                                f32x2 pr1, pr2;
#pragma unroll
                                for (int q = 0; q < 2; ++q) { const int pv = __float_as_int(acc[ai][bj][m - 1][n][2 * h + q]), cv = __float_as_int(cur[2 * h + q]);
                                    pr1[q] = __int_as_float(__builtin_amdgcn_update_dpp(__builtin_amdgcn_mov_dpp(pv, 0x121, 0xF, 0xF, false), cv, 0x111, 0xF, 0xF, false));
                                    pr2[q] = __int_as_float(__builtin_amdgcn_update_dpp(__builtin_amdgcn_mov_dpp(pv, 0x122, 0xF, 0xF, false), cv, 0x112, 0xF, 0xF, false)); }
                                const f32x2 c2 = {cur[2 * h], cur[2 * h + 1]}, w02 = {w0[2 * h], w0[2 * h + 1]}, w12 = {w1[2 * h], w1[2 * h + 1]}, w22 = {w2[2 * h], w2[2 * h + 1]}, bb2 = {bb[2 * h], bb[2 * h + 1]};
                                const f32x2 o2 = bb2 + w02 * pr2 + w12 * pr1 + w22 * c2;
                                o[2 * h] = o2[0]; o[2 * h + 1] = o2[1]; }
                        }
                        y[bj][n] = o;
                    }
                u32x4 w;
                { const f32x4 a0 = y[0][0], a1 = y[0][1], v0 = y[1][0], v1 = y[1][1];
                  w.x = cvt_pk_bf16(silu_f(a0[0]) * v0[0], silu_f(a0[1]) * v0[1]); w.y = cvt_pk_bf16(silu_f(a0[2]) * v0[2], silu_f(a0[3]) * v0[3]);
                  w.z = cvt_pk_bf16(silu_f(a1[0]) * v1[0], silu_f(a1[1]) * v1[1]); w.w = cvt_pk_bf16(silu_f(a1[2]) * v1[2], silu_f(a1[3]) * v1[3]); }
                const bool skip = (g == 0) && (m == 0) && (fr < 2) && (u.pm > 0);
                if (!skip) *(u32x4*)(ACT + (size_t)row * ff + j0) = w;
            }
        }
    }
};

template <class Epi, class Sched, bool ALIGN_EPI = false, bool SP2 = false>
__device__ __forceinline__ void gemm_phase(PG8_LAS unsigned char* lds, const Gemm g, const Sched& S, const Epi& E, int wid) {
    const int lane = lane_id(), tid = wid * 64 + lane, wr = wid >> 2, wc = wid & 3, fr = lane & 15, fq = lane >> 4;
    const int K = g.K, nt = K / BK;
    unsigned voffA[2], voffB[2];
#pragma unroll
    for (int i = 0; i < 2; ++i) { int R, C; stage_rc(tid * 16 + i * 8192, R, C); const int Rb = Epi::PERM ? ((R & ~31) + perm32(R & 31)) : R;
        voffA[i] = (unsigned)(R * K + C) * 2u; voffB[i] = (unsigned)(Rb * K + C) * 2u; }
    const size_t kstep = (size_t)(BK * 2);
    const size_t hstep = (size_t)HALF * K * 2;
    const size_t tstep = 2 * hstep;
    const unsigned ldsw = (unsigned)wid * 1024u;
    const int aoff = lds_byte(wr * 64 + fr, fq * 8), boff = lds_byte(wc * 32 + fr, fq * 8);
#define PG8_SA(b, h) (((b) * 2 + (h)) * HTB)
#define PG8_SB(b, h) ((4 + (b) * 2 + (h)) * HTB)
#define PG8_STAGE(bufoff, gbase, voff) do { _Pragma("unroll") for (int _i = 0; _i < 2; ++_i) \
        __builtin_amdgcn_global_load_lds((const unsigned*)((const char*)(gbase) + (voff)[_i]), (PG8_LAS unsigned*)(lds + (bufoff) + ldsw + _i * 8192), 16, 0, 0); } while (0)
#define PG8_LDA(dst, b, h) do { _Pragma("unroll") for (int m = 0; m < 4; ++m) _Pragma("unroll") for (int k = 0; k < 2; ++k) dst[m][k] = *(const PG8_LAS bf16x8*)(lds + PG8_SA(b, h) + aoff + m * 2048 + k * 1024); } while (0)
#define PG8_LDB(dst, b, h) do { _Pragma("unroll") for (int n = 0; n < 2; ++n) _Pragma("unroll") for (int k = 0; k < 2; ++k) dst[n][k] = *(const PG8_LAS bf16x8*)(lds + PG8_SB(b, h) + boff + n * 2048 + k * 1024); } while (0)
#define PG8_MMA(ai, bj, At, Bt) do { __builtin_amdgcn_s_setprio(1); _Pragma("unroll") for (int m = 0; m < 4; ++m) _Pragma("unroll") for (int n = 0; n < 2; ++n) _Pragma("unroll") for (int k = 0; k < 2; ++k) \
        acc[ai][bj][m][n] = __builtin_amdgcn_mfma_f32_16x16x32_bf16(Bt[n][k], At[m][k], acc[ai][bj][m][n], 0, 0, 0); __builtin_amdgcn_s_setprio(0); } while (0)
#define PG8_WAIT_V(n) asm volatile("s_waitcnt vmcnt(" #n ")" ::: "memory")
#define PG8_WAIT_L(n) asm volatile("s_waitcnt lgkmcnt(" #n ")" ::: "memory")
#define PG8_BAR __builtin_amdgcn_s_barrier()
#define PG8_SCHED __builtin_amdgcn_sched_barrier(0)
    Unit cur, nxt; int ui = 0;
    if (!S.next(0, cur)) return;
    f32x4 acc[2][2][4][2];
#pragma unroll
    for (int a = 0; a < 2; ++a)
#pragma unroll
        for (int b = 0; b < 2; ++b)
#pragma unroll
            for (int m = 0; m < 4; ++m)
#pragma unroll
                for (int n = 0; n < 2; ++n) acc[a][b][m][n] = (f32x4){0.f, 0.f, 0.f, 0.f};
    bf16x8 At[4][2], B0[2][2], B1[2][2];
    const char* cA = (const char*)g.A + (size_t)cur.pm * tstep; const char* cB = (const char*)g.Bt + (size_t)cur.pn * tstep;
    S.a_ready(cur);
    if constexpr (SP2) {
        PG8_STAGE(PG8_SB(0, 0), cB, voffB); PG8_STAGE(PG8_SB(0, 1), cB + hstep, voffB); PG8_STAGE(PG8_SA(0, 0), cA, voffA); PG8_STAGE(PG8_SA(0, 1), cA + hstep, voffA);
        if (wr == 1) PG8_BAR;
        PG8_WAIT_V(2); PG8_BAR;
        PG8_STAGE(PG8_SB(1, 0), cB + kstep, voffB); PG8_STAGE(PG8_SA(1, 0), cA + kstep, voffA); PG8_STAGE(PG8_SB(1, 1), cB + hstep + kstep, voffB);
        PG8_WAIT_V(6); PG8_BAR;
    } else {
        PG8_STAGE(PG8_SB(0, 0), cB, voffB); PG8_STAGE(PG8_SA(0, 0), cA, voffA); PG8_STAGE(PG8_SB(0, 1), cB + hstep, voffB); PG8_STAGE(PG8_SA(0, 1), cA + hstep, voffA);
        if (wr == 1) PG8_BAR;
        PG8_WAIT_V(4); PG8_BAR;
        PG8_STAGE(PG8_SB(1, 0), cB + kstep, voffB); PG8_STAGE(PG8_SA(1, 0), cA + kstep, voffA); PG8_STAGE(PG8_SB(1, 1), cB + hstep + kstep, voffB);
        PG8_WAIT_V(6); PG8_BAR;
    }
    for (;;) {
        const bool has_next = S.next(ui + 1, nxt);
        const char* nA = has_next ? (const char*)g.A + (size_t)nxt.pm * tstep : cA; const char* nB = has_next ? (const char*)g.Bt + (size_t)nxt.pn * tstep : cB;
        for (int t = 0; t < nt; t += 2) {
            const bool last = (t == nt - 2);
            const char* a1 = cA + (size_t)(t + 1) * kstep;
            const char* a2 = last ? nA : cA + (size_t)(t + 2) * kstep; const char* b2 = last ? nB : cB + (size_t)(t + 2) * kstep;
            const char* a3 = a2 + kstep; const char* b3 = b2 + kstep;
            if (last && has_next) S.a_ready(nxt);
            if constexpr (SP2) {
            PG8_LDB(B0, 0, 0); PG8_LDB(B1, 0, 1); PG8_SCHED; PG8_LDA(At, 0, 0); PG8_STAGE(PG8_SA(1, 1), a1 + hstep, voffA);
            PG8_WAIT_V(8); PG8_WAIT_L(0); PG8_BAR; PG8_MMA(0, 0, At, B0); PG8_MMA(0, 1, At, B1); PG8_BAR; PG8_SCHED;
            PG8_LDA(At, 0, 1); PG8_STAGE(PG8_SB(0, 0), b2, voffB); PG8_STAGE(PG8_SB(0, 1), b2 + hstep, voffB); PG8_STAGE(PG8_SA(0, 0), a2, voffA);
            PG8_WAIT_V(8); PG8_WAIT_L(0); PG8_BAR; PG8_MMA(1, 0, At, B0); PG8_MMA(1, 1, At, B1); PG8_BAR; PG8_SCHED;
            PG8_LDB(B0, 1, 0); PG8_LDB(B1, 1, 1); PG8_SCHED; PG8_LDA(At, 1, 0); PG8_STAGE(PG8_SA(0, 1), a2 + hstep, voffA);
            PG8_WAIT_V(8); PG8_WAIT_L(0); PG8_BAR; PG8_MMA(0, 0, At, B0); PG8_MMA(0, 1, At, B1); PG8_BAR; PG8_SCHED;
            PG8_LDA(At, 1, 1); PG8_STAGE(PG8_SB(1, 0), b3, voffB); PG8_STAGE(PG8_SB(1, 1), b3 + hstep, voffB); PG8_STAGE(PG8_SA(1, 0), a3, voffA);
            PG8_WAIT_V(8); PG8_WAIT_L(0); PG8_BAR; PG8_MMA(1, 0, At, B0); PG8_MMA(1, 1, At, B1); PG8_BAR; PG8_SCHED;
            } else {
            PG8_LDB(B0, 0, 0); PG8_SCHED; PG8_LDA(At, 0, 0); PG8_STAGE(PG8_SA(1, 1), a1 + hstep, voffA);
            PG8_WAIT_L(8); PG8_BAR; PG8_WAIT_L(0); PG8_MMA(0, 0, At, B0); PG8_BAR; PG8_SCHED;
            PG8_LDB(B1, 0, 1); PG8_STAGE(PG8_SB(0, 0), b2, voffB);
            PG8_BAR; PG8_WAIT_L(0); PG8_MMA(0, 1, At, B1); PG8_BAR;
            PG8_LDA(At, 0, 1); PG8_STAGE(PG8_SA(0, 0), a2, voffA);
            PG8_BAR; PG8_WAIT_L(0); PG8_MMA(1, 0, At, B0); PG8_BAR; PG8_SCHED;
            PG8_STAGE(PG8_SB(0, 1), b2 + hstep, voffB);
            PG8_WAIT_V(6); PG8_BAR; PG8_MMA(1, 1, At, B1); PG8_BAR;
            PG8_LDB(B0, 1, 0); PG8_SCHED; PG8_LDA(At, 1, 0); PG8_STAGE(PG8_SA(0, 1), a2 + hstep, voffA);
            PG8_WAIT_L(8); PG8_BAR; PG8_WAIT_L(0); PG8_MMA(0, 0, At, B0); PG8_BAR; PG8_SCHED;
            PG8_LDB(B1, 1, 1); PG8_STAGE(PG8_SB(1, 0), b3, voffB);
            PG8_BAR; PG8_WAIT_L(0); PG8_MMA(0, 1, At, B1); PG8_BAR;
            PG8_LDA(At, 1, 1); PG8_STAGE(PG8_SA(1, 0), a3, voffA);
            PG8_BAR; PG8_WAIT_L(0); PG8_MMA(1, 0, At, B0); PG8_BAR; PG8_SCHED;
            PG8_STAGE(PG8_SB(1, 1), b3 + hstep, voffB);
            PG8_WAIT_V(6); PG8_BAR; PG8_MMA(1, 1, At, B1); PG8_BAR;
            }
        }
        if constexpr (ALIGN_EPI) { if (wr == 0) PG8_BAR; }
        if constexpr (!Epi::AFTER_DRAIN) { E(acc, cur, wr, wc, fr, fq); S.done(cur); }
        if (!has_next) break;
#pragma unroll
        for (int a = 0; a < 2; ++a)
#pragma unroll
            for (int b = 0; b < 2; ++b)
#pragma unroll
                for (int m = 0; m < 4; ++m)
#pragma unroll
                    for (int n = 0; n < 2; ++n) acc[a][b][m][n] = (f32x4){0.f, 0.f, 0.f, 0.f};
        cur = nxt; cA = nA; cB = nB; ++ui;
        if constexpr (ALIGN_EPI) { if (wr == 1) PG8_BAR; }
    }
    PG8_WAIT_V(0);
    if constexpr (!ALIGN_EPI) { if (wr == 0) PG8_BAR; }
    PG8_BAR;
    if constexpr (Epi::AFTER_DRAIN) { E.fused(acc, cur, wr, wc, fr, fq, lds, wid, lane); S.done(cur); }
#undef PG8_SA
#undef PG8_SB
#undef PG8_STAGE
#undef PG8_LDA
#undef PG8_LDB
#undef PG8_MMA
#undef PG8_WAIT_V
#undef PG8_WAIT_L
#undef PG8_BAR
#undef PG8_SCHED
}
}


#define GAS __attribute__((address_space(1)))
#define LAS __attribute__((address_space(3)))
typedef unsigned short bf16;
typedef unsigned v4u __attribute__((ext_vector_type(4)));
typedef float f32x4 __attribute__((ext_vector_type(4)));
typedef short bf16x8 __attribute__((ext_vector_type(8)));
typedef GAS unsigned gu32;
typedef GAS unsigned long long gu64;
#define RLX_AGENT __ATOMIC_RELAXED, __HIP_MEMORY_SCOPE_AGENT
#define LDS_WAIT() asm volatile("s_waitcnt lgkmcnt(0)" ::: "memory")
#define VM_WAIT() asm volatile("s_waitcnt vmcnt(0)" ::: "memory")
__device__ __forceinline__ unsigned long long rt() { return __builtin_amdgcn_s_memrealtime(); }
__device__ __forceinline__ unsigned f2bf(float f) { unsigned u = __builtin_bit_cast(unsigned, f); return (u + 0x7fffu + ((u >> 16) & 1u)) >> 16; }
__device__ __forceinline__ unsigned pk2(float lo, float hi) { return f2bf(lo) | (f2bf(hi) << 16); }

#define XB_TMO      128
#define XB_XCNT(j)  (256  + 64 * (j))
#define XB_XSUB(j)  (1280 + 64 * (j))
#define XB_XGEN(j)  (2304 + 64 * (j))
#define XB_TOP      3328
#define XB_TOPGEN   3392
#define XCD_BAR_WORDS 3456
#define XB_SPIN_CAP (1u << 18)

__device__ __forceinline__ unsigned xb_ld(unsigned* p)              { return __hip_atomic_load(p, __ATOMIC_RELAXED, __HIP_MEMORY_SCOPE_AGENT); }
__device__ __forceinline__ unsigned xb_add(unsigned* p, unsigned v) { return __hip_atomic_fetch_add(p, v, __ATOMIC_RELAXED, __HIP_MEMORY_SCOPE_AGENT); }
__device__ __forceinline__ unsigned xb_xcc_id() { return (unsigned)__builtin_amdgcn_s_getreg((3 << 11) | 20) & 0xFu; }
#define XB_SPIN(cond, bar) do { unsigned _sp = 0; while (cond) { __builtin_amdgcn_s_sleep(1); \
    if ((++_sp & 255u) == 0u) { if (xb_ld(&(bar)[XB_TMO])) break; if (_sp > XB_SPIN_CAP) { atomicAdd(&(bar)[XB_TMO], 1u); break; } } } } while (0)

struct XcdBarrier {
    unsigned* bar; unsigned x;
    volatile LAS unsigned* st;
};

__device__ __forceinline__ XcdBarrier xcd_barrier_post(unsigned* bar, volatile LAS unsigned* st) {
    XcdBarrier b; b.bar = bar; b.x = xb_xcc_id(); b.st = st;
    if (threadIdx.x == 0) (void)xb_add(&bar[XB_XCNT(b.x)], 1u);
    return b;
}
__device__ __forceinline__ void xcd_barrier_complete(unsigned* bar, unsigned x, unsigned& nloc, unsigned& nx) {
    const unsigned G = gridDim.x * gridDim.y * gridDim.z;
    unsigned sum, cnt, mine, sp = 0u;
    for (;;) {
        sum = 0u; cnt = 0u; mine = 0u;
#pragma unroll
        for (unsigned j = 0; j < 16; ++j) { const unsigned c = xb_ld(&bar[XB_XCNT(j)]); sum += c; cnt += (c > 0u) ? 1u : 0u; mine = (j == x) ? c : mine; }
        if (sum == G) break;
        __builtin_amdgcn_s_sleep(1);
        if ((++sp & 255u) == 0u) { if (xb_ld(&bar[XB_TMO])) break; if (sp > XB_SPIN_CAP) { atomicAdd(&bar[XB_TMO], 1u); break; } }
    }
    nloc = mine > 0u ? mine : 1u; nx = cnt > 0u ? cnt : 1u;
}

__device__ __forceinline__ void xcd_barrier(const XcdBarrier& b) {
    asm volatile("s_waitcnt vmcnt(0)" ::: "memory");
    __syncthreads();
    if (threadIdx.x == 0) {
        unsigned* bar = b.bar;
        __builtin_amdgcn_s_waitcnt(0);
        unsigned nloc = b.st[0], nx = b.st[1];
        if (nloc == 0u) { xcd_barrier_complete(bar, b.x, nloc, nx); b.st[0] = nloc; b.st[1] = nx; }
        const unsigned old = xb_add(&bar[XB_XSUB(b.x)], 1u);
        const unsigned gen = old / nloc;
        if (old + 1u == (gen + 1u) * nloc) {
            __builtin_amdgcn_fence(__ATOMIC_RELEASE, "agent");
            asm volatile("s_waitcnt vmcnt(0)" ::: "memory");
            const unsigned og = xb_add(&bar[XB_TOP], 1u);
            const unsigned tg = og / nx;
            if (og + 1u == (tg + 1u) * nx) xb_add(&bar[XB_TOPGEN], 1u);
            else XB_SPIN(xb_ld(&bar[XB_TOPGEN]) == tg, bar);
            __builtin_amdgcn_fence(__ATOMIC_ACQUIRE, "agent");
            xb_add(&bar[XB_XGEN(b.x)], 1u);
            asm volatile("s_waitcnt vmcnt(0)" ::: "memory");
        } else {
            XB_SPIN(xb_ld(&bar[XB_XGEN(b.x)]) == gen, bar);
            __builtin_amdgcn_fence(__ATOMIC_ACQUIRE, "agent");
            asm volatile("s_waitcnt vmcnt(0)" ::: "memory");
        }
    }
    __syncthreads();
}


constexpr size_t MiB = 1u << 20;
constexpr size_t WS_CTL = 0, CTL_ZERO_BYTES = 32 * 1024;
constexpr size_t WS_PART = 1 * MiB;
constexpr size_t WS_MOD = 3 * MiB, WS_LB = 3 * MiB + 128 * 1024;
constexpr size_t WS_LF = 4 * MiB, WS_CL = 5 * MiB, WS_BB = 6 * MiB;
constexpr size_t WS_DBT = 6 * MiB + 65536;
constexpr size_t WS_NRM = 7 * MiB;
constexpr size_t WS_WF = 8 * MiB;
constexpr size_t WS_WIN = 16 * MiB, WS_WO = 128 * MiB, WS_WUP = 160 * MiB, WS_WD = 332 * MiB;
constexpr size_t WS_H = 418 * MiB;
constexpr size_t WS_PROJ = 482 * MiB;
constexpr size_t WS_MIX = 706 * MiB;
constexpr size_t WS_D1 = 770 * MiB, WS_D2 = 834 * MiB;
constexpr size_t WS_HU = 898 * MiB, WS_HS = 1026 * MiB, WS_HD = 1090 * MiB;
constexpr size_t WS_UH = 898 * MiB;
constexpr size_t WS_ACT = 482 * MiB;
constexpr size_t WS_OFOX = 1100 * MiB, WS_OHG = 1164 * MiB, WS_END = 1228 * MiB;
constexpr int CW_BAR = 4096;
constexpr int CW_WD = 128;
constexpr int KSPLIT = 16;
constexpr int KSPLIT_A = 4;

constexpr int RING_BYTES = 133120  , LDSCTL_OFF = RING_BYTES, MISC_OFF = LDSCTL_OFF + 320, HALO_OFF = RING_BYTES + 1024  , LDS_BYTES = 147456;

enum { PC_PRO = 0, PC_MODR = 1, PC_NORM1 = 2, PC_CUM = 3, PC_GEMM1 = 4, PC_HGA = 5, PC_HGB = 6, PC_HGC = 7, PC_ATTN = 8, PC_GEMM2 = 9, PC_NORM2 = 10, PC_GEMM3 = 11, PC_CONV = 12, PC_GEMM4 = 13, PC_FNORM = 14, PC_N = 15 };

struct Args { const float* in[17]; float* out; unsigned char* ws; unsigned mask; unsigned pad; };

__device__ __forceinline__ float wave_sum(float v) {
#pragma unroll
    for (int o = 1; o < 64; o <<= 1) v += __shfl_xor(v, o);
    return v;
}
__device__ __forceinline__ float sigm_f(float z) { return __builtin_amdgcn_rcpf(1.0f + __builtin_amdgcn_exp2f(-LOG2E * z)); }
__device__ __forceinline__ float silu2_f(float z) { return z * sigm_f(z); }

#ifndef WD_PRO_KB
#define WD_PRO_KB 0
#endif
constexpr int WD_PRO_ITEMS = WD_PRO_KB * (D / 64), WD_DEFER_ITEMS = (FF / 64) * (D / 64) - WD_PRO_ITEMS;
struct TrItem { const float* src; bf16* dst; int ldw, ldt; int nt; };
__device__ __forceinline__ void tr_load(const TrItem& it, f32x4 (&r)[16], int lane) {
    const int a4 = (lane & 15) * 4, kr = lane >> 4;
#pragma unroll
#ifdef TRLOAD_PLAIN
    for (int i = 0; i < 16; ++i) r[i] = *((const GAS f32x4*)(it.src + (size_t)(4 * i + kr) * it.ldw + a4));
#else
    for (int i = 0; i < 16; ++i) r[i] = __builtin_nontemporal_load((const GAS f32x4*)(it.src + (size_t)(4 * i + kr) * it.ldw + a4));
#endif
}
__device__ __forceinline__ void tr_store(const TrItem& it, const f32x4 (&r)[16], LAS float* scr, int lane) {
    const int a4 = (lane & 15) * 4, kr = lane >> 4;
#pragma unroll
    for (int i = 0; i < 16; ++i) { LAS float* d = scr + (4 * i + kr) * 65 + a4; d[0] = r[i].x; d[1] = r[i].y; d[2] = r[i].z; d[3] = r[i].w; }
    LDS_WAIT(); asm volatile("" ::: "memory");
    const int c = lane & 7;
#pragma unroll
    for (int j = 0; j < 8; ++j) { const int n = (lane >> 3) + 8 * j; const LAS float* s = scr + (8 * c) * 65 + n;
        v4u o; o.x = pk2(s[0 * 65], s[1 * 65]); o.y = pk2(s[2 * 65], s[3 * 65]); o.z = pk2(s[4 * 65], s[5 * 65]); o.w = pk2(s[6 * 65], s[7 * 65]);
        GAS v4u* dp = (GAS v4u*)(it.dst + (size_t)n * it.ldt + 8 * c); if (it.nt) __builtin_nontemporal_store(o, dp); else *dp = o; }
    LDS_WAIT(); asm volatile("" ::: "memory");
}
__device__ __forceinline__ TrItem tr_mk(const float* W, int ldw, int c0, int k0, bf16* WT, int ldt, int drow0, int nt = 0) { TrItem t; t.src = W + (size_t)k0 * ldw + c0; t.dst = WT + (size_t)drow0 * ldt + k0; t.ldw = ldw; t.ldt = ldt; t.nt = nt; return t; }
__device__ __forceinline__ void tr_item(const float* W, int ldw, int c0, int k0, bf16* WT, int ldt, int drow0, LAS float* scr, int lane) {
    const TrItem t = tr_mk(W, ldw, c0, k0, WT, ldt, drow0); f32x4 r[16]; tr_load(t, r, lane); tr_store(t, r, scr, lane);
}
template <int PARTS>
__device__ __forceinline__ void ph_prologue(const Args* ka, LAS unsigned char* lds, int vcu, int G, int tid, int lane, int wave) {
    unsigned char* ws = ka->ws;
    const float* c = ka->in[1]; const float* w_ada = ka->in[2]; const float* w_in = ka->in[5]; const float* lbl = ka->in[7];
    const float* w_out = ka->in[10]; const float* w_up = ka->in[12]; const float* w_down = ka->in[15];
#ifdef TOUCH_X
    if constexpr (PARTS & 1) {
        const float* xp = ka->in[0]; float acc_ = 0.f;
        for (int i = vcu * 512 + tid; i < (int)(((size_t)T * D * 4) / TOUCH_X); i += G * 512) acc_ += __builtin_nontemporal_load(xp + (size_t)i * (TOUCH_X / 4));
        if (acc_ == 1.2345e-38f) ((float*)(ws + WS_PART))[0] = acc_;
    }
#endif
    LAS float* sc_ = (LAS float*)lds;
    for (int i = tid; i < D; i += 512) sc_[i] = silu2_f(c[i]);
    __syncthreads();
    float* part = (float*)(ws + WS_PART);
    constexpr int NCG = NMOD / 4, KROWS = D / KSPLIT, CG0 = (PARTS & 1) ? 0 : 2 * D / 4, CG1 = (PARTS & 2) ? NCG : 2 * D / 4, NCGP = CG1 - CG0;
    if constexpr (PARTS == 1) {
        static_assert(KSPLIT_A * (2 * D / 4 / 32) == 256, "one block per workgroup of a 256-workgroup grid");
        for (int blk = vcu; blk < KSPLIT_A * (2 * D / 4 / 32); blk += G) {
            const int ks = blk & (KSPLIT_A - 1), cg = (blk / KSPLIT_A) * 32 + (tid & 31), kk = tid >> 5;
            const GAS f32x4* wp = (const GAS f32x4*)(w_ada + (size_t)(ks * (D / KSPLIT_A) + kk) * NMOD) + cg;
            f32x4 acc = {0.f, 0.f, 0.f, 0.f};
#pragma unroll 8
            for (int j = 0; j < D / KSPLIT_A / 16; ++j) { const f32x4 w = __builtin_nontemporal_load(wp + (size_t)(16 * j) * NCG); acc += w * sc_[ks * (D / KSPLIT_A) + kk + 16 * j]; }
            LAS f32x4* red = (LAS f32x4*)(lds + 16384);
            red[tid] = acc;
            __syncthreads();
            if (tid < 32) { f32x4 t = red[tid];
#pragma unroll
                for (int q = 1; q < 16; ++q) t += red[tid + 32 * q];
                ((GAS f32x4*)(part + (size_t)ks * NMOD))[cg] = t; }
            __syncthreads();
        }
    } else
    for (int it = vcu * 512 + tid; it < KSPLIT * NCGP; it += G * 512) {
        const int ks = it / NCGP, cg = CG0 + it % NCGP;
        const GAS f32x4* wp = (const GAS f32x4*)(w_ada + (size_t)(ks * KROWS) * NMOD) + cg;
        f32x4 acc = {0.f, 0.f, 0.f, 0.f};
#pragma unroll 8
        for (int k = 0; k < KROWS; ++k) { const f32x4 w = __builtin_nontemporal_load(wp + (size_t)k * NCG); acc += w * sc_[ks * KROWS + k]; }
        ((GAS f32x4*)(part + (size_t)ks * NMOD))[cg] = acc;
    }
    if constexpr (PARTS & 1) {
    float* lb = (float*)(ws + WS_LB);
    for (int i = vcu * 512 + tid; i < 2048; i += G * 512) lb[i] = 1.0f / (1.0f + __expf(-(lbl[i] - lbl[2048 + i])));
    bf16* WfT = (bf16*)(ws + WS_WF);
    for (int i = vcu * 512 + tid; i < 16 * D; i += G * 512) { const int k = i >> 4, n = i & 15; WfT[(size_t)n * D + k] = (bf16)f2bf(w_in[(size_t)k * INC + FOX_F0 + n]); }
    }
    __syncthreads();
    LAS float* scr = (LAS float*)(lds + wave * 16640);
    const int gw = vcu * 8 + wave, NGW = G * 8;
    constexpr int NB_A = FOX_F0 / 64, NB_B = (NPROJ - FOX_F0) / 64, NB_C = D / 64, NB_D = FF2 / 64, NB_E = D / 64;
    constexpr int I_A = 64 * NB_A, I_B = 64 * NB_B, I_C = 64 * NB_C, I_D = 64 * NB_D, I_E = WD_PRO_ITEMS  , NITEMS = I_A + I_B + I_C + I_D + I_E;
    bf16* WinT = (bf16*)(ws + WS_WIN); bf16* WoT = (bf16*)(ws + WS_WO); bf16* WupT = (bf16*)(ws + WS_WUP); bf16* WdT = (bf16*)(ws + WS_WD);
    auto decode = [&](int it) -> TrItem { int r = it;
        if (r < I_A) { const int kb = 8 * ((r >> 3) / NB_A) + (r & 7), nb = (r >> 3) % NB_A; return tr_mk(w_in, INC, 64 * nb, 64 * kb, WinT, D, 64 * nb); } r -= I_A;
        if (r < I_B) { const int kb = 8 * ((r >> 3) / NB_B) + (r & 7), nb = (r >> 3) % NB_B; return tr_mk(w_in, INC, HG_Q0 + 64 * nb, 64 * kb, WinT, D, FOX_F0 + 64 * nb); } r -= I_B;
        if (r < I_C) { const int kb = 8 * ((r >> 3) / NB_C) + (r & 7), nb = (r >> 3) % NB_C; return tr_mk(w_out, D, 64 * nb, 64 * kb, WoT, D, 64 * nb, 1); } r -= I_C;
        if (r < I_D) { const int kb = 8 * ((r >> 3) / NB_D) + (r & 7), nb = (r >> 3) % NB_D; const int c0 = 64 * nb, cc = c0 < FF ? c0 : c0 - FF; return tr_mk(w_up, FF2, c0, 64 * kb, WupT, D, 256 * (cc >> 7) + (c0 < FF ? 0 : 128) + (cc & 127), 1); } r -= I_D;
        { const int kb = r / NB_E, nb = r % NB_E; return tr_mk(w_down, D, 64 * nb, 64 * kb, WdT, FF, 64 * nb); } };
    f32x4 ra[16], rb[16];
    constexpr int IT0 = (PARTS & 1) ? 0 : I_A + I_B, IT1 = (PARTS & 2) ? NITEMS : I_A + I_B;
    static_assert(I_E == 0, "the w_down items sit behind the deferred ones");
    int it = IT0 + gw;
    if (it < IT1) { TrItem ta = decode(it); tr_load(ta, ra, lane);
        for (;;) {
            const int itb = it + NGW; const bool hb = itb < IT1; TrItem tb = ta; if (hb) { tb = decode(itb); tr_load(tb, rb, lane); }
            tr_store(ta, ra, scr, lane);
            if (!hb) break;
            const int itc = itb + NGW; const bool hc = itc < IT1; if (hc) { ta = decode(itc); tr_load(ta, ra, lane); }
            tr_store(tb, rb, scr, lane);
            if (!hc) break;
            it = itc;
        }
    }
}
__device__ __forceinline__ void ph_convert_wd(const Args* ka, LAS unsigned char* lds, int rank, int nrank, int wave) {
    const int lane = lane_id(); const float* w_down = ka->in[15]; bf16* WdT = (bf16*)(ka->ws + WS_WD);
    LAS float* scr = (LAS float*)(lds + wave * 16640);
    for (int r0 = rank * 8 + wave; r0 < WD_DEFER_ITEMS; r0 += nrank * 8) { const int r = r0 + WD_PRO_ITEMS, kb = r / (D / 64), nb = r % (D / 64); tr_item(w_down, D, 64 * nb, 64 * kb, WdT, FF, 64 * nb, scr, lane); }
}
__device__ __forceinline__ void ph_convert_wd_dyn(const Args* ka, LAS unsigned char* lds, int wave) {
    const int lane = lane_id(); const float* w_down = ka->in[15]; bf16* WdT = (bf16*)(ka->ws + WS_WD);
    unsigned* ctr = (unsigned*)(ka->ws + WS_CTL) + CW_WD;
    LAS float* scr = (LAS float*)(lds + wave * 16640);
#ifndef WD_CHUNK
#define WD_CHUNK 8
#endif
    int cur = 0, end = 0;
    auto next = [&]() -> int { if (cur == end) { unsigned v = 0u; if (lane == 0) v = xb_add(ctr, 1u); cur = (int)__builtin_amdgcn_readfirstlane(v) * WD_CHUNK; end = cur + WD_CHUNK; } return cur++; };
    auto mk = [&](int r0) -> TrItem { const int r = r0 + WD_PRO_ITEMS, kb = r / (D / 64), nb = r % (D / 64); return tr_mk(w_down, D, 64 * nb, 64 * kb, WdT, FF, 64 * nb); };
    static_assert(WD_DEFER_ITEMS % WD_CHUNK == 0, "whole chunks");
    f32x4 ra[16], rb[16];
    const int ia = next();
    if (ia >= WD_DEFER_ITEMS) return;
    TrItem ta = mk(ia); tr_load(ta, ra, lane);
    for (;;) {
        const int ib = next(); const bool hb = ib < WD_DEFER_ITEMS; TrItem tb = ta; if (hb) { tb = mk(ib); tr_load(tb, rb, lane); }
        tr_store(ta, ra, scr, lane);
        if (!hb) break;
        const int ic = next(); const bool hc = ic < WD_DEFER_ITEMS; if (hc) { ta = mk(ic); tr_load(ta, ra, lane); }
        tr_store(tb, rb, scr, lane);
        if (!hc) break;
    }
}
__device__ __forceinline__ void ph_modreduce(const Args* ka, int i0, int vcu, int G, int tid) {
    const float* part = (const float*)(ka->ws + WS_PART); const float* b = ka->in[3]; float* mod = (float*)(ka->ws + WS_MOD);
    for (int i = i0 + vcu * 512 + tid; i < NMOD; i += G * 512) { float s = b[i];
#pragma unroll
        for (int ks = 0; ks < KSPLIT; ++ks) s += part[(size_t)ks * NMOD + i];
        mod[i] = s; }
}
template <bool FGATE>
__device__ __forceinline__ void ph_norm(const float* x, const bf16* d1, const float* g, const float* sh, const float* sc, bf16* H, const bf16* WfT, const float* bfox, float* lf, float* modout, int modn,
                                        LAS unsigned char* lds, int vcu, int G, int tid, int lane, int wave) {
    LAS float* A_ = (LAS float*)lds; LAS float* B_ = A_ + D;
    if constexpr (FGATE) {
        const float* part = sh; const float* bada = sc;
#ifndef RED_REP
#define RED_REP 1
#endif
#ifndef FG_REP
#define FG_REP 1
#endif
        const bool blocked = modn < NMOD;
        for (int rr_ = 0; rr_ < RED_REP; ++rr_)
        for (int i4 = tid; i4 < D / 4; i4 += 512) { f32x4 s0 = *(const GAS f32x4*)(bada + 4 * i4), s1 = *(const GAS f32x4*)(bada + D + 4 * i4);
            if (blocked) {
#pragma unroll
                for (int ks = 0; ks < KSPLIT_A; ++ks) { s0 += *(const GAS f32x4*)(part + (size_t)ks * NMOD + 4 * i4); s1 += *(const GAS f32x4*)(part + (size_t)ks * NMOD + D + 4 * i4); }
            } else {
#pragma unroll
            for (int ks = 0; ks < KSPLIT; ++ks) { s0 += *(const GAS f32x4*)(part + (size_t)ks * NMOD + 4 * i4); s1 += *(const GAS f32x4*)(part + (size_t)ks * NMOD + D + 4 * i4); }
            }
            const f32x4 gv = *(const GAS f32x4*)(g + 4 * i4);
            *(LAS f32x4*)(A_ + 4 * i4) = gv * (s1 + 1.0f); *(LAS f32x4*)(B_ + 4 * i4) = s0; }
        const int nred = modn, per = (nred + G - 1) / G, iend = (vcu + 1) * per < nred ? (vcu + 1) * per : nred;
        for (int i = vcu * per + tid; i < iend; i += 512) { float s = bada[i];
            for (int ks = 0; ks < (blocked ? KSPLIT_A : KSPLIT); ++ks) s += part[(size_t)ks * NMOD + i];
            modout[i] = s; }
    } else {
        for (int i = tid; i < D; i += 512) { A_[i] = g[i] * (1.0f + sc[i]); B_[i] = sh[i]; }
    }
    __syncthreads();
    for (int blk = vcu; blk < T / 32; blk += G) {
        const int row0 = blk * 32;
#pragma unroll 1
        for (int j = 0; j < 4; ++j) {
            const int row = row0 + wave * 4 + j;
            const GAS f32x4* xr = (const GAS f32x4*)(x + (size_t)row * D) + lane;
            f32x4 v[16]; float s = 0.f;
#pragma unroll
            for (int jj = 0; jj < 16; ++jj) { v[jj] = __builtin_nontemporal_load(xr + 64 * jj);
                if constexpr (!FGATE) { const unsigned long long dw = ((const GAS unsigned long long*)(d1 + (size_t)row * D) + lane)[64 * jj]; const unsigned w0 = (unsigned)dw, w1 = (unsigned)(dw >> 32);
                    v[jj].x += __uint_as_float(w0 << 16); v[jj].y += __uint_as_float(w0 & 0xffff0000u); v[jj].z += __uint_as_float(w1 << 16); v[jj].w += __uint_as_float(w1 & 0xffff0000u); }
                s += (v[jj].x * v[jj].x + v[jj].y * v[jj].y) + (v[jj].z * v[jj].z + v[jj].w * v[jj].w); }
            const float r = 1.0f / sqrtf(wave_sum(s) * (1.0f / D) + EPS);
            GAS unsigned long long* o8 = (GAS unsigned long long*)(H + (size_t)row * D) + lane;
#pragma unroll
            for (int jj = 0; jj < 16; ++jj) { const f32x4 av = *(const LAS f32x4*)(A_ + 4 * (lane + 64 * jj)), bv = *(const LAS f32x4*)(B_ + 4 * (lane + 64 * jj));
                const f32x4 hv = v[jj] * r * av + bv;
                o8[64 * jj] = (unsigned long long)pk2(hv.x, hv.y) | ((unsigned long long)pk2(hv.z, hv.w) << 32); }
        }
        if constexpr (FGATE) for (int fr_ = 0; fr_ < FG_REP; ++fr_) {
            __syncthreads();
            const int g_ = wave >> 2, kq = wave & 3; f32x4 acc = {0.f, 0.f, 0.f, 0.f};
            const bf16* ap = H + (size_t)(row0 + 16 * g_ + (lane & 15)) * D + kq * 1024 + (lane >> 4) * 8;
            const bf16* bp = WfT + (size_t)(lane & 15) * D + kq * 1024 + (lane >> 4) * 8;
#pragma unroll 16
            for (int s = 0; s < 32; ++s) { const bf16x8 av = *(const GAS bf16x8*)(ap + 32 * s), bv = *(const GAS bf16x8*)(bp + 32 * s); acc = __builtin_amdgcn_mfma_f32_16x16x32_bf16(av, bv, acc, 0, 0, 0); }
            LAS f32x4* red = (LAS f32x4*)(lds + 32768);
            red[wave * 64 + lane] = acc;
            __syncthreads();
            if (kq == 0) { const f32x4 t = (red[(g_ * 4 + 0) * 64 + lane] + red[(g_ * 4 + 1) * 64 + lane]) + (red[(g_ * 4 + 2) * 64 + lane] + red[(g_ * 4 + 3) * 64 + lane]);
                const int head = lane & 15; const float bias = bfox[head];
#pragma unroll
                for (int e = 0; e < 4; ++e) { const float z = t[e] + bias; lf[(size_t)head * T + row0 + 16 * g_ + (lane >> 4) * 4 + e] = fminf(z, 0.f) - log1pf(__expf(-fabsf(z))); } }
            __syncthreads();
        }
    }
}
__device__ __forceinline__ void ph_cum(const Args* ka, LAS unsigned char* lds, int vcu, int tid, int lane) {
    if (vcu >= NH) return;
    const int h = vcu; const float* lf = (const float*)(ka->ws + WS_LF) + (size_t)h * T + tid * 16; float* cl = (float*)(ka->ws + WS_CL) + (size_t)h * T + tid * 16;
    double* Bb = (double*)(ka->ws + WS_BB) + h * 32;
    float v[16];
#pragma unroll
    for (int q = 0; q < 4; ++q) { const f32x4 t = ((const GAS f32x4*)lf)[q]; v[4 * q] = t.x; v[4 * q + 1] = t.y; v[4 * q + 2] = t.z; v[4 * q + 3] = t.w; }
    float run = 0.f;
#pragma unroll
    for (int j = 0; j < 16; ++j) { run += v[j] * LOG2E; v[j] = run; }
    float s = run;
#pragma unroll
    for (int d = 1; d < 16; d <<= 1) { const float y = __shfl_up(s, d, 16); if ((lane & 15) >= d) s += y; }
    const float excl = s - run;
#pragma unroll
    for (int q = 0; q < 4; ++q) ((GAS f32x4*)cl)[q] = (f32x4){-(v[4 * q] + excl), -(v[4 * q + 1] + excl), -(v[4 * q + 2] + excl), -(v[4 * q + 3] + excl)};
    LAS double* bt = (LAS double*)lds;
    if ((lane & 15) == 15) bt[tid >> 4] = (double)s;
    __syncthreads();
    if (tid == 0) { double c = 0.0; for (int b = 0; b < 32; ++b) { Bb[b] = c; c += bt[b]; } }
    __syncthreads();
    if (tid < 32) { double c = 0.0; for (int b = 0; b < tid; ++b) c += bt[b]; bt[32 + tid] = c; }
    __syncthreads();
    { float* dBt = (float*)(ka->ws + WS_DBT) + h * 1024;
      for (int e = tid; e < 1024; e += 512) dBt[e] = (float)(bt[32 + (e >> 5)] - bt[32 + (e & 31)]); }
    __syncthreads();
}
__device__ __forceinline__ void ph_convfix(const Args* ka, int vcu, int G, int tid) {
    const float* UH = (const float*)(ka->ws + WS_UH); bf16* ACT = (bf16*)(ka->ws + WS_ACT); const float* cw = ka->in[13]; const float* cb = ka->in[14];
    constexpr int NCG = FF / 4, NIT = 31 * NCG;
    for (int it = vcu * 512 + tid; it < NIT; it += G * 512) {
        const int pm = 1 + it / NCG, j0 = (it % NCG) * 4;
        f32x4 act[2];
        f32x4 ua[4], uv[4];
#pragma unroll
        for (int q = 0; q < 4; ++q) { const size_t rowoff = (size_t)((q < 2 ? (pm - 1) * 4 + 2 + q : pm * 4 + (q - 2))) * FF2;
            ua[q] = *(const GAS f32x4*)(UH + rowoff + j0); uv[q] = *(const GAS f32x4*)(UH + rowoff + FF + j0); }
        f32x4 wa[3], wv[3];
#pragma unroll
        for (int tp = 0; tp < 3; ++tp) { wa[tp] = *(const GAS f32x4*)(cw + (size_t)tp * FF2 + j0); wv[tp] = *(const GAS f32x4*)(cw + (size_t)tp * FF2 + FF + j0); }
        const f32x4 ba = *(const GAS f32x4*)(cb + j0), bv = *(const GAS f32x4*)(cb + FF + j0);
#pragma unroll
        for (int rr = 0; rr < 2; ++rr) { const f32x4 ya = ba + wa[0] * ua[rr] + wa[1] * ua[rr + 1] + wa[2] * ua[rr + 2], yv = bv + wv[0] * uv[rr] + wv[1] * uv[rr + 1] + wv[2] * uv[rr + 2];
            act[rr] = (f32x4){silu2_f(ya.x) * yv.x, silu2_f(ya.y) * yv.y, silu2_f(ya.z) * yv.z, silu2_f(ya.w) * yv.w};
            *(GAS unsigned long long*)(ACT + (size_t)(pm * 256 + rr) * FF + j0) = (unsigned long long)pk2(act[rr].x, act[rr].y) | ((unsigned long long)pk2(act[rr].z, act[rr].w) << 32); }
    }
}
__device__ __forceinline__ void ph_fnorm(const float* x, const bf16* d1, const bf16* d2, float* out, const float* g, int vcu, int G, int lane, int wave) {
    const int gw = vcu * 8 + wave, NGW = G * 8;
    for (int row = gw; row < T; row += NGW) {
        const GAS f32x4* xr = (const GAS f32x4*)(x + (size_t)row * D) + lane;
        const GAS unsigned long long* p1 = (const GAS unsigned long long*)(d1 + (size_t)row * D) + lane; const GAS unsigned long long* p2 = (const GAS unsigned long long*)(d2 + (size_t)row * D) + lane;
        f32x4 v[16]; float s = 0.f;
#pragma unroll
        for (int jj = 0; jj < 16; ++jj) { v[jj] = __builtin_nontemporal_load(xr + 64 * jj); const unsigned long long a1 = __builtin_nontemporal_load(p1 + 64 * jj), a2 = __builtin_nontemporal_load(p2 + 64 * jj);
            const unsigned w0 = (unsigned)a1, w1 = (unsigned)(a1 >> 32), y0 = (unsigned)a2, y1 = (unsigned)(a2 >> 32);
            v[jj].x += __uint_as_float(w0 << 16) + __uint_as_float(y0 << 16); v[jj].y += __uint_as_float(w0 & 0xffff0000u) + __uint_as_float(y0 & 0xffff0000u);
            v[jj].z += __uint_as_float(w1 << 16) + __uint_as_float(y1 << 16); v[jj].w += __uint_as_float(w1 & 0xffff0000u) + __uint_as_float(y1 & 0xffff0000u);
            s += (v[jj].x * v[jj].x + v[jj].y * v[jj].y) + (v[jj].z * v[jj].z + v[jj].w * v[jj].w); }
        const float r = 1.0f / sqrtf(wave_sum(s) * (1.0f / D) + EPS);
        GAS f32x4* orow = (GAS f32x4*)(out + (size_t)row * D) + lane;
#pragma unroll
        for (int jj = 0; jj < 16; ++jj) { const f32x4 gv = *(const GAS f32x4*)(g + 4 * (lane + 64 * jj)); __builtin_nontemporal_store(v[jj] * r * gv, orow + 64 * jj); }
    }
}

namespace fa {
typedef short bf16x8 __attribute__((ext_vector_type(8)));
typedef short s16x4 __attribute__((ext_vector_type(4)));
typedef float f32x16 __attribute__((ext_vector_type(16)));
typedef float f32x4 __attribute__((ext_vector_type(4)));
typedef unsigned u32x4 __attribute__((ext_vector_type(4)));
constexpr int NW = 8, QBLK = 32, KVBLK = 64, QB = NW * QBLK, DH = 128;
constexpr int SHM_V = KVBLK * DH * 2, SHM_K = KVBLK * DH * 2;
constexpr int LDS_BYTES = 2 * SHM_V + 2 * SHM_K + NW * 64 * 4;
constexpr float THR2 = 11.5f;
#define KSWZ(row, colB) ((row) * 256 + ((colB) ^ (((row) & 7) << 4)))
#define SBAR() __builtin_amdgcn_sched_barrier(0)
__device__ __forceinline__ int v_st(int k, int c) { const int kk = (k & ~0xC) | ((k & 4) << 1) | ((k & 8) >> 1); return ((kk >> 3) * 4 + (c >> 5)) * 512 + ((kk & 7) * 32 + (c & 31)) * 2; }
__device__ __forceinline__ int v_rd_base(int lane) { return ((lane & 3) << 3) | (((lane >> 2) & 3) << 6) | (((lane >> 4) & 1) << 5) | (((lane >> 5) & 1) << 8); }
constexpr int v_rd_off(int d0, int ks, int half) { return d0 * 512 + ks * 4096 + half * 2048; }
__device__ __forceinline__ int crow(int r, int hi) { return (r & 3) + 8 * (r >> 2) + 4 * hi; }
__device__ __forceinline__ unsigned cvtpk(float lo, float hi) { unsigned r; asm volatile("v_cvt_pk_bf16_f32 %0, %1, %2" : "=v"(r) : "v"(lo), "v"(hi)); return r; }
template <int M> __device__ __forceinline__ float swz_xor(float v) { return __int_as_float(__builtin_amdgcn_ds_swizzle(__float_as_int(v), 0x1F | (M << 10))); }
__device__ __forceinline__ bf16x8 load8(const bf16* p) { return *reinterpret_cast<const bf16x8*>(p); }
__device__ __forceinline__ void mask_tile(f32x16& p0, f32x16& p1, int dq) {
    const float NEG = -__builtin_inff();
#pragma unroll
    for (int r = 0; r < 16; ++r) { const int c = (r & 3) + 8 * (r >> 2); if (dq - c < 0) p0[r] = NEG; if (dq - c - 32 < 0) p1[r] = NEG; }
}
__device__ __forceinline__ void partialSM(f32x16& p0, f32x16& p1, float& m_reg, float& mn, float& alpha, float dB) {
    float pmax = p0[0]; for (int r = 1; r < 16; ++r) pmax = fmaxf(pmax, p0[r]); for (int r = 0; r < 16; ++r) pmax = fmaxf(pmax, p1[r]);
    { auto rr = __builtin_amdgcn_permlane32_swap(__float_as_uint(pmax), __float_as_uint(pmax), false, false);
      pmax = fmaxf(__uint_as_float(rr[0]), __uint_as_float(rr[1])); }
    const float pm = pmax + dB;
    if (__builtin_expect(__all(pm - m_reg <= THR2), 1)) { mn = m_reg; alpha = 1.f; }
    else { mn = fmaxf(m_reg, pm); alpha = __builtin_amdgcn_exp2f(m_reg - mn); m_reg = mn; }
    const float sub = mn - dB;
    for (int r = 0; r < 16; ++r) p0[r] = p0[r] - sub; for (int r = 0; r < 16; ++r) p1[r] = p1[r] - sub;
    for (int r = 0; r < 16; ++r) p0[r] = __builtin_amdgcn_exp2f(p0[r]);
}
__device__ __forceinline__ void finishSM(f32x16& p0, f32x16& p1, float alpha, float& l_reg, bf16x8& pa0, bf16x8& pa1, bf16x8& pa2, bf16x8& pa3) {
    for (int r = 0; r < 16; ++r) p1[r] = __builtin_amdgcn_exp2f(p1[r]);
    float ps = 0; for (int r = 0; r < 16; ++r) ps += p0[r]; for (int r = 0; r < 16; ++r) ps += p1[r];
    { auto rr = __builtin_amdgcn_permlane32_swap(__float_as_uint(ps), __float_as_uint(ps), false, false);
      ps = __uint_as_float(rr[0]) + __uint_as_float(rr[1]); }
    l_reg = l_reg * alpha + ps;
#define PK4(P, B_, OUT) do { unsigned a0 = cvtpk(P[B_+0], P[B_+1]), a1 = cvtpk(P[B_+2], P[B_+3]);                          \
        unsigned b0 = cvtpk(P[B_+4], P[B_+5]), b1 = cvtpk(P[B_+6], P[B_+7]);                                             \
        auto r0 = __builtin_amdgcn_permlane32_swap(a0, b0, false, false); auto r1 = __builtin_amdgcn_permlane32_swap(a1, b1, false, false); \
        u32x4 w = {r0[0], r1[0], r0[1], r1[1]}; OUT = *reinterpret_cast<bf16x8*>(&w); } while (0)
    PK4(p0, 0, pa0); PK4(p0, 8, pa1); PK4(p1, 0, pa2); PK4(p1, 8, pa3);
#undef PK4
}
template <int KB>
__device__ __forceinline__ void qkt(f32x16& p0, f32x16& p1, const char* K_lds, int r32, int hi, const bf16x8* qr) {
    const char* kb[4];
#pragma unroll
    for (int dd = 0; dd < 4; ++dd) kb[dd] = K_lds + KB * SHM_K + KSWZ(r32, (dd * 16 + hi * 8) * 2);
#pragma unroll
    for (int d0 = 0; d0 < 8; ++d0) { const char* a = kb[d0 & 3] + (d0 >> 2) * 128;
        bf16x8 b0 = *reinterpret_cast<const bf16x8*>(a);
        bf16x8 b1 = *reinterpret_cast<const bf16x8*>(a + 32 * 256);
        p0 = __builtin_amdgcn_mfma_f32_32x32x16_bf16(b0, qr[d0], p0, 0, 0, 0);
        p1 = __builtin_amdgcn_mfma_f32_32x32x16_bf16(b1, qr[d0], p1, 0, 0, 0); }
}
template <int VB>
__device__ __forceinline__ void pv_tile(f32x16* o, int vb0, bf16x8 pa0, bf16x8 pa1, bf16x8 pa2, bf16x8 pa3) {
#define TRRD(dst, off) asm volatile("ds_read_b64_tr_b16 %0, %1 offset:%2" : "=&v"(dst) : "v"(vb0), "i"(off) : "memory")
#define PV_D0(d0) do { s16x4 l0, l1, l2, l3, h0, h1, h2, h3; constexpr int b_ = VB * SHM_V + v_rd_off(d0, 0, 0);   \
        TRRD(l0, b_); TRRD(h0, b_ + 2048); TRRD(l1, b_ + 4096); TRRD(h1, b_ + 6144); TRRD(l2, b_ + 8192); TRRD(h2, b_ + 10240); TRRD(l3, b_ + 12288); TRRD(h3, b_ + 14336); \
        asm volatile("s_waitcnt lgkmcnt(0)" ::: "memory"); SBAR();   \
        o[d0] = __builtin_amdgcn_mfma_f32_32x32x16_bf16(pa0, (bf16x8){l0[0], l0[1], l0[2], l0[3], h0[0], h0[1], h0[2], h0[3]}, o[d0], 0, 0, 0);   \
        o[d0] = __builtin_amdgcn_mfma_f32_32x32x16_bf16(pa1, (bf16x8){l1[0], l1[1], l1[2], l1[3], h1[0], h1[1], h1[2], h1[3]}, o[d0], 0, 0, 0);   \
        o[d0] = __builtin_amdgcn_mfma_f32_32x32x16_bf16(pa2, (bf16x8){l2[0], l2[1], l2[2], l2[3], h2[0], h2[1], h2[2], h2[3]}, o[d0], 0, 0, 0);   \
        o[d0] = __builtin_amdgcn_mfma_f32_32x32x16_bf16(pa3, (bf16x8){l3[0], l3[1], l3[2], l3[3], h3[0], h3[1], h3[2], h3[3]}, o[d0], 0, 0, 0); } while (0)
    PV_D0(0); PV_D0(1); PV_D0(2); PV_D0(3);
#undef PV_D0
#undef TRRD
}
typedef __amdgpu_buffer_rsrc_t rsrc_t;
__device__ __forceinline__ rsrc_t mk_rsrc(const void* p, unsigned bytes) { return __builtin_amdgcn_make_buffer_rsrc((void*)p, (short)0, (int)bytes, 0x00020000); }
__device__ __forceinline__ bf16x8 bload8(rsrc_t r, unsigned voff, unsigned soff) { const u32x4 w = __builtin_bit_cast(u32x4, __builtin_amdgcn_raw_buffer_load_b128(r, (int)voff, (int)soff, 0)); return __builtin_bit_cast(bf16x8, w); }
__device__ __forceinline__ f32x4 bloadf4(rsrc_t r, unsigned voff, unsigned soff) { return __builtin_bit_cast(f32x4, __builtin_amdgcn_raw_buffer_load_b128(r, (int)voff, (int)soff, 0)); }
struct AttnPtrs { rsrc_t rsP, rsN, rsG, rsM; const float* dBt; };
struct BlockRef { int h; int P0; int jlo; };
struct Seam { bf16x8 qr[8]; bf16x8 st_v0, st_v1, st_k0, st_k1; };
#define ROWS(typ, hh, k0, add) ((unsigned)((((typ) * NH + (hh)) * T + (k0) + (add)) * (DH * 2)))
#define VMW() asm volatile("s_waitcnt vmcnt(0)" ::: "memory")
#define VMWN(n) asm volatile("s_waitcnt vmcnt(%0)" :: "i"(n) : "memory")
#define SLOAD_H(hh, k0) do { S.st_v0 = bload8(P.rsP, stoff, ROWS(2, hh, k0, 0)); S.st_v1 = bload8(P.rsP, stoff, ROWS(2, hh, k0, 32));              \
                         S.st_k0 = bload8(P.rsP, stoff, ROWS(1, hh, k0, 0)); S.st_k1 = bload8(P.rsP, stoff, ROWS(1, hh, k0, 32)); } while (0)
#define SWRITE_HK(bf) do { *(bf16x8*)(K_lds + (bf) * SHM_K + kws) = S.st_k0; *(bf16x8*)(K_lds + (bf) * SHM_K + kws + 32 * 256) = S.st_k1; } while (0)
#define SWRITE_HV(bf) do { *(bf16x8*)(V_lds + (bf) * SHM_V + vst0) = S.st_v0; *(bf16x8*)(V_lds + (bf) * SHM_V + vst1) = S.st_v1; } while (0)
#define SWRITE_H(bf) do { SWRITE_HV(bf); SWRITE_HK(bf); } while (0)
__device__ __forceinline__ void fox_prime(const AttnPtrs& P, const BlockRef& cur, char* lds, Seam& S, int wid) {
    const int lane = lane_id(), tid = wid * 64 + lane, r32 = lane & 31, hi = lane >> 5;
    const unsigned stoff = (unsigned)(((tid >> 4) * DH + (tid & 15) * 8) * 2), qoff = (unsigned)((r32 * DH + hi * 8) * 2);
    const int sr = tid >> 4, sc = (tid & 15) * 8, kws = KSWZ(sr, sc * 2); char* K_lds = lds + 2 * SHM_V; (void)qoff;
    const int kb0 = cur.jlo * KVBLK;
    for (int d0 = 0; d0 < 8; ++d0) S.qr[d0] = bload8(P.rsP, qoff + d0 * 32, ROWS(0, cur.h, cur.P0 + wid * QBLK, 0));
    SLOAD_H(cur.h, kb0); VMW(); SWRITE_HK(0);
    __syncthreads();
}
__device__ __forceinline__ void fox_block(const AttnPtrs& P, const BlockRef& cur, const BlockRef& nxt, char* lds, Seam& S, int wid) {
    const int lane = lane_id(), tid = wid * 64 + lane, r32 = lane & 31, hi = lane >> 5;
    const unsigned stoff = (unsigned)(((tid >> 4) * DH + (tid & 15) * 8) * 2), qoff = (unsigned)((r32 * DH + hi * 8) * 2);
    const int j_lo = cur.jlo;
    const int j_hi = (cur.P0 + QB - 1) / KVBLK + 1;
    const int NT = j_hi - j_lo;
    const int kbn = nxt.jlo * KVBLK;
    const int qlo = cur.P0 + wid * QBLK, qm = qlo + r32 - 4 * hi;
    char* V_lds = lds; char* K_lds = lds + 2 * SHM_V;
    float* ws = (float*)(lds + 2 * SHM_V + 2 * SHM_K) + wid * 64; float* li_l = ws, * al_l = ws + 32;
    float m_reg = -1e30f, l_reg = 0; f32x16 o[4] = {};
    const int sr = tid >> 4, sc = (tid & 15) * 8, vst0 = v_st(sr, sc), vst1 = v_st(32 + sr, sc), kws = KSWZ(sr, sc * 2);
    const int vb0 = (int)(uintptr_t)V_lds + v_rd_base(lane);
    const float* dbrow = P.dBt + (cur.h * 32 + (cur.P0 >> 8)) * 32;
#define RESC(a) do { if (__any((a) < 1.f)) { if (hi == 0) al_l[r32] = (a); asm volatile("s_waitcnt lgkmcnt(0)" ::: "memory");              \
                     for (int d_ = 0; d_ < 4; ++d_) for (int r = 0; r < 16; ++r) o[d_][r] *= al_l[crow(r, hi)]; } } while (0)
#define KBASE(t) ((j_lo + (t)) * KVBLK)
#define DB(t) (__int_as_float(__builtin_amdgcn_readfirstlane(__float_as_int(dbrow[KBASE(t) >> 8]))))
#define MASKT(P0_, P1_, t) do { const int kb_ = KBASE(t); if (kb_ + KVBLK - 1 > qlo) mask_tile(P0_, P1_, qm - kb_); } while (0)
#define BIASLD(P0_, P1_, t) do { const unsigned so_ = (unsigned)((cur.h * T + KBASE(t)) * 4), vo_ = (unsigned)(hi * 16);                                             \
        _Pragma("unroll") for (int g_ = 0; g_ < 4; ++g_) { const f32x4 x_ = bloadf4(P.rsN, vo_ + 32 * g_, so_), y_ = bloadf4(P.rsN, vo_ + 128 + 32 * g_, so_);   \
            P0_[4 * g_] = x_.x; P0_[4 * g_ + 1] = x_.y; P0_[4 * g_ + 2] = x_.z; P0_[4 * g_ + 3] = x_.w; P1_[4 * g_] = y_.x; P1_[4 * g_ + 1] = y_.y; P1_[4 * g_ + 2] = y_.z; P1_[4 * g_ + 3] = y_.w; } } while (0)
    constexpr int NQL = 8;
#define SEAM_K0() do { VMWN(NQL); SWRITE_HK(0); SBAR(); } while (0)
    f32x16 pA0, pA1, pB0, pB1; float mnA, mnB, alA, alB; bf16x8 pa0, pa1, pa2, pa3;
    BIASLD(pA0, pA1, 0);
    SWRITE_HV(0); SBAR();
    SLOAD_H(cur.h, KBASE(1));
    SBAR(); qkt<0>(pA0, pA1, K_lds, r32, hi, S.qr);
    BIASLD(pB0, pB1, 1);
    MASKT(pA0, pA1, 0); partialSM(pA0, pA1, m_reg, mnA, alA, DB(0));
    VMW(); SWRITE_H(1);
    __syncthreads();
#define HALF_STEP(PX0, PX1, mnX, alX, PY0, PY1, alY, t, KB, VB, SB) do {                                                      \
        if ((t) + 1 < NT) { SLOAD_H(cur.h, KBASE((t) + 1)); }     \
        SBAR(); qkt<KB>(PX0, PX1, K_lds, r32, hi, S.qr);                                                                      \
        finishSM(PY0, PY1, alY, l_reg, pa0, pa1, pa2, pa3); SBAR();                                                           \
        if ((t) + 1 < NT) { BIASLD(PY0, PY1, (t) + 1); SBAR(); }                                                              \
        pv_tile<VB>(o, vb0, pa0, pa1, pa2, pa3); MASKT(PX0, PX1, (t)); partialSM(PX0, PX1, m_reg, mnX, alX, DB(t));           \
        __syncthreads();                                                                                                      \
        if ((t) + 1 < NT) { VMW(); SWRITE_H(SB); }                                                                            \
        RESC(alX); __syncthreads(); } while (0)
    for (int t = 1; t + 1 < NT; t += 2) {
        HALF_STEP(pB0, pB1, mnB, alB, pA0, pA1, alA, t, 1, 0, 0);
        HALF_STEP(pA0, pA1, mnA, alA, pB0, pB1, alB, t + 1, 0, 1, 1);
    }
    const bool even = (NT & 1) == 0;
    if (even) { SBAR(); qkt<1>(pB0, pB1, K_lds, r32, hi, S.qr); SBAR(); }
    SLOAD_H(nxt.h, kbn); SBAR();
#pragma unroll
    for (int d0 = 0; d0 < 8; ++d0) S.qr[d0] = bload8(P.rsP, qoff + d0 * 32, ROWS(0, nxt.h, nxt.P0 + wid * QBLK, 0));
    SBAR();
    finishSM(pA0, pA1, alA, l_reg, pa0, pa1, pa2, pa3); SBAR();
    pv_tile<0>(o, vb0, pa0, pa1, pa2, pa3);
    if (even) { MASKT(pB0, pB1, NT - 1); partialSM(pB0, pB1, m_reg, mnB, alB, DB(NT - 1)); __syncthreads(); RESC(alB);
        finishSM(pB0, pB1, alB, l_reg, pa0, pa1, pa2, pa3); SBAR(); pv_tile<1>(o, vb0, pa0, pa1, pa2, pa3); }
    SBAR(); SEAM_K0();
    if (hi == 0) li_l[r32] = l_reg; asm volatile("s_waitcnt lgkmcnt(0)" ::: "memory");
    float rs[16];
#pragma unroll
    for (int r = 0; r < 16; ++r) { const float rl = __builtin_amdgcn_rcpf(li_l[crow(r, hi)]); float ss = 0.f;
#pragma unroll
        for (int d0 = 0; d0 < 4; ++d0) { o[d0][r] *= rl; ss += o[d0][r] * o[d0][r]; }
        rs[r] = ss; }
#pragma unroll
    for (int r = 0; r < 16; ++r) { rs[r] += swz_xor<1>(rs[r]); rs[r] += swz_xor<2>(rs[r]); rs[r] += swz_xor<4>(rs[r]); rs[r] += swz_xor<8>(rs[r]); rs[r] += swz_xor<16>(rs[r]); }
    float gv[4];
#pragma unroll
    for (int d0 = 0; d0 < 4; ++d0) gv[d0] = __builtin_bit_cast(float, __builtin_amdgcn_raw_buffer_load_b32(P.rsG, (int)(r32 * 4 + d0 * 128), (int)(cur.h * DH * 4), 0));
    const unsigned olane = (unsigned)((4 * hi * D + r32) * 2);
#pragma unroll
    for (int r = 0; r < 16; ++r) { const int orow_u = (r & 3) + 8 * (r >> 2); const float rn = 1.0f / sqrtf(rs[r] * (1.0f / 128.0f) + EPS);
#pragma unroll
        for (int d0 = 0; d0 < 4; ++d0) { const float v = o[d0][r] * rn * gv[d0]; const float vn = swz_xor<1>(v);
            if ((r32 & 1) == 0) __builtin_amdgcn_raw_buffer_store_b32(cvtpk(v, vn), P.rsM, (int)olane, (int)((((cur.P0 + wid * QBLK + orow_u) * D) + cur.h * DH + d0 * 32) * 2), 0); } }
    __syncthreads();
#undef RESC
#undef KBASE
#undef DB
#undef MASKT
#undef BIASLD
#undef SEAM_K0
#undef HALF_STEP
}
#undef ROWS
#undef VMW
#undef VMWN
#undef SLOAD_H
#undef SWRITE_HK
#undef SWRITE_HV
#undef SWRITE_H
}

constexpr float SKIPT = 64.0f;
__device__ __forceinline__ float nrm_of(const float* n4, int tile) { const f32x4 v = *(const GAS f32x4*)(n4 + 4 * tile); return sqrtf((v.x + v.y) + (v.z + v.w)); }
__device__ __forceinline__ int fox_jlo(const Args* ka, int h, int qb, int lane) {
    const float* nrm = (const float*)(ka->ws + WS_NRM); const float* ncl = (const float*)(ka->ws + WS_CL) + (size_t)h * T; const float* dbrow = (const float*)(ka->ws + WS_DBT) + (h * 32 + qb) * 32;
    const float* qn = nrm + (size_t)h * 128 * 4; const float* kn = nrm + (size_t)(16 + h) * 128 * 4;
    const float Qn = fmaxf(fmaxf(nrm_of(qn, 4 * qb), nrm_of(qn, 4 * qb + 1)), fmaxf(nrm_of(qn, 4 * qb + 2), nrm_of(qn, 4 * qb + 3)));
    const float Knb = fmaxf(fmaxf(nrm_of(kn, 4 * qb), nrm_of(kn, 4 * qb + 1)), fmaxf(nrm_of(kn, 4 * qb + 2), nrm_of(kn, 4 * qb + 3)));
    const float c0 = ncl[qb * 256];
    bool ns[2];
#pragma unroll
    for (int q = 0; q < 2; ++q) { const int j = lane + 64 * q; bool keep = true;
        if (j < 4 * qb) { const float bm = dbrow[j >> 2] - c0 + ncl[64 * j + 63]; const float bound = Qn * (nrm_of(kn, j) + Knb) + bm; keep = !(bound < -SKIPT); }
        ns[q] = keep; }
    const unsigned long long m0 = __ballot(ns[0]), m1 = __ballot(ns[1]);
    const int j0 = m0 ? (int)__builtin_ctzll(m0) : 64 + (int)__builtin_ctzll(m1);
    return __builtin_amdgcn_readfirstlane(j0 < 4 * qb ? j0 : 4 * qb);
}
__device__ __forceinline__ fa::BlockRef mk_ref(int item, int pass_, int L0, int jl0, int jl1) { const int x = item & 15, qb = pass_ ? 31 - x : x; fa::BlockRef r; r.h = item >> 4; r.P0 = qb * 256; r.jlo = item == L0 ? (pass_ ? jl1 : jl0) : 0; return r; }
__device__ __forceinline__ void ph_attn(const Args* ka, LAS unsigned char* lds_las, int vcu, int G, int wave) {
    char* lds = (char*)lds_las;
    unsigned char* ws = ka->ws;
    fa::AttnPtrs P; P.rsP = fa::mk_rsrc(ws + WS_PROJ, (unsigned)(3 * HEADBUF * 2)); P.rsN = fa::mk_rsrc(ws + WS_CL, (unsigned)(NH * T * 4)); P.rsG = fa::mk_rsrc(ka->in[8], 2048u * 4u);
    P.rsM = fa::mk_rsrc(ws + WS_MIX, (unsigned)((size_t)T * D * 2)); P.dBt = (const float*)(ws + WS_DBT);
    const int total = NH * 16;
    int L = vcu; if (L >= total) return;
    const int L0 = L; int jl0, jl1; { const int lane = lane_id(); jl0 = fox_jlo(ka, L >> 4, L & 15, lane); jl1 = fox_jlo(ka, L >> 4, 31 - (L & 15), lane); }
    int pass = 0; fa::BlockRef cur = mk_ref(L, 0, L0, jl0, jl1); fa::Seam S;
    fa::fox_prime(P, cur, lds, S, wave);
    for (;;) {
        const bool more_pass = pass == 0, more_item = L + G < total, last = !more_pass && !more_item;
        int passn = pass + 1, Ln = L; if (!more_pass) { passn = 0; Ln = more_item ? L + G : L; }
        const fa::BlockRef nxt = last ? cur : mk_ref(Ln, passn, L0, jl0, jl1);
        fa::fox_block(P, cur, nxt, lds, S, wave);
        if (last) break;
        cur = nxt; pass = passn; L = Ln;
    }
}

#ifndef HG_DLIM
#define HG_DLIM 100.0f
#endif
namespace hg {
typedef short bf16x8 __attribute__((ext_vector_type(8)));
typedef float f32x16 __attribute__((ext_vector_type(16)));
typedef float f32x4 __attribute__((ext_vector_type(4)));
typedef float f32x2 __attribute__((ext_vector_type(2)));
template <int M> __device__ __forceinline__ float swzx(float v) { return __int_as_float(__builtin_amdgcn_ds_swizzle(__float_as_int(v), 0x1F | (M << 10))); }
__device__ __forceinline__ float b2f(bf16 v) { return __uint_as_float((unsigned)v << 16); }
__device__ __forceinline__ float ex2(float v) { return __builtin_amdgcn_exp2f(v); }
__device__ __forceinline__ int crow(int r, int hi) { return (r & 3) + 8 * (r >> 2) + 4 * hi; }
__device__ __forceinline__ void gate(float f, float lbk, float omlb, float& g2, float& kk) {
    const float e = ex2(f * LOG2E);
    const float sg = __builtin_amdgcn_rcpf(1.0f + __builtin_amdgcn_rcpf(e)), sgn = __builtin_amdgcn_rcpf(1.0f + e);
    g2 = __builtin_amdgcn_logf(lbk + omlb * sg); kk = omlb * sgn;
}
}

__device__ __forceinline__ void ph_hgA(const Args* ka, LAS unsigned char* lds, int vcu, int G, int wave) {
    using namespace hg;
    const int lane = lane_id(), tid = wave * 64 + lane;
    unsigned char* ws = ka->ws;
    const bf16* HF = (const bf16*)(ws + WS_PROJ) + 4 * HEADBUF; const bf16* HI = (const bf16*)(ws + WS_PROJ) + 5 * HEADBUF;
    bf16* UT = (bf16*)(ws + WS_HU); float* dv = (float*)(ws + WS_HD); const float* lb = (const float*)(ws + WS_LB);
    LAS bf16* kdT = (LAS bf16*)lds; LAS bf16* iT = (LAS bf16*)(lds + 18432); LAS float* qt = (LAS float*)(lds + 36864);
    const int k = tid & 127, rq = tid >> 7;
    bf16 fraw[16]; v4u ivn0 = {0u, 0u, 0u, 0u}, ivn1 = ivn0;
    if (vcu < NH * 128) { const size_t rb = ((size_t)(vcu >> 7) * T + (vcu & 127) * 64 + 16 * rq) * 128 + k;
#pragma unroll
        for (int j = 0; j < 16; ++j) fraw[j] = HF[rb + j * 128];
        const bf16* ipn = HI + ((size_t)(vcu >> 7) * T + (vcu & 127) * 64 + (tid >> 4)) * 128 + (tid & 15) * 8; ivn0 = *(const GAS v4u*)ipn; ivn1 = *(const GAS v4u*)(ipn + 32 * 128); }
    for (int u = vcu; u < NH * 128; u += G) {
        const int h = u >> 7, n = u & 127, t0 = n * 64;
        const float lbk = lb[h * 128 + k], omlb = 1.0f - lbk;
        float c[16], kk[16]; float run = 0.f;
#pragma unroll
        for (int j = 0; j < 16; ++j) { float g2; gate(b2f(fraw[j]), lbk, omlb, g2, kk[j]); run += g2; c[j] = run; }
        qt[rq * 128 + k] = run;
        const v4u iv0 = ivn0, iv1 = ivn1;
        { const int un = u + G < NH * 128 ? u + G : u; const size_t rb = ((size_t)(un >> 7) * T + (un & 127) * 64 + 16 * rq) * 128 + k;
#pragma unroll
          for (int j = 0; j < 16; ++j) fraw[j] = HF[rb + j * 128];
          const bf16* ipn = HI + ((size_t)(un >> 7) * T + (un & 127) * 64 + (tid >> 4)) * 128 + (tid & 15) * 8; ivn0 = *(const GAS v4u*)ipn; ivn1 = *(const GAS v4u*)(ipn + 32 * 128); }
        __syncthreads();
        float off = 0.f, tot = 0.f;
#pragma unroll
        for (int q = 0; q < 4; ++q) { const float xq = qt[q * 128 + k]; if (q < rq) off += xq; tot += xq; }
#pragma unroll
        for (int j = 0; j < 16; ++j) (kdT + k * 72 + 16 * rq)[j] = (bf16)f2bf(kk[j] * ex2(tot - (off + c[j])));
        if (rq == 0) dv[(size_t)u * 128 + k] = ex2(tot);
        { const int tt = tid >> 4, v0 = (tid & 15) * 8;
#pragma unroll
          for (int e = 0; e < 4; ++e) { iT[(v0 + 2 * e) * 72 + tt] = (bf16)(iv0[e] & 0xffffu); iT[(v0 + 2 * e + 1) * 72 + tt] = (bf16)(iv0[e] >> 16);
                                        iT[(v0 + 2 * e) * 72 + tt + 32] = (bf16)(iv1[e] & 0xffffu); iT[(v0 + 2 * e + 1) * 72 + tt + 32] = (bf16)(iv1[e] >> 16); } }
        __syncthreads();
        const int mb = wave >> 1, nh = wave & 1, r = lane & 31, hh = lane >> 5;
        f32x16 acc0 = {}, acc1 = {};
#pragma unroll
        for (int s = 0; s < 4; ++s) { const bf16x8 av = *(const LAS bf16x8*)(iT + (mb * 32 + r) * 72 + 16 * s + 8 * hh);
            const bf16x8 b0 = *(const LAS bf16x8*)(kdT + (nh * 64 + r) * 72 + 16 * s + 8 * hh), b1 = *(const LAS bf16x8*)(kdT + (nh * 64 + 32 + r) * 72 + 16 * s + 8 * hh);
            acc0 = __builtin_amdgcn_mfma_f32_32x32x16_bf16(av, b0, acc0, 0, 0, 0); acc1 = __builtin_amdgcn_mfma_f32_32x32x16_bf16(av, b1, acc1, 0, 0, 0); }
        bf16* up = UT + (size_t)u * 16384 + nh * 64 + r;
#pragma unroll
        for (int r_ = 0; r_ < 16; ++r_) { const int v = mb * 32 + crow(r_, hh); const float n0 = swzx<1>(acc0[r_]), n1 = swzx<1>(acc1[r_]);
            if ((r & 1) == 0) { *(unsigned*)(up + v * 128) = pk2(acc0[r_], n0); *(unsigned*)(up + v * 128 + 32) = pk2(acc1[r_], n1); } }
        __syncthreads();
    }
}

__device__ __forceinline__ void ph_hgB(const Args* ka, int vcu, int G, int wave) {
    using namespace hg;
    const int lane = lane_id(), tid = wave * 64 + lane;
    unsigned char* ws = ka->ws;
    const bf16* UT = (const bf16*)(ws + WS_HU); const float* dv = (const float*)(ws + WS_HD); bf16* ST = (bf16*)(ws + WS_HS);
    for (int idx = vcu * 512 + tid; idx < NH * 128 * 64; idx += G * 512) {
        const int h = idx >> 13, v = (idx >> 6) & 127, kp = idx & 63;
        const unsigned* up = (const unsigned*)(UT + (size_t)h * 128 * 16384 + v * 128 + 2 * kp);
        const float* dp = dv + (size_t)h * 128 * 128 + 2 * kp;
        unsigned* sp = (unsigned*)(ST + (size_t)h * 128 * 16384 + v * 128 + 2 * kp);
        float s0 = 0.f, s1 = 0.f;
#ifndef HGB_DEPTH
#define HGB_DEPTH 32
#endif
#pragma unroll 1
        for (int n0 = 0; n0 < 128; n0 += HGB_DEPTH) {
            unsigned uw[HGB_DEPTH]; f32x2 dd[HGB_DEPTH];
#pragma unroll
            for (int j = 0; j < HGB_DEPTH; ++j) { uw[j] = __builtin_nontemporal_load(up + (size_t)(n0 + j) * 8192); dd[j] = *(const GAS f32x2*)(dp + (n0 + j) * 128); }
#pragma unroll
            for (int j = 0; j < HGB_DEPTH; ++j) { sp[(size_t)(n0 + j) * 8192] = pk2(s0, s1); s0 = dd[j].x * s0 + __uint_as_float(uw[j] << 16); s1 = dd[j].y * s1 + __uint_as_float(uw[j] & 0xffff0000u); }
        }
    }
}

__device__ __forceinline__ void ph_hgC(const Args* ka, LAS unsigned char* lds, int vcu, int G, int wave) {
    using namespace hg;
    const int lane = lane_id(), tid = wave * 64 + lane;
    unsigned char* ws = ka->ws;
    const bf16* PR = (const bf16*)(ws + WS_PROJ);
    const bf16* HQ = PR + 3 * HEADBUF; const bf16* HF = PR + 4 * HEADBUF; const bf16* HI = PR + 5 * HEADBUF; const bf16* HGb = PR + 6 * HEADBUF;
    const bf16* ST = (const bf16*)(ws + WS_HS); const float* lb = (const float*)(ws + WS_LB); bf16* MIX = (bf16*)(ws + WS_MIX); const float* ghg = ka->in[9];
    constexpr int OFF_QM = 0, OFF_KM = 17408, OFF_QR = 34816, OFF_KD = 52224, OFF_AM = 78336, OFF_QT = 87552, OFF_FLAG = 89600, OFF_FBQ = 89856, OFF_FBK = 107264;
    constexpr int BST = 132, HST = 136, AST = 72; constexpr float DLIM = HG_DLIM;
    LAS bf16* qmS = (LAS bf16*)(lds + OFF_QM); LAS bf16* kmS = (LAS bf16*)(lds + OFF_KM); LAS bf16* qrS = (LAS bf16*)(lds + OFF_QR); LAS bf16* kdS = (LAS bf16*)(lds + OFF_KD);
    LAS bf16* Am = (LAS bf16*)(lds + OFF_AM); LAS float* qt = (LAS float*)(lds + OFF_QT); volatile LAS unsigned* flag = (volatile LAS unsigned*)(lds + OFF_FLAG);
    LAS float* bS = (LAS float*)(lds + OFF_QM); LAS bf16* qS = (LAS bf16*)(lds + OFF_FBQ); LAS bf16* kkS = (LAS bf16*)(lds + OFF_FBK);
    LAS bf16* qdS = (LAS bf16*)(lds + OFF_QM); LAS bf16* iT = (LAS bf16*)(lds + OFF_KD); LAS bf16* STl = (LAS bf16*)(lds + OFF_KM); LAS float* oS = (LAS float*)(lds + OFF_KM);
    const int k = tid & 127, rq = tid >> 7;
    bf16 fraw[16], qraw[16];
    if (vcu < NH * 128) { const size_t rb = ((size_t)(vcu >> 7) * T + (vcu & 127) * 64 + 16 * rq) * 128 + k;
#pragma unroll
        for (int j = 0; j < 16; ++j) { fraw[j] = HF[rb + j * 128]; qraw[j] = HQ[rb + j * 128]; } }
    if (tid < 2) flag[tid] = 0u;
    __syncthreads();
    int par = 0;
    for (int u = vcu; u < NH * 128; u += G, par ^= 1) {
        const int h = u >> 7, n = u & 127, t0 = n * 64;
        const float lbk = lb[h * 128 + k], omlb = 1.0f - lbk;
        float c[16], kk[16], qv[16]; float run = 0.f;
#pragma unroll
        for (int j = 0; j < 16; ++j) { float g2; gate(b2f(fraw[j]), lbk, omlb, g2, kk[j]); run += g2; c[j] = run; qv[j] = b2f(qraw[j]); }
        { const int un = u + G < NH * 128 ? u + G : u; const size_t rb = ((size_t)(un >> 7) * T + (un & 127) * 64 + 16 * rq) * 128 + k;
#pragma unroll
          for (int j = 0; j < 16; ++j) { fraw[j] = HF[rb + j * 128]; qraw[j] = HQ[rb + j * 128]; } }
        qt[rq * 128 + k] = run;
        if (!(fmaxf(c[7] - c[15], c[0] - c[7]) <= DLIM)) flag[par] = 1u;
        for (int i = tid; i < 64 * AST / 2; i += 512) ((LAS unsigned*)Am)[i] = 0u;
        __syncthreads();
        const bool exact = flag[par] != 0u;
        if (tid == 0) flag[par ^ 1] = 0u;
        const float P1 = qt[k], P2 = P1 + qt[128 + k], P3 = P2 + qt[256 + k];
        const float off = rq == 0 ? 0.f : (rq == 1 ? P1 : (rq == 2 ? P2 : P3));
        { const int rbq = rq * (16 * HST) + k;
          LAS bf16* qr0 = qrS + rbq; LAS bf16* kd1 = kdS + rbq; LAS bf16* kd2 = kdS + 16 * HST + rbq; LAS bf16* kd3 = kdS + 48 * HST + rbq;
#pragma unroll
          for (int j = 0; j < 16; ++j) { const float bv = off + c[j];
            if (rq >= 1) qr0[j * HST] = (bf16)f2bf(qv[j] * ex2(c[j]));
            if (rq < 1) kd1[j * HST] = (bf16)f2bf(kk[j] * ex2(P1 - bv));
            if (rq < 2) kd2[j * HST] = (bf16)f2bf(kk[j] * ex2(P2 - bv));
            if (rq < 3) kd3[j * HST] = (bf16)f2bf(kk[j] * ex2(P3 - bv)); }
          if (!exact) { LAS bf16* qm0 = qmS + rbq; LAS bf16* km0 = kmS + rbq;
#pragma unroll
            for (int j = 0; j < 16; ++j) { qm0[j * HST] = (bf16)f2bf(qv[j] * ex2(c[j] - c[7])); km0[j * HST] = (bf16)f2bf(kk[j] * ex2(c[7] - c[j])); } }
          else { LAS float* bS0 = bS + rq * (16 * BST) + k; LAS bf16* kk0 = kkS + rbq; LAS bf16* q0 = qS + rbq;
#pragma unroll
            for (int j = 0; j < 16; ++j) { bS0[j * BST] = off + c[j]; kk0[j * HST] = (bf16)f2bf(kk[j]); q0[j * HST] = (bf16)f2bf(qv[j]); } } }
        __syncthreads();
        if (wave < 6) {
            const int I = wave < 1 ? 1 : (wave < 3 ? 2 : 3), J = wave < 1 ? 0 : (wave < 3 ? wave - 1 : wave - 3), kb = I == 1 ? 0 : (I == 2 ? 16 : 48);
            const int r16 = lane & 15, kq = lane >> 4; f32x4 acc = {0.f, 0.f, 0.f, 0.f};
#pragma unroll
            for (int ks = 0; ks < 4; ++ks) { const bf16x8 av = *(const LAS bf16x8*)(qrS + (16 * I + r16) * HST + 32 * ks + 8 * kq), bv = *(const LAS bf16x8*)(kdS + (kb + 16 * J + r16) * HST + 32 * ks + 8 * kq);
                acc = __builtin_amdgcn_mfma_f32_16x16x32_bf16(av, bv, acc, 0, 0, 0); }
#pragma unroll
            for (int e = 0; e < 4; ++e) Am[(16 * I + kq * 4 + e) * AST + 16 * J + r16] = (bf16)f2bf(acc[e]);
        }
        if (!exact && wave < 4) {
            const int I = wave, r16 = lane & 15, kq = lane >> 4; f32x4 acc = {0.f, 0.f, 0.f, 0.f};
#pragma unroll
            for (int ks = 0; ks < 4; ++ks) { const bf16x8 av = *(const LAS bf16x8*)(qmS + (16 * I + r16) * HST + 32 * ks + 8 * kq), bv = *(const LAS bf16x8*)(kmS + (16 * I + r16) * HST + 32 * ks + 8 * kq);
                acc = __builtin_amdgcn_mfma_f32_16x16x32_bf16(av, bv, acc, 0, 0, 0); }
#pragma unroll
            for (int e = 0; e < 4; ++e) if (r16 <= kq * 4 + e) Am[(16 * I + kq * 4 + e) * AST + 16 * I + r16] = (bf16)f2bf(acc[e]);
        }
        const bf16* ip = HI + ((size_t)h * T + t0 + (tid >> 4)) * 128 + (tid & 15) * 8;
        const v4u iv0 = *(const GAS v4u*)ip, iv1 = *(const GAS v4u*)(ip + 32 * 128);
        const bf16* sp = ST + (size_t)u * 16384 + (size_t)tid * 8;
        const v4u sv0 = __builtin_nontemporal_load((const GAS v4u*)sp), sv1 = __builtin_nontemporal_load((const GAS v4u*)(sp + 4096)), sv2 = __builtin_nontemporal_load((const GAS v4u*)(sp + 8192)), sv3 = __builtin_nontemporal_load((const GAS v4u*)(sp + 12288));
        if (exact) {
          const int ks = tid & 7, sq = (tid >> 3) & 3, tq = (tid >> 5) & 3, bI = tid >> 7;
          if (sq <= tq) {
            float acc[4][4];
#pragma unroll
            for (int i = 0; i < 4; ++i)
#pragma unroll
                for (int j = 0; j < 4; ++j) acc[i][j] = 0.f;
            const int tb = 16 * bI + 4 * tq, sb = 16 * bI + 4 * sq;
#pragma unroll 1
            for (int k4 = 0; k4 < 4; ++k4) { const int kc = ks * 16 + 4 * k4;
                f32x4 bt[4], bs[4]; float qf[4][4], kf[4][4];
#pragma unroll
                for (int i = 0; i < 4; ++i) { bt[i] = *(const LAS f32x4*)(bS + (tb + i) * BST + kc); const f32x2 qw = *(const LAS f32x2*)(qS + (tb + i) * HST + kc);
                    const unsigned w0 = __float_as_uint(qw.x), w1 = __float_as_uint(qw.y); qf[i][0] = __uint_as_float(w0 << 16); qf[i][1] = __uint_as_float(w0 & 0xffff0000u); qf[i][2] = __uint_as_float(w1 << 16); qf[i][3] = __uint_as_float(w1 & 0xffff0000u); }
#pragma unroll
                for (int j = 0; j < 4; ++j) { bs[j] = *(const LAS f32x4*)(bS + (sb + j) * BST + kc); const f32x2 kw = *(const LAS f32x2*)(kkS + (sb + j) * HST + kc);
                    const unsigned w0 = __float_as_uint(kw.x), w1 = __float_as_uint(kw.y); kf[j][0] = __uint_as_float(w0 << 16); kf[j][1] = __uint_as_float(w0 & 0xffff0000u); kf[j][2] = __uint_as_float(w1 << 16); kf[j][3] = __uint_as_float(w1 & 0xffff0000u); }
#pragma unroll
                for (int i = 0; i < 4; ++i)
#pragma unroll
                    for (int j = 0; j < 4; ++j)
#pragma unroll
                        for (int e = 0; e < 4; ++e) acc[i][j] += qf[i][e] * kf[j][e] * ex2(fminf(bt[i][e] - bs[j][e], 0.f));
            }
#pragma unroll
            for (int i = 0; i < 4; ++i)
#pragma unroll
                for (int j = 0; j < 4; ++j) { float a_ = acc[i][j]; a_ += swzx<1>(a_); a_ += swzx<2>(a_); a_ += swzx<4>(a_);
                    if (ks == 0 && sb + j <= tb + i) Am[(tb + i) * AST + sb + j] = (bf16)f2bf(a_); }
          }
        }
        __syncthreads();
        { LAS bf16* qd0 = qdS + rq * (16 * HST) + k;
#pragma unroll
          for (int j = 0; j < 16; ++j) qd0[j * HST] = (bf16)f2bf(qv[j] * ex2(off + c[j])); }
        { const int tt = tid >> 4, v0 = (tid & 15) * 8;
#pragma unroll
          for (int e = 0; e < 4; ++e) { iT[(v0 + 2 * e) * AST + tt] = (bf16)(iv0[e] & 0xffffu); iT[(v0 + 2 * e + 1) * AST + tt] = (bf16)(iv0[e] >> 16);
                                        iT[(v0 + 2 * e) * AST + tt + 32] = (bf16)(iv1[e] & 0xffffu); iT[(v0 + 2 * e + 1) * AST + tt + 32] = (bf16)(iv1[e] >> 16); }
          *(LAS v4u*)(STl + ((tid >> 4)) * HST + (tid & 15) * 8) = sv0; *(LAS v4u*)(STl + ((tid >> 4) + 32) * HST + (tid & 15) * 8) = sv1;
          *(LAS v4u*)(STl + ((tid >> 4) + 64) * HST + (tid & 15) * 8) = sv2; *(LAS v4u*)(STl + ((tid >> 4) + 96) * HST + (tid & 15) * 8) = sv3; }
        __syncthreads();
        const int mb = wave >> 2, nb = wave & 3, r = lane & 31, hh = lane >> 5;
        f32x16 oacc = {};
#pragma unroll
        for (int s = 0; s < 8; ++s) { const bf16x8 av = *(const LAS bf16x8*)(qdS + (mb * 32 + r) * HST + 16 * s + 8 * hh), bv = *(const LAS bf16x8*)(STl + (nb * 32 + r) * HST + 16 * s + 8 * hh);
            oacc = __builtin_amdgcn_mfma_f32_32x32x16_bf16(av, bv, oacc, 0, 0, 0); }
#pragma unroll
        for (int s = 0; s < 4; ++s) { const bf16x8 av = *(const LAS bf16x8*)(Am + (mb * 32 + r) * AST + 16 * s + 8 * hh), bv = *(const LAS bf16x8*)(iT + (nb * 32 + r) * AST + 16 * s + 8 * hh);
            oacc = __builtin_amdgcn_mfma_f32_32x32x16_bf16(av, bv, oacc, 0, 0, 0); }
        __syncthreads();
#pragma unroll
        for (int r_ = 0; r_ < 16; ++r_) oS[(mb * 32 + crow(r_, hh)) * BST + nb * 32 + r] = oacc[r_];
        __syncthreads();
        { const int t = tid >> 3, seg = tid & 7; float ov[16]; float ss = 0.f;
#pragma unroll
          for (int q = 0; q < 4; ++q) { const f32x4 x4 = *(const LAS f32x4*)(oS + t * BST + seg * 16 + 4 * q); ov[4 * q] = x4.x; ov[4 * q + 1] = x4.y; ov[4 * q + 2] = x4.z; ov[4 * q + 3] = x4.w;
              ss += (x4.x * x4.x + x4.y * x4.y) + (x4.z * x4.z + x4.w * x4.w); }
          ss += swzx<1>(ss); ss += swzx<2>(ss); ss += swzx<4>(ss);
          const float rn = 1.0f / sqrtf(ss * (1.0f / 128.0f) + EPS);
          const bf16* gp = HGb + ((size_t)h * T + t0 + t) * 128 + seg * 16;
          const v4u g0 = *(const GAS v4u*)gp, g1 = *(const GAS v4u*)(gp + 8);
          float gf[16];
#pragma unroll
          for (int e = 0; e < 4; ++e) { gf[2 * e] = __uint_as_float(g0[e] << 16); gf[2 * e + 1] = __uint_as_float(g0[e] & 0xffff0000u); gf[8 + 2 * e] = __uint_as_float(g1[e] << 16); gf[8 + 2 * e + 1] = __uint_as_float(g1[e] & 0xffff0000u); }
          float yv[16];
#pragma unroll
          for (int q = 0; q < 4; ++q) { const f32x4 gg = *(const GAS f32x4*)(ghg + h * 128 + seg * 16 + 4 * q);
              yv[4 * q] = ov[4 * q] * rn * gg.x * gf[4 * q]; yv[4 * q + 1] = ov[4 * q + 1] * rn * gg.y * gf[4 * q + 1]; yv[4 * q + 2] = ov[4 * q + 2] * rn * gg.z * gf[4 * q + 2]; yv[4 * q + 3] = ov[4 * q + 3] * rn * gg.w * gf[4 * q + 3]; }
          bf16* mp = MIX + (size_t)(t0 + t) * D + 2048 + h * 128 + seg * 16;
          v4u w0, w1;
#pragma unroll
          for (int e = 0; e < 4; ++e) { w0[e] = pk2(yv[2 * e], yv[2 * e + 1]); w1[e] = pk2(yv[8 + 2 * e], yv[8 + 2 * e + 1]); }
          *(GAS v4u*)mp = w0; *(GAS v4u*)(mp + 8) = w1; }
        __syncthreads();
    }
}

__global__ void __launch_bounds__(512, 2) fwd(Args a) {
    const Args* ka = (const Args*)__builtin_amdgcn_kernarg_segment_ptr();
    extern __shared__ __attribute__((aligned(16))) unsigned char lds_[];
    LAS unsigned char* lds = (LAS unsigned char*)lds_;
    volatile LAS unsigned* MISC = (volatile LAS unsigned*)(lds + MISC_OFF);
    const int wave = __builtin_amdgcn_readfirstlane(threadIdx.x >> 6);
#define lane lane_id()
#define tid (wave * 64 + lane_id())
    const int G = gridDim.x; const int bx = blockIdx.x; const int vcu = (G % 8 == 0) ? (bx % 8) * (G / 8) + bx / 8 : bx;
    for (int u = tid; u < (LDS_BYTES - LDSCTL_OFF) / 4; u += 512) ((LAS unsigned*)(lds + LDSCTL_OFF))[u] = 0u;
    __syncthreads();
#define ws (ka->ws)
    gu32* ctl = (gu32*)(ws + WS_CTL);
    XcdBarrier bar = xcd_barrier_post((unsigned*)(ctl + CW_BAR), MISC + 8);
    const unsigned mask = ka->mask;
#ifndef GEMM_SP2
#define GEMM_SP2 true
#endif
#define HAS(p) (mask & (1u << (p)))
#ifndef REPEAT_MASK
#define REPEAT_MASK 0u
#endif
#define REP(p) for (int rep_ = 0; rep_ < 1 + (int)((REPEAT_MASK >> (p)) & 1u); ++rep_) if (rep_ ? (__syncthreads(), true) : true)
#ifdef TP_A
    unsigned long long tpa_ = wall_clock64(), tpb_ = 0;
#define SEAM(k) do { if ((mask & ((1u << (k)) - 1u)) && (mask >> (k))) xcd_barrier(bar); if ((k) == TP_A) tpa_ = wall_clock64(); if ((k) == TP_B) tpb_ = wall_clock64(); } while (0)
#else
#define SEAM(k) do { if ((mask & ((1u << (k)) - 1u)) && (mask >> (k))) xcd_barrier(bar); } while (0)
#endif
#define x (ka->in[0])
#define mod ((float*)(ws + WS_MOD))
#define Hb ((bf16*)(ws + WS_H))
#define PROJ ((bf16*)(ws + WS_PROJ))
#define MIX ((bf16*)(ws + WS_MIX))
#define D1b ((bf16*)(ws + WS_D1))
#define D2b ((bf16*)(ws + WS_D2))

    const int G1 = (G == 256) ? 224 : G;
    if (HAS(PC_PRO)) REP(PC_PRO) { if (G1 < G) ph_prologue<1>(ka, lds, vcu, G, tid, lane, wave); else ph_prologue<3>(ka, lds, vcu, G, tid, lane, wave); }
    SEAM(PC_NORM1);
    if (HAS(PC_NORM1)) REP(PC_NORM1) ph_norm<true>(x, nullptr, ka->in[4], (const float*)(ws + WS_PART), ka->in[3], Hb, (const bf16*)(ws + WS_WF), ka->in[6], (float*)(ws + WS_LF), mod, G1 < G ? 2 * D : NMOD, lds, vcu, G, tid, lane, wave);
    SEAM(PC_CUM);
    if (HAS(PC_GEMM1)) REP(PC_GEMM1) {
        pg8::Gemm g{Hb, (const bf16*)(ws + WS_WIN), T, NPROJ, D}; pg8::StaticOrder S; S.init(T, NPROJ, G1, bx);
        pg8::EpiProj E{PROJ, HEADBUF, T, QSCALE, (float*)(ws + WS_NRM)};
        if (bx < G1) pg8::gemm_phase<pg8::EpiProj, pg8::StaticOrder, true, GEMM_SP2>(lds, g, S, E, wave);
#ifndef STREAM_REP
#define STREAM_REP 1
#endif
        else { if (HAS(PC_CUM)) ph_cum(ka, lds, bx - G1, tid, lane);
            for (int sr_ = 0; sr_ < STREAM_REP; ++sr_) { if (sr_) __syncthreads(); ph_prologue<2>(ka, lds, bx - G1, G - G1, tid, lane, wave); }
#ifdef STREAM_DELAY_US
            { const unsigned long long t0_ = wall_clock64(); while (wall_clock64() - t0_ < 100ull * STREAM_DELAY_US) __builtin_amdgcn_s_sleep(8); }
#endif
        }
    }
    SEAM(PC_HGA);
    if (HAS(PC_GEMM1) && G1 < G) ph_modreduce(ka, 2 * D, vcu, G, tid);
    if (HAS(PC_CUM) && G1 == G) REP(PC_CUM) ph_cum(ka, lds, vcu, tid, lane);
    if (HAS(PC_HGA)) REP(PC_HGA) ph_hgA(ka, lds, vcu, G, wave);
    SEAM(PC_HGB);
    if (HAS(PC_HGB)) REP(PC_HGB) ph_hgB(ka, vcu, G, wave);
    SEAM(PC_HGC);
    if (HAS(PC_HGC)) REP(PC_HGC) ph_hgC(ka, lds, vcu, G, wave);
#ifdef SPLIT_HC
    SEAM(PC_ATTN);
#endif
    if (HAS(PC_ATTN)) REP(PC_ATTN) ph_attn(ka, lds, vcu, G, wave);
    SEAM(PC_GEMM2);
    if (HAS(PC_GEMM2)) REP(PC_GEMM2) {
        pg8::Gemm g{MIX, (const bf16*)(ws + WS_WO), T, D, D}; pg8::StaticOrder S; S.init(T, D, G, bx);
        pg8::EpiGate E{D1b, D, mod + 2 * D};
        pg8::gemm_phase<pg8::EpiGate, pg8::StaticOrder, true, GEMM_SP2>(lds, g, S, E, wave);
    }
    SEAM(PC_NORM2);
    if (HAS(PC_NORM2)) REP(PC_NORM2) ph_norm<false>(x, D1b, ka->in[11], mod + 3 * D, mod + 4 * D, Hb, nullptr, nullptr, nullptr, nullptr, 0, lds, vcu, G, tid, lane, wave);
    SEAM(PC_GEMM3);
    if (HAS(PC_GEMM3)) REP(PC_GEMM3) {
        pg8::Gemm g{Hb, (const bf16*)(ws + WS_WUP), T, FF2, D}; pg8::StaticOrder S; S.init(T, FF2, G, bx);
        pg8::EpiConv E{(bf16*)(ws + WS_ACT), ka->in[13], ka->in[14], (float*)(ws + WS_UH), lds + HALO_OFF, FF};
        pg8::gemm_phase<pg8::EpiConv, pg8::StaticOrder, true, GEMM_SP2>(lds, g, S, E, wave);
#ifndef WD_DYN
        { const int nun = (T / 256) * (FF2 / 256), rem = nun % G;
          const int rank = rem ? bx - rem : bx, nrank = rem ? G - rem : G;
          if (rank >= 0) ph_convert_wd(ka, lds, rank, nrank, wave); }
#else
        ph_convert_wd_dyn(ka, lds, wave);
#endif
    }
    SEAM(PC_CONV);
    if (HAS(PC_CONV)) REP(PC_CONV) ph_convfix(ka, vcu, G, tid);
    SEAM(PC_GEMM4);
    if (HAS(PC_GEMM4)) REP(PC_GEMM4) {
        pg8::Gemm g{(const bf16*)(ws + WS_ACT), (const bf16*)(ws + WS_WD), T, D, FF}; pg8::StaticOrder S; S.init(T, D, G, bx);
        pg8::EpiGate E{D2b, D, mod + 5 * D};
        pg8::gemm_phase<pg8::EpiGate, pg8::StaticOrder, true, GEMM_SP2>(lds, g, S, E, wave);
    }
    SEAM(PC_FNORM);
    if (HAS(PC_FNORM)) REP(PC_FNORM) ph_fnorm(x, D1b, D2b, ka->out, ka->in[16], vcu, G, lane, wave);
#ifdef TP_A
    if (TP_B >= PC_N) tpb_ = wall_clock64();
    if (bx == 0) { const unsigned long long t0_ = wall_clock64(), dd_ = (tpb_ - tpa_) * TP_K; while (wall_clock64() - t0_ < dd_) __builtin_amdgcn_s_sleep(16); }
#endif
#undef HAS
#undef lane
#undef tid
#undef SEAM
#undef ws
#undef x
#undef mod
#undef Hb
#undef PROJ
#undef MIX
#undef D1b
#undef D2b
}

extern "C" void kernel_launch(void* const* d_in, const int* in_sizes, int n_in, void* d_out, int out_size, void* d_ws, size_t ws_size, hipStream_t stream) {
    static int grid = 0;
    if (grid == 0) {
        if (n_in != 17 || in_sizes[0] != T * D || out_size != T * D || ws_size < WS_END) { fprintf(stderr, "kernel_launch: unexpected shapes / workspace (n_in %d, ws %zu)\n", n_in, ws_size); grid = -1; return; }
        int dev = 0, cus = 0, per_cu = 0;
        if (hipGetDevice(&dev) != hipSuccess || hipDeviceGetAttribute(&cus, hipDeviceAttributeMultiprocessorCount, dev) != hipSuccess) { grid = -1; return; }
        if (hipFuncSetAttribute((const void*)fwd, hipFuncAttributeMaxDynamicSharedMemorySize, LDS_BYTES) != hipSuccess) { fprintf(stderr, "kernel_launch: hipFuncSetAttribute failed\n"); grid = -1; return; }
        if (hipOccupancyMaxActiveBlocksPerMultiprocessor(&per_cu, (const void*)fwd, 512, LDS_BYTES) != hipSuccess || per_cu < 1) fprintf(stderr, "kernel_launch: occupancy query reports %d\n", per_cu);
        (void)hipGetLastError();
        grid = cus;
    }
    if (grid < 0) return;
    (void)hipMemsetAsync((char*)d_ws + WS_CTL, 0, CTL_ZERO_BYTES, stream);
    Args a{};
    for (int i = 0; i < 17; ++i) a.in[i] = (const float*)d_in[i];
    a.out = (float*)d_out; a.ws = (unsigned char*)d_ws; a.mask = (1u << PC_N) - 1u; a.pad = 0u;
    hipLaunchKernelGGL(fwd, dim3(grid), dim3(512), LDS_BYTES, stream, a);
}
```

```cpp
#include <hip/hip_runtime.h>
#include <cstdio>
#include <cstdint>

constexpr int T = 8192, D = 4096, NMOD = 6 * D, INC = 14352, FF = 11008, FF2 = 22016, NH = 16, HD = 128;
constexpr int FOX_F0 = 6144, HG_Q0 = 6160, HG_F0 = HG_Q0 + 2048, HG_I0 = HG_F0 + 2048, HG_G0 = HG_I0 + 2048;
constexpr int NPROJ = 14336;
constexpr float EPS = 1e-6f;
constexpr float LOG2E = 1.4426950408889634f;
constexpr float QSCALE = 0.08838834764831845f * 1.4426950408889634f;
constexpr size_t HEADBUF = (size_t)NH * T * HD;
__device__ __forceinline__ int lane_id() { int l; asm volatile("v_mbcnt_lo_u32_b32 %0, -1, 0\n\tv_mbcnt_hi_u32_b32 %0, -1, %0" : "=v"(l)); return l; }


#ifndef PG8_WGM
#define PG8_WGM 8
#endif
namespace pg8 {
#define PG8_LAS __attribute__((address_space(3)))
typedef unsigned short bf16_t;
typedef short bf16x8 __attribute__((ext_vector_type(8)));
typedef float f32x4 __attribute__((ext_vector_type(4)));
typedef float f32x2 __attribute__((ext_vector_type(2)));
typedef unsigned u32x4 __attribute__((ext_vector_type(4)));
constexpr int BM = 256, BK = 64, HALF = 128, HTB = HALF * BK * 2  , STAGE_BYTES = 8 * HTB, NXCD = 8, WGM = PG8_WGM;

__host__ __device__ __forceinline__ int lds_byte(int r, int c) { const int st = (r >> 4) * 2 + (c >> 5), rr = r & 15, cc = c & 31, ob = rr * 64 + cc * 2; return st * 1024 + (ob ^ (((ob >> 9) & 1) << 5)); }
__host__ __device__ __forceinline__ void stage_rc(int b, int& R, int& C) { const int st = b / 1024, sb = b % 1024, swz = sb ^ (((sb >> 9) & 1) << 5); R = (st >> 1) * 16 + swz / 64; C = (st & 1) * 32 + (swz % 64) / 2; }
__host__ __device__ __forceinline__ int perm32(int rho) { const int n = rho >> 4, i = rho & 15; return 8 * (i >> 2) + 4 * n + (i & 3); }

struct Unit { int pm, pn; };
struct Gemm { const bf16_t* A; const bf16_t* Bt; int M, N, K; };

struct StaticOrder {
    int nM, nN, nwg, G, c;
    __host__ __device__ void init(int M, int N, int G_, int c_) { nM = M / BM; nN = N / BM; nwg = nM * nN; G = G_; c = c_; }
    __host__ __device__ bool next(int i, Unit& u) const {
        const long L = (long)i * G + c; if (L >= nwg) return false;
        int wgid = (int)L; { const int q = nwg / NXCD, r = nwg % NXCD, xcd = wgid % NXCD, off = wgid / NXCD; wgid = (xcd < r ? xcd * (q + 1) : r * (q + 1) + (xcd - r) * q) + off; }
        const int nig = WGM * nN, gid = wgid / nig, fm = gid * WGM, gsz = (nM - fm) < WGM ? (nM - fm) : WGM;
        u.pm = fm + ((wgid % nig) % gsz); u.pn = (wgid % nig) / gsz; return true;
    }
    __device__ __forceinline__ void a_ready(const Unit&) const {}
    __device__ __forceinline__ void done(const Unit&) const {}
};


__device__ __forceinline__ unsigned cvt_pk_bf16(float lo, float hi) { unsigned r; asm volatile("v_cvt_pk_bf16_f32 %0, %1, %2" : "=v"(r) : "v"(lo), "v"(hi)); return r; }
__device__ __forceinline__ float silu_f(float v) { return v * __builtin_amdgcn_rcpf(1.0f + __builtin_amdgcn_exp2f(-1.4426950408889634f * v)); }
struct EpiBf16 {
    static constexpr bool PERM = true, AFTER_DRAIN = false;
    bf16_t* O; int ldc;
    __device__ __forceinline__ void operator()(const f32x4 (&acc)[2][2][4][2], const Unit& u, int wr, int wc, int fr, int fq) const {
        const int row0 = u.pm * BM + wr * 64 + fr, col0 = u.pn * BM + wc * 32 + 8 * fq;
#pragma unroll
        for (int ai = 0; ai < 2; ++ai)
#pragma unroll
            for (int m = 0; m < 4; ++m) { bf16_t* rowp = O + (size_t)(row0 + ai * HALF + m * 16) * ldc + col0;
#pragma unroll
                for (int bj = 0; bj < 2; ++bj) { const f32x4 v0 = acc[ai][bj][m][0], v1 = acc[ai][bj][m][1];
                    u32x4 w; w.x = cvt_pk_bf16(v0[0], v0[1]); w.y = cvt_pk_bf16(v0[2], v0[3]); w.z = cvt_pk_bf16(v1[0], v1[1]); w.w = cvt_pk_bf16(v1[2], v1[3]);
                    *(u32x4*)(rowp + bj * HALF) = w; } }
    }
};
struct EpiProj {
    static constexpr bool PERM = true, AFTER_DRAIN = false;
    bf16_t* base; size_t bufsz; int tlen; float qscale; float* nrm4;
    __device__ __forceinline__ void operator()(const f32x4 (&acc)[2][2][4][2], const Unit& u, int wr, int wc, int fr, int fq) const {
        const int type = u.pn >> 3, hp = u.pn & 7;
        const int row0 = u.pm * BM + wr * 64 + fr, cin = wc * 32 + 8 * fq;
        bf16_t* tb = base + (size_t)type * bufsz;
        const bool act = (type == 3) || (type == 6); const float sc = (type == 0) ? qscale : 1.0f;
#pragma unroll
        for (int ai = 0; ai < 2; ++ai)
#pragma unroll
            for (int m = 0; m < 4; ++m) { const int row = row0 + ai * HALF + m * 16;
#pragma unroll
                for (int bj = 0; bj < 2; ++bj) { f32x4 v0 = acc[ai][bj][m][0], v1 = acc[ai][bj][m][1];
                    if (act) {
#pragma unroll
                        for (int e = 0; e < 4; ++e) { v0[e] = silu_f(v0[e]); v1[e] = silu_f(v1[e]); } }
                    v0 = v0 * sc; v1 = v1 * sc;
                    u32x4 w; w.x = cvt_pk_bf16(v0[0], v0[1]); w.y = cvt_pk_bf16(v0[2], v0[3]); w.z = cvt_pk_bf16(v1[0], v1[1]); w.w = cvt_pk_bf16(v1[2], v1[3]);
                    *(u32x4*)(tb + ((size_t)(2 * hp + bj) * tlen + row) * 128 + cin) = w; } }
        if (type <= 1) {
#pragma unroll
            for (int ai = 0; ai < 2; ++ai)
#pragma unroll
                for (int bj = 0; bj < 2; ++bj) { float mx = 0.f;
#pragma unroll
                    for (int m = 0; m < 4; ++m) { const f32x4 v0 = acc[ai][bj][m][0] * sc, v1 = acc[ai][bj][m][1] * sc;
                        float ss = (v0[0] * v0[0] + v0[1] * v0[1]) + (v0[2] * v0[2] + v0[3] * v0[3]) + (v1[0] * v1[0] + v1[1] * v1[1]) + (v1[2] * v1[2] + v1[3] * v1[3]);
                        ss += __shfl_xor(ss, 16); ss += __shfl_xor(ss, 32); mx = fmaxf(mx, ss); }
                    mx = fmaxf(mx, __shfl_xor(mx, 1)); mx = fmaxf(mx, __shfl_xor(mx, 2)); mx = fmaxf(mx, __shfl_xor(mx, 4)); mx = fmaxf(mx, __shfl_xor(mx, 8));
                    if (fr == 0 && fq == 0) nrm4[(((size_t)type * 16 + 2 * hp + bj) * (tlen / 64) + (u.pm * 4 + 2 * ai + wr)) * 4 + wc] = mx * 1.01f; }
        }
    }
};
struct EpiGate {
    static constexpr bool PERM = true, AFTER_DRAIN = false;
    bf16_t* O; int ldc; const float* gate;
    __device__ __forceinline__ void operator()(const f32x4 (&acc)[2][2][4][2], const Unit& u, int wr, int wc, int fr, int fq) const {
        const int row0 = u.pm * BM + wr * 64 + fr, col0 = u.pn * BM + wc * 32 + 8 * fq;
        f32x4 gv[2][2];
#pragma unroll
        for (int bj = 0; bj < 2; ++bj)
#pragma unroll
            for (int n = 0; n < 2; ++n) gv[bj][n] = *(const f32x4*)(gate + col0 + bj * HALF + 4 * n);
#pragma unroll
        for (int ai = 0; ai < 2; ++ai)
#pragma unroll
            for (int m = 0; m < 4; ++m) { bf16_t* rowp = O + (size_t)(row0 + ai * HALF + m * 16) * ldc + col0;
#pragma unroll
                for (int bj = 0; bj < 2; ++bj) { const f32x4 v0 = acc[ai][bj][m][0] * gv[bj][0], v1 = acc[ai][bj][m][1] * gv[bj][1];
                    u32x4 w; w.x = cvt_pk_bf16(v0[0], v0[1]); w.y = cvt_pk_bf16(v0[2], v0[3]); w.z = cvt_pk_bf16(v1[0], v1[1]); w.w = cvt_pk_bf16(v1[2], v1[3]);
                    *(u32x4*)(rowp + bj * HALF) = w; } }
    }
};
struct EpiRes {
    static constexpr bool PERM = false, AFTER_DRAIN = false;
    const float* R; float* out; int ldc; const float* gate;
    __device__ __forceinline__ void operator()(const f32x4 (&acc)[2][2][4][2], const Unit& u, int wr, int wc, int fr, int fq) const {
        const int col0 = u.pn * BM + wc * 32 + 4 * fq;
        f32x4 gv[2][2];
#pragma unroll
        for (int bj = 0; bj < 2; ++bj)
#pragma unroll
            for (int n = 0; n < 2; ++n) gv[bj][n] = *(const f32x4*)(gate + col0 + bj * HALF + n * 16);
#pragma unroll
        for (int ai = 0; ai < 2; ++ai)
#pragma unroll
            for (int m = 0; m < 4; ++m) { const size_t off = (size_t)(u.pm * BM + ai * HALF + wr * 64 + m * 16 + fr) * ldc + col0;
#pragma unroll
                for (int bj = 0; bj < 2; ++bj)
#pragma unroll
                    for (int n = 0; n < 2; ++n) { const f32x4 rs = *(const f32x4*)(R + off + bj * HALF + n * 16);
                        *(f32x4*)(out + off + bj * HALF + n * 16) = rs + gv[bj][n] * acc[ai][bj][m][n]; } }
    }
};


__device__ __forceinline__ float dpp_f(float oldv, float src, const int ctrl_sel) {
    return ctrl_sel == 0 ? __int_as_float(__builtin_amdgcn_update_dpp(__float_as_int(oldv), __float_as_int(src), 0x111, 0xF, 0xF, false))
         : ctrl_sel == 1 ? __int_as_float(__builtin_amdgcn_update_dpp(__float_as_int(oldv), __float_as_int(src), 0x112, 0xF, 0xF, false))
         : ctrl_sel == 2 ? __int_as_float(__builtin_amdgcn_update_dpp(__float_as_int(oldv), __float_as_int(src), 0x15F, 0xF, 0xF, false))
         :                 __int_as_float(__builtin_amdgcn_update_dpp(__float_as_int(oldv), __float_as_int(src), 0x15E, 0xF, 0xF, false));
}
struct EpiConv {
    static constexpr bool PERM = true, AFTER_DRAIN = false;
    bf16_t* ACT; const float* cw; const float* cb; float* UH; PG8_LAS unsigned char* halo; int ff;
    __device__ __forceinline__ void operator()(const f32x4 (&acc)[2][2][4][2], const Unit& u, int wr, int wc, int fr, int fq) const {
        const int cin = wc * 32 + 8 * fq, j0 = u.pn * 128 + cin, ff2 = 2 * ff;
        PG8_LAS f32x4* hl = (PG8_LAS f32x4*)halo;
        if (fr >= 14) {
#pragma unroll
            for (int ai = 0; ai < 2; ++ai)
#pragma unroll
                for (int bj = 0; bj < 2; ++bj)
#pragma unroll
                    for (int n = 0; n < 2; ++n) hl[(((2 * ai + wr) * 2 + (fr - 14)) * 2 + bj) * 32 + (cin >> 2) + n] = acc[ai][bj][3][n];
            if (wr == 1) {
#pragma unroll
                for (int bj = 0; bj < 2; ++bj)
#pragma unroll
                    for (int n = 0; n < 2; ++n) *(f32x4*)(UH + (size_t)(u.pm * 4 + 2 + (fr - 14)) * ff2 + bj * ff + j0 + 4 * n) = acc[1][bj][3][n];
            }
        }
        if (wr == 0 && fr < 2) {
#pragma unroll
            for (int bj = 0; bj < 2; ++bj)
#pragma unroll
                for (int n = 0; n < 2; ++n) *(f32x4*)(UH + (size_t)(u.pm * 4 + fr) * ff2 + bj * ff + j0 + 4 * n) = acc[0][bj][0][n];
        }
        f32x4 wA[3][2], wV[3][2], bA[2], bV[2];
#pragma unroll
        for (int n = 0; n < 2; ++n) {
#pragma unroll
            for (int tp = 0; tp < 3; ++tp) { wA[tp][n] = *(const f32x4*)(cw + (size_t)tp * ff2 + j0 + 4 * n); wV[tp][n] = *(const f32x4*)(cw + (size_t)tp * ff2 + ff + j0 + 4 * n); }
            bA[n] = *(const f32x4*)(cb + j0 + 4 * n); bV[n] = *(const f32x4*)(cb + ff + j0 + 4 * n); }
        asm volatile("s_waitcnt lgkmcnt(0)" ::: "memory"); __builtin_amdgcn_s_barrier(); asm volatile("" ::: "memory");
#pragma unroll
        for (int ai = 0; ai < 2; ++ai) {
            const int g = 2 * ai + wr;
#pragma unroll
            for (int m = 0; m < 4; ++m) {
                const int row = u.pm * BM + ai * HALF + wr * 64 + m * 16 + fr;
                f32x4 y[2][2];
#pragma unroll
                for (int bj = 0; bj < 2; ++bj)
#pragma unroll
                    for (int n = 0; n < 2; ++n) {
                        const f32x4 cur = acc[ai][bj][m][n];
                        const f32x4 w0 = bj ? wV[0][n] : wA[0][n], w1 = bj ? wV[1][n] : wA[1][n], w2 = bj ? wV[2][n] : wA[2][n], bb = bj ? bV[n] : bA[n];
                        f32x4 o;
                        if (m == 0) {
                            f32x4 p62, p63;
                            if (g == 0) { p62 = (f32x4){0.f, 0.f, 0.f, 0.f}; p63 = p62; }
                            else { p62 = hl[(((g - 1) * 2 + 0) * 2 + bj) * 32 + (cin >> 2) + n]; p63 = hl[(((g - 1) * 2 + 1) * 2 + bj) * 32 + (cin >> 2) + n]; }
#pragma unroll
                            for (int e = 0; e < 4; ++e) { const float xx = dpp_f(p62[e], p63[e], 0);
                                const float pr1 = dpp_f(p63[e], cur[e], 0), pr2 = dpp_f(xx, cur[e], 1);
                                o[e] = bb[e] + w0[e] * pr2 + w1[e] * pr1 + w2[e] * cur[e]; }
                        } else {
#pragma unroll
                            for (int h = 0; h < 2; ++h) {
                                f32x2 pr1, pr2;
#pragma unroll
                                for (int q = 0; q < 2; ++q) { const int pv = __float_as_int(acc[ai][bj][m - 1][n][2 * h + q]), cv = __float_as_int(cur[2 * h + q]);
                                    pr1[q] = __int_as_float(__builtin_amdgcn_update_dpp(__builtin_amdgcn_mov_dpp(pv, 0x121, 0xF, 0xF, false), cv, 0x111, 0xF, 0xF, false));
                                    pr2[q] = __int_as_float(__builtin_amdgcn_update_dpp(__builtin_amdgcn_mov_dpp(pv, 0x122, 0xF, 0xF, false), cv, 0x112, 0xF, 0xF, false)); }
                                const f32x2 c2 = {cur[2 * h], cur[2 * h + 1]}, w02 = {w0[2 * h], w0[2 * h + 1]}, w12 = {w1[2 * h], w1[2 * h + 1]}, w22 = {w2[2 * h], w2[2 * h + 1]}, bb2 = {bb[2 * h], bb[2 * h + 1]};
                                const f32x2 o2 = bb2 + w02 * pr2 + w12 * pr1 + w22 * c2;
                                o[2 * h] = o2[0]; o[2 * h + 1] = o2[1]; }
                        }
                        y[bj][n] = o;
                    }
                u32x4 w;
                { const f32x4 a0 = y[0][0], a1 = y[0][1], v0 = y[1][0], v1 = y[1][1];
                  w.x = cvt_pk_bf16(silu_f(a0[0]) * v0[0], silu_f(a0[1]) * v0[1]); w.y = cvt_pk_bf16(silu_f(a0[2]) * v0[2], silu_f(a0[3]) * v0[3]);
                  w.z = cvt_pk_bf16(silu_f(a1[0]) * v1[0], silu_f(a1[1]) * v1[1]); w.w = cvt_pk_bf16(silu_f(a1[2]) * v1[2], silu_f(a1[3]) * v1[3]); }
                const bool skip = (g == 0) && (m == 0) && (fr < 2) && (u.pm > 0);
                if (!skip) *(u32x4*)(ACT + (size_t)row * ff + j0) = w;
            }
        }
    }
};

template <class Epi, class Sched, bool ALIGN_EPI = false, bool SP2 = false>
__device__ __forceinline__ void gemm_phase(PG8_LAS unsigned char* lds, const Gemm g, const Sched& S, const Epi& E, int wid) {
    const int lane = lane_id(), tid = wid * 64 + lane, wr = wid >> 2, wc = wid & 3, fr = lane & 15, fq = lane >> 4;
    const int K = g.K, nt = K / BK;
    unsigned voffA[2], voffB[2];
#pragma unroll
    for (int i = 0; i < 2; ++i) { int R, C; stage_rc(tid * 16 + i * 8192, R, C); const int Rb = Epi::PERM ? ((R & ~31) + perm32(R & 31)) : R;
        voffA[i] = (unsigned)(R * K + C) * 2u; voffB[i] = (unsigned)(Rb * K + C) * 2u; }
    const size_t kstep = (size_t)(BK * 2);
    const size_t hstep = (size_t)HALF * K * 2;
    const size_t tstep = 2 * hstep;
    const unsigned ldsw = (unsigned)wid * 1024u;
    const int aoff = lds_byte(wr * 64 + fr, fq * 8), boff = lds_byte(wc * 32 + fr, fq * 8);
#define PG8_SA(b, h) (((b) * 2 + (h)) * HTB)
#define PG8_SB(b, h) ((4 + (b) * 2 + (h)) * HTB)
#define PG8_STAGE(bufoff, gbase, voff) do { _Pragma("unroll") for (int _i = 0; _i < 2; ++_i) \
        __builtin_amdgcn_global_load_lds((const unsigned*)((const char*)(gbase) + (voff)[_i]), (PG8_LAS unsigned*)(lds + (bufoff) + ldsw + _i * 8192), 16, 0, 0); } while (0)
#define PG8_LDA(dst, b, h) do { _Pragma("unroll") for (int m = 0; m < 4; ++m) _Pragma("unroll") for (int k = 0; k < 2; ++k) dst[m][k] = *(const PG8_LAS bf16x8*)(lds + PG8_SA(b, h) + aoff + m * 2048 + k * 1024); } while (0)
#define PG8_LDB(dst, b, h) do { _Pragma("unroll") for (int n = 0; n < 2; ++n) _Pragma("unroll") for (int k = 0; k < 2; ++k) dst[n][k] = *(const PG8_LAS bf16x8*)(lds + PG8_SB(b, h) + boff + n * 2048 + k * 1024); } while (0)
#define PG8_MMA(ai, bj, At, Bt) do { __builtin_amdgcn_s_setprio(1); _Pragma("unroll") for (int m = 0; m < 4; ++m) _Pragma("unroll") for (int n = 0; n < 2; ++n) _Pragma("unroll") for (int k = 0; k < 2; ++k) \
        acc[ai][bj][m][n] = __builtin_amdgcn_mfma_f32_16x16x32_bf16(Bt[n][k], At[m][k], acc[ai][bj][m][n], 0, 0, 0); __builtin_amdgcn_s_setprio(0); } while (0)
#define PG8_WAIT_V(n) asm volatile("s_waitcnt vmcnt(" #n ")" ::: "memory")
#define PG8_WAIT_L(n) asm volatile("s_waitcnt lgkmcnt(" #n ")" ::: "memory")
#define PG8_BAR __builtin_amdgcn_s_barrier()
#define PG8_SCHED __builtin_amdgcn_sched_barrier(0)
    Unit cur, nxt; int ui = 0;
    if (!S.next(0, cur)) return;
    f32x4 acc[2][2][4][2];
#pragma unroll
    for (int a = 0; a < 2; ++a)
#pragma unroll
        for (int b = 0; b < 2; ++b)
#pragma unroll
            for (int m = 0; m < 4; ++m)
#pragma unroll
                for (int n = 0; n < 2; ++n) acc[a][b][m][n] = (f32x4){0.f, 0.f, 0.f, 0.f};
    bf16x8 At[4][2], B0[2][2], B1[2][2];
    const char* cA = (const char*)g.A + (size_t)cur.pm * tstep; const char* cB = (const char*)g.Bt + (size_t)cur.pn * tstep;
    S.a_ready(cur);
    if constexpr (SP2) {
        PG8_STAGE(PG8_SB(0, 0), cB, voffB); PG8_STAGE(PG8_SB(0, 1), cB + hstep, voffB); PG8_STAGE(PG8_SA(0, 0), cA, voffA); PG8_STAGE(PG8_SA(0, 1), cA + hstep, voffA);
        if (wr == 1) PG8_BAR;
        PG8_WAIT_V(2); PG8_BAR;
        PG8_STAGE(PG8_SB(1, 0), cB + kstep, voffB); PG8_STAGE(PG8_SA(1, 0), cA + kstep, voffA); PG8_STAGE(PG8_SB(1, 1), cB + hstep + kstep, voffB);
        PG8_WAIT_V(6); PG8_BAR;
    } else {
        PG8_STAGE(PG8_SB(0, 0), cB, voffB); PG8_STAGE(PG8_SA(0, 0), cA, voffA); PG8_STAGE(PG8_SB(0, 1), cB + hstep, voffB); PG8_STAGE(PG8_SA(0, 1), cA + hstep, voffA);
        if (wr == 1) PG8_BAR;
        PG8_WAIT_V(4); PG8_BAR;
        PG8_STAGE(PG8_SB(1, 0), cB + kstep, voffB); PG8_STAGE(PG8_SA(1, 0), cA + kstep, voffA); PG8_STAGE(PG8_SB(1, 1), cB + hstep + kstep, voffB);
        PG8_WAIT_V(6); PG8_BAR;
    }
    for (;;) {
        const bool has_next = S.next(ui + 1, nxt);
        const char* nA = has_next ? (const char*)g.A + (size_t)nxt.pm * tstep : cA; const char* nB = has_next ? (const char*)g.Bt + (size_t)nxt.pn * tstep : cB;
        for (int t = 0; t < nt; t += 2) {
            const bool last = (t == nt - 2);
            const char* a1 = cA + (size_t)(t + 1) * kstep;
            const char* a2 = last ? nA : cA + (size_t)(t + 2) * kstep; const char* b2 = last ? nB : cB + (size_t)(t + 2) * kstep;
            const char* a3 = a2 + kstep; const char* b3 = b2 + kstep;
            if (last && has_next) S.a_ready(nxt);
            if constexpr (SP2) {
            PG8_LDB(B0, 0, 0); PG8_LDB(B1, 0, 1); PG8_SCHED; PG8_LDA(At, 0, 0); PG8_STAGE(PG8_SA(1, 1), a1 + hstep, voffA);
            PG8_WAIT_V(8); PG8_WAIT_L(0); PG8_BAR; PG8_MMA(0, 0, At, B0); PG8_MMA(0, 1, At, B1); PG8_BAR; PG8_SCHED;
            PG8_LDA(At, 0, 1); PG8_STAGE(PG8_SB(0, 0), b2, voffB); PG8_STAGE(PG8_SB(0, 1), b2 + hstep, voffB); PG8_STAGE(PG8_SA(0, 0), a2, voffA);
            PG8_WAIT_V(8); PG8_WAIT_L(0); PG8_BAR; PG8_MMA(1, 0, At, B0); PG8_MMA(1, 1, At, B1); PG8_BAR; PG8_SCHED;
            PG8_LDB(B0, 1, 0); PG8_LDB(B1, 1, 1); PG8_SCHED; PG8_LDA(At, 1, 0); PG8_STAGE(PG8_SA(0, 1), a2 + hstep, voffA);
            PG8_WAIT_V(8); PG8_WAIT_L(0); PG8_BAR; PG8_MMA(0, 0, At, B0); PG8_MMA(0, 1, At, B1); PG8_BAR; PG8_SCHED;
            PG8_LDA(At, 1, 1); PG8_STAGE(PG8_SB(1, 0), b3, voffB); PG8_STAGE(PG8_SB(1, 1), b3 + hstep, voffB); PG8_STAGE(PG8_SA(1, 0), a3, voffA);
            PG8_WAIT_V(8); PG8_WAIT_L(0); PG8_BAR; PG8_MMA(1, 0, At, B0); PG8_MMA(1, 1, At, B1); PG8_BAR; PG8_SCHED;
            } else {
            PG8_LDB(B0, 0, 0); PG8_SCHED; PG8_LDA(At, 0, 0); PG8_STAGE(PG8_SA(1, 1), a1 + hstep, voffA);
            PG8_WAIT_L(8); PG8_BAR; PG8_WAIT_L(0); PG8_MMA(0, 0, At, B0); PG8_BAR; PG8_SCHED;
            PG8_LDB(B1, 0, 1); PG8_STAGE(PG8_SB(0, 0), b2, voffB);
            PG8_BAR; PG8_WAIT_L(0); PG8_MMA(0, 1, At, B1); PG8_BAR;
            PG8_LDA(At, 0, 1); PG8_STAGE(PG8_SA(0, 0), a2, voffA);
            PG8_BAR; PG8_WAIT_L(0); PG8_MMA(1, 0, At, B0); PG8_BAR; PG8_SCHED;
            PG8_STAGE(PG8_SB(0, 1), b2 + hstep, voffB);
            PG8_WAIT_V(6); PG8_BAR; PG8_MMA(1, 1, At, B1); PG8_BAR;
            PG8_LDB(B0, 1, 0); PG8_SCHED; PG8_LDA(At, 1, 0); PG8_STAGE(PG8_SA(0, 1), a2 + hstep, voffA);
            PG8_WAIT_L(8); PG8_BAR; PG8_WAIT_L(0); PG8_MMA(0, 0, At, B0); PG8_BAR; PG8_SCHED;
            PG8_LDB(B1, 1, 1); PG8_STAGE(PG8_SB(1, 0), b3, voffB);
            PG8_BAR; PG8_WAIT_L(0); PG8_MMA(0, 1, At, B1); PG8_BAR;
            PG8_LDA(At, 1, 1); PG8_STAGE(PG8_SA(1, 0), a3, voffA);
            PG8_BAR; PG8_WAIT_L(0); PG8_MMA(1, 0, At, B0); PG8_BAR; PG8_SCHED;
            PG8_STAGE(PG8_SB(1, 1), b3 + hstep, voffB);
            PG8_WAIT_V(6); PG8_BAR; PG8_MMA(1, 1, At, B1); PG8_BAR;
            }
        }
        if constexpr (ALIGN_EPI) { if (wr == 0) PG8_BAR; }
        if constexpr (!Epi::AFTER_DRAIN) { E(acc, cur, wr, wc, fr, fq); S.done(cur); }
        if (!has_next) break;
#pragma unroll
        for (int a = 0; a < 2; ++a)
#pragma unroll
            for (int b = 0; b < 2; ++b)
#pragma unroll
                for (int m = 0; m < 4; ++m)
#pragma unroll
                    for (int n = 0; n < 2; ++n) acc[a][b][m][n] = (f32x4){0.f, 0.f, 0.f, 0.f};
        cur = nxt; cA = nA; cB = nB; ++ui;
        if constexpr (ALIGN_EPI) { if (wr == 1) PG8_BAR; }
    }
    PG8_WAIT_V(0);
    if constexpr (!ALIGN_EPI) { if (wr == 0) PG8_BAR; }
    PG8_BAR;
    if constexpr (Epi::AFTER_DRAIN) { E.fused(acc, cur, wr, wc, fr, fq, lds, wid, lane); S.done(cur); }
#undef PG8_SA
#undef PG8_SB
#undef PG8_STAGE
#undef PG8_LDA
#undef PG8_LDB
#undef PG8_MMA
#undef PG8_WAIT_V
#undef PG8_WAIT_L
#undef PG8_BAR
#undef PG8_SCHED
}
}


#define GAS __attribute__((address_space(1)))
#define LAS __attribute__((address_space(3)))
typedef unsigned short bf16;
typedef unsigned v4u __attribute__((ext_vector_type(4)));
typedef float f32x4 __attribute__((ext_vector_type(4)));
typedef short bf16x8 __attribute__((ext_vector_type(8)));
typedef GAS unsigned gu32;
typedef GAS unsigned long long gu64;
#define RLX_AGENT __ATOMIC_RELAXED, __HIP_MEMORY_SCOPE_AGENT
#define LDS_WAIT() asm volatile("s_waitcnt lgkmcnt(0)" ::: "memory")
#define VM_WAIT() asm volatile("s_waitcnt vmcnt(0)" ::: "memory")
__device__ __forceinline__ unsigned long long rt() { return __builtin_amdgcn_s_memrealtime(); }
__device__ __forceinline__ unsigned f2bf(float f) { unsigned u = __builtin_bit_cast(unsigned, f); return (u + 0x7fffu + ((u >> 16) & 1u)) >> 16; }
__device__ __forceinline__ unsigned pk2(float lo, float hi) { return f2bf(lo) | (f2bf(hi) << 16); }

#define XB_TMO      128
#define XB_XCNT(j)  (256  + 64 * (j))
#define XB_XSUB(j)  (1280 + 64 * (j))
#define XB_XGEN(j)  (2304 + 64 * (j))
#define XB_TOP      3328
#define XB_TOPGEN   3392
#define XCD_BAR_WORDS 3456
#define XB_SPIN_CAP (1u << 18)

__device__ __forceinline__ unsigned xb_ld(unsigned* p)              { return __hip_atomic_load(p, __ATOMIC_RELAXED, __HIP_MEMORY_SCOPE_AGENT); }
__device__ __forceinline__ unsigned xb_add(unsigned* p, unsigned v) { return __hip_atomic_fetch_add(p, v, __ATOMIC_RELAXED, __HIP_MEMORY_SCOPE_AGENT); }
__device__ __forceinline__ unsigned xb_xcc_id() { return (unsigned)__builtin_amdgcn_s_getreg((3 << 11) | 20) & 0xFu; }
#define XB_SPIN(cond, bar) do { unsigned _sp = 0; while (cond) { __builtin_amdgcn_s_sleep(1); \
    if ((++_sp & 255u) == 0u) { if (xb_ld(&(bar)[XB_TMO])) break; if (_sp > XB_SPIN_CAP) { atomicAdd(&(bar)[XB_TMO], 1u); break; } } } } while (0)

struct XcdBarrier {
    unsigned* bar; unsigned x;
    volatile LAS unsigned* st;
};

__device__ __forceinline__ XcdBarrier xcd_barrier_post(unsigned* bar, volatile LAS unsigned* st) {
    XcdBarrier b; b.bar = bar; b.x = xb_xcc_id(); b.st = st;
    if (threadIdx.x == 0) (void)xb_add(&bar[XB_XCNT(b.x)], 1u);
    return b;
}
__device__ __forceinline__ void xcd_barrier_complete(unsigned* bar, unsigned x, unsigned& nloc, unsigned& nx) {
    const unsigned G = gridDim.x * gridDim.y * gridDim.z;
    unsigned sum, cnt, mine, sp = 0u;
    for (;;) {
        sum = 0u; cnt = 0u; mine = 0u;
#pragma unroll
        for (unsigned j = 0; j < 16; ++j) { const unsigned c = xb_ld(&bar[XB_XCNT(j)]); sum += c; cnt += (c > 0u) ? 1u : 0u; mine = (j == x) ? c : mine; }
        if (sum == G) break;
        __builtin_amdgcn_s_sleep(1);
        if ((++sp & 255u) == 0u) { if (xb_ld(&bar[XB_TMO])) break; if (sp > XB_SPIN_CAP) { atomicAdd(&bar[XB_TMO], 1u); break; } }
    }
    nloc = mine > 0u ? mine : 1u; nx = cnt > 0u ? cnt : 1u;
}

__device__ __forceinline__ void xcd_barrier(const XcdBarrier& b) {
    asm volatile("s_waitcnt vmcnt(0)" ::: "memory");
    __syncthreads();
    if (threadIdx.x == 0) {
        unsigned* bar = b.bar;
        __builtin_amdgcn_s_waitcnt(0);
        unsigned nloc = b.st[0], nx = b.st[1];
        if (nloc == 0u) { xcd_barrier_complete(bar, b.x, nloc, nx); b.st[0] = nloc; b.st[1] = nx; }
        const unsigned old = xb_add(&bar[XB_XSUB(b.x)], 1u);
        const unsigned gen = old / nloc;
        if (old + 1u == (gen + 1u) * nloc) {
            __builtin_amdgcn_fence(__ATOMIC_RELEASE, "agent");
            asm volatile("s_waitcnt vmcnt(0)" ::: "memory");
            const unsigned og = xb_add(&bar[XB_TOP], 1u);
            const unsigned tg = og / nx;
            if (og + 1u == (tg + 1u) * nx) xb_add(&bar[XB_TOPGEN], 1u);
            else XB_SPIN(xb_ld(&bar[XB_TOPGEN]) == tg, bar);
            __builtin_amdgcn_fence(__ATOMIC_ACQUIRE, "agent");
            xb_add(&bar[XB_XGEN(b.x)], 1u);
            asm volatile("s_waitcnt vmcnt(0)" ::: "memory");
        } else {
            XB_SPIN(xb_ld(&bar[XB_XGEN(b.x)]) == gen, bar);
            __builtin_amdgcn_fence(__ATOMIC_ACQUIRE, "agent");
            asm volatile("s_waitcnt vmcnt(0)" ::: "memory");
        }
    }
    __syncthreads();
}


constexpr size_t MiB = 1u << 20;
constexpr size_t WS_CTL = 0, CTL_ZERO_BYTES = 32 * 1024;
constexpr size_t WS_PART = 1 * MiB;
constexpr size_t WS_MOD = 3 * MiB, WS_LB = 3 * MiB + 128 * 1024;
constexpr size_t WS_LF = 4 * MiB, WS_CL = 5 * MiB, WS_BB = 6 * MiB;
constexpr size_t WS_DBT = 6 * MiB + 65536;
constexpr size_t WS_NRM = 7 * MiB;
constexpr size_t WS_WF = 8 * MiB;
constexpr size_t WS_WIN = 16 * MiB, WS_WO = 128 * MiB, WS_WUP = 160 * MiB, WS_WD = 332 * MiB;
constexpr size_t WS_H = 418 * MiB;
constexpr size_t WS_PROJ = 482 * MiB;
constexpr size_t WS_MIX = 706 * MiB;
constexpr size_t WS_D1 = 770 * MiB, WS_D2 = 834 * MiB;
constexpr size_t WS_HU = 898 * MiB, WS_HS = 1026 * MiB, WS_HD = 1090 * MiB;
constexpr size_t WS_UH = 898 * MiB;
constexpr size_t WS_ACT = 482 * MiB;
constexpr size_t WS_OFOX = 1100 * MiB, WS_OHG = 1164 * MiB, WS_END = 1228 * MiB;
constexpr int CW_BAR = 4096;
constexpr int CW_WD = 128;
constexpr int KSPLIT = 16;
constexpr int KSPLIT_A = 4;

constexpr int RING_BYTES = 133120  , LDSCTL_OFF = RING_BYTES, MISC_OFF = LDSCTL_OFF + 320, HALO_OFF = RING_BYTES + 1024  , LDS_BYTES = 147456;

enum { PC_PRO = 0, PC_MODR = 1, PC_NORM1 = 2, PC_CUM = 3, PC_GEMM1 = 4, PC_HGA = 5, PC_HGB = 6, PC_HGC = 7, PC_ATTN = 8, PC_GEMM2 = 9, PC_NORM2 = 10, PC_GEMM3 = 11, PC_CONV = 12, PC_GEMM4 = 13, PC_FNORM = 14, PC_N = 15 };

struct Args { const float* in[17]; float* out; unsigned char* ws; unsigned mask; unsigned pad; };

__device__ __forceinline__ float wave_sum(float v) {
#pragma unroll
    for (int o = 1; o < 64; o <<= 1) v += __shfl_xor(v, o);
    return v;
}
__device__ __forceinline__ float sigm_f(float z) { return __builtin_amdgcn_rcpf(1.0f + __builtin_amdgcn_exp2f(-LOG2E * z)); }
__device__ __forceinline__ float silu2_f(float z) { return z * sigm_f(z); }

#ifndef WD_PRO_KB
#define WD_PRO_KB 0
#endif
constexpr int WD_PRO_ITEMS = WD_PRO_KB * (D / 64), WD_DEFER_ITEMS = (FF / 64) * (D / 64) - WD_PRO_ITEMS;
struct TrItem { const float* src; bf16* dst; int ldw, ldt; int nt; };
__device__ __forceinline__ void tr_load(const TrItem& it, f32x4 (&r)[16], int lane) {
    const int a4 = (lane & 15) * 4, kr = lane >> 4;
#pragma unroll
#ifdef TRLOAD_PLAIN
    for (int i = 0; i < 16; ++i) r[i] = *((const GAS f32x4*)(it.src + (size_t)(4 * i + kr) * it.ldw + a4));
#else
    for (int i = 0; i < 16; ++i) r[i] = __builtin_nontemporal_load((const GAS f32x4*)(it.src + (size_t)(4 * i + kr) * it.ldw + a4));
#endif
}
__device__ __forceinline__ void tr_store(const TrItem& it, const f32x4 (&r)[16], LAS float* scr, int lane) {
    const int a4 = (lane & 15) * 4, kr = lane >> 4;
#pragma unroll
    for (int i = 0; i < 16; ++i) { LAS float* d = scr + (4 * i + kr) * 65 + a4; d[0] = r[i].x; d[1] = r[i].y; d[2] = r[i].z; d[3] = r[i].w; }
    LDS_WAIT(); asm volatile("" ::: "memory");
    const int c = lane & 7;
#pragma unroll
    for (int j = 0; j < 8; ++j) { const int n = (lane >> 3) + 8 * j; const LAS float* s = scr + (8 * c) * 65 + n;
        v4u o; o.x = pk2(s[0 * 65], s[1 * 65]); o.y = pk2(s[2 * 65], s[3 * 65]); o.z = pk2(s[4 * 65], s[5 * 65]); o.w = pk2(s[6 * 65], s[7 * 65]);
        GAS v4u* dp = (GAS v4u*)(it.dst + (size_t)n * it.ldt + 8 * c); if (it.nt) __builtin_nontemporal_store(o, dp); else *dp = o; }
    LDS_WAIT(); asm volatile("" ::: "memory");
}
__device__ __forceinline__ TrItem tr_mk(const float* W, int ldw, int c0, int k0, bf16* WT, int ldt, int drow0, int nt = 0) { TrItem t; t.src = W + (size_t)k0 * ldw + c0; t.dst = WT + (size_t)drow0 * ldt + k0; t.ldw = ldw; t.ldt = ldt; t.nt = nt; return t; }
__device__ __forceinline__ void tr_item(const float* W, int ldw, int c0, int k0, bf16* WT, int ldt, int drow0, LAS float* scr, int lane) {
    const TrItem t = tr_mk(W, ldw, c0, k0, WT, ldt, drow0); f32x4 r[16]; tr_load(t, r, lane); tr_store(t, r, scr, lane);
}
template <int PARTS>
__device__ __forceinline__ void ph_prologue(const Args* ka, LAS unsigned char* lds, int vcu, int G, int tid, int lane, int wave) {
    unsigned char* ws = ka->ws;
    const float* c = ka->in[1]; const float* w_ada = ka->in[2]; const float* w_in = ka->in[5]; const float* lbl = ka->in[7];
    const float* w_out = ka->in[10]; const float* w_up = ka->in[12]; const float* w_down = ka->in[15];
#ifdef TOUCH_X
    if constexpr (PARTS & 1) {
        const float* xp = ka->in[0]; float acc_ = 0.f;
        for (int i = vcu * 512 + tid; i < (int)(((size_t)T * D * 4) / TOUCH_X); i += G * 512) acc_ += __builtin_nontemporal_load(xp + (size_t)i * (TOUCH_X / 4));
        if (acc_ == 1.2345e-38f) ((float*)(ws + WS_PART))[0] = acc_;
    }
#endif
    LAS float* sc_ = (LAS float*)lds;
    for (int i = tid; i < D; i += 512) sc_[i] = silu2_f(c[i]);
    __syncthreads();
    float* part = (float*)(ws + WS_PART);
    constexpr int NCG = NMOD / 4, KROWS = D / KSPLIT, CG0 = (PARTS & 1) ? 0 : 2 * D / 4, CG1 = (PARTS & 2) ? NCG : 2 * D / 4, NCGP = CG1 - CG0;
    if constexpr (PARTS == 1) {
        static_assert(KSPLIT_A * (2 * D / 4 / 32) == 256, "one block per workgroup of a 256-workgroup grid");
        for (int blk = vcu; blk < KSPLIT_A * (2 * D / 4 / 32); blk += G) {
            const int ks = blk & (KSPLIT_A - 1), cg = (blk / KSPLIT_A) * 32 + (tid & 31), kk = tid >> 5;
            const GAS f32x4* wp = (const GAS f32x4*)(w_ada + (size_t)(ks * (D / KSPLIT_A) + kk) * NMOD) + cg;
            f32x4 acc = {0.f, 0.f, 0.f, 0.f};
#pragma unroll 8
            for (int j = 0; j < D / KSPLIT_A / 16; ++j) { const f32x4 w = __builtin_nontemporal_load(wp + (size_t)(16 * j) * NCG); acc += w * sc_[ks * (D / KSPLIT_A) + kk + 16 * j]; }
            LAS f32x4* red = (LAS f32x4*)(lds + 16384);
            red[tid] = acc;
            __syncthreads();
            if (tid < 32) { f32x4 t = red[tid];
#pragma unroll
                for (int q = 1; q < 16; ++q) t += red[tid + 32 * q];
                ((GAS f32x4*)(part + (size_t)ks * NMOD))[cg] = t; }
            __syncthreads();
        }
    } else
    for (int it = vcu * 512 + tid; it < KSPLIT * NCGP; it += G * 512) {
        const int ks = it / NCGP, cg = CG0 + it % NCGP;
        const GAS f32x4* wp = (const GAS f32x4*)(w_ada + (size_t)(ks * KROWS) * NMOD) + cg;
        f32x4 acc = {0.f, 0.f, 0.f, 0.f};
#pragma unroll 8
        for (int k = 0; k < KROWS; ++k) { const f32x4 w = __builtin_nontemporal_load(wp + (size_t)k * NCG); acc += w * sc_[ks * KROWS + k]; }
        ((GAS f32x4*)(part + (size_t)ks * NMOD))[cg] = acc;
    }
    if constexpr (PARTS & 1) {
    float* lb = (float*)(ws + WS_LB);
    for (int i = vcu * 512 + tid; i < 2048; i += G * 512) lb[i] = 1.0f / (1.0f + __expf(-(lbl[i] - lbl[2048 + i])));
    bf16* WfT = (bf16*)(ws + WS_WF);
    for (int i = vcu * 512 + tid; i < 16 * D; i += G * 512) { const int k = i >> 4, n = i & 15; WfT[(size_t)n * D + k] = (bf16)f2bf(w_in[(size_t)k * INC + FOX_F0 + n]); }
    }
    __syncthreads();
    LAS float* scr = (LAS float*)(lds + wave * 16640);
    const int gw = vcu * 8 + wave, NGW = G * 8;
    constexpr int NB_A = FOX_F0 / 64, NB_B = (NPROJ - FOX_F0) / 64, NB_C = D / 64, NB_D = FF2 / 64, NB_E = D / 64;
    constexpr int I_A = 64 * NB_A, I_B = 64 * NB_B, I_C = 64 * NB_C, I_D = 64 * NB_D, I_E = WD_PRO_ITEMS  , NITEMS = I_A + I_B + I_C + I_D + I_E;
    bf16* WinT = (bf16*)(ws + WS_WIN); bf16* WoT = (bf16*)(ws + WS_WO); bf16* WupT = (bf16*)(ws + WS_WUP); bf16* WdT = (bf16*)(ws + WS_WD);
    auto decode = [&](int it) -> TrItem { int r = it;
        if (r < I_A) { const int kb = 8 * ((r >> 3) / NB_A) + (r & 7), nb = (r >> 3) % NB_A; return tr_mk(w_in, INC, 64 * nb, 64 * kb, WinT, D, 64 * nb); } r -= I_A;
        if (r < I_B) { const int kb = 8 * ((r >> 3) / NB_B) + (r & 7), nb = (r >> 3) % NB_B; return tr_mk(w_in, INC, HG_Q0 + 64 * nb, 64 * kb, WinT, D, FOX_F0 + 64 * nb); } r -= I_B;
        if (r < I_C) { const int kb = 8 * ((r >> 3) / NB_C) + (r & 7), nb = (r >> 3) % NB_C; return tr_mk(w_out, D, 64 * nb, 64 * kb, WoT, D, 64 * nb, 1); } r -= I_C;
        if (r < I_D) { const int kb = 8 * ((r >> 3) / NB_D) + (r & 7), nb = (r >> 3) % NB_D; const int c0 = 64 * nb, cc = c0 < FF ? c0 : c0 - FF; return tr_mk(w_up, FF2, c0, 64 * kb, WupT, D, 256 * (cc >> 7) + (c0 < FF ? 0 : 128) + (cc & 127), 1); } r -= I_D;
        { const int kb = r / NB_E, nb = r % NB_E; return tr_mk(w_down, D, 64 * nb, 64 * kb, WdT, FF, 64 * nb); } };
    f32x4 ra[16], rb[16];
    constexpr int IT0 = (PARTS & 1) ? 0 : I_A + I_B, IT1 = (PARTS & 2) ? NITEMS : I_A + I_B;
    static_assert(I_E == 0, "the w_down items sit behind the deferred ones");
    int it = IT0 + gw;
    if (it < IT1) { TrItem ta = decode(it); tr_load(ta, ra, lane);
        for (;;) {
            const int itb = it + NGW; const bool hb = itb < IT1; TrItem tb = ta; if (hb) { tb = decode(itb); tr_load(tb, rb, lane); }
            tr_store(ta, ra, scr, lane);
            if (!hb) break;
            const int itc = itb + NGW; const bool hc = itc < IT1; if (hc) { ta = decode(itc); tr_load(ta, ra, lane); }
            tr_store(tb, rb, scr, lane);
            if (!hc) break;
            it = itc;
        }
    }
}
__device__ __forceinline__ void ph_convert_wd(const Args* ka, LAS unsigned char* lds, int rank, int nrank, int wave) {
    const int lane = lane_id(); const float* w_down = ka->in[15]; bf16* WdT = (bf16*)(ka->ws + WS_WD);
    LAS float* scr = (LAS float*)(lds + wave * 16640);
    for (int r0 = rank * 8 + wave; r0 < WD_DEFER_ITEMS; r0 += nrank * 8) { const int r = r0 + WD_PRO_ITEMS, kb = r / (D / 64), nb = r % (D / 64); tr_item(w_down, D, 64 * nb, 64 * kb, WdT, FF, 64 * nb, scr, lane); }
}
__device__ __forceinline__ void ph_convert_wd_dyn(const Args* ka, LAS unsigned char* lds, int wave) {
    const int lane = lane_id(); const float* w_down = ka->in[15]; bf16* WdT = (bf16*)(ka->ws + WS_WD);
    unsigned* ctr = (unsigned*)(ka->ws + WS_CTL) + CW_WD;
    LAS float* scr = (LAS float*)(lds + wave * 16640);
#ifndef WD_CHUNK
#define WD_CHUNK 8
#endif
    int cur = 0, end = 0;
    auto next = [&]() -> int { if (cur == end) { unsigned v = 0u; if (lane == 0) v = xb_add(ctr, 1u); cur = (int)__builtin_amdgcn_readfirstlane(v) * WD_CHUNK; end = cur + WD_CHUNK; } return cur++; };
    auto mk = [&](int r0) -> TrItem { const int r = r0 + WD_PRO_ITEMS, kb = r / (D / 64), nb = r % (D / 64); return tr_mk(w_down, D, 64 * nb, 64 * kb, WdT, FF, 64 * nb); };
    static_assert(WD_DEFER_ITEMS % WD_CHUNK == 0, "whole chunks");
    f32x4 ra[16], rb[16];
    const int ia = next();
    if (ia >= WD_DEFER_ITEMS) return;
    TrItem ta = mk(ia); tr_load(ta, ra, lane);
    for (;;) {
        const int ib = next(); const bool hb = ib < WD_DEFER_ITEMS; TrItem tb = ta; if (hb) { tb = mk(ib); tr_load(tb, rb, lane); }
        tr_store(ta, ra, scr, lane);
        if (!hb) break;
        const int ic = next(); const bool hc = ic < WD_DEFER_ITEMS; if (hc) { ta = mk(ic); tr_load(ta, ra, lane); }
        tr_store(tb, rb, scr, lane);
        if (!hc) break;
    }
}
__device__ __forceinline__ void ph_modreduce(const Args* ka, int i0, int vcu, int G, int tid) {
    const float* part = (const float*)(ka->ws + WS_PART); const float* b = ka->in[3]; float* mod = (float*)(ka->ws + WS_MOD);
    for (int i = i0 + vcu * 512 + tid; i < NMOD; i += G * 512) { float s = b[i];
#pragma unroll
        for (int ks = 0; ks < KSPLIT; ++ks) s += part[(size_t)ks * NMOD + i];
        mod[i] = s; }
}
template <bool FGATE>
__device__ __forceinline__ void ph_norm(const float* x, const bf16* d1, const float* g, const float* sh, const float* sc, bf16* H, const bf16* WfT, const float* bfox, float* lf, float* modout, int modn,
                                        LAS unsigned char* lds, int vcu, int G, int tid, int lane, int wave) {
    LAS float* A_ = (LAS float*)lds; LAS float* B_ = A_ + D;
    if constexpr (FGATE) {
        const float* part = sh; const float* bada = sc;
#ifndef RED_REP
#define RED_REP 1
#endif
#ifndef FG_REP
#define FG_REP 1
#endif
        const bool blocked = modn < NMOD;
        for (int rr_ = 0; rr_ < RED_REP; ++rr_)
        for (int i4 = tid; i4 < D / 4; i4 += 512) { f32x4 s0 = *(const GAS f32x4*)(bada + 4 * i4), s1 = *(const GAS f32x4*)(bada + D + 4 * i4);
            if (blocked) {
#pragma unroll
                for (int ks = 0; ks < KSPLIT_A; ++ks) { s0 += *(const GAS f32x4*)(part + (size_t)ks * NMOD + 4 * i4); s1 += *(const GAS f32x4*)(part + (size_t)ks * NMOD + D + 4 * i4); }
            } else {
#pragma unroll
            for (int ks = 0; ks < KSPLIT; ++ks) { s0 += *(const GAS f32x4*)(part + (size_t)ks * NMOD + 4 * i4); s1 += *(const GAS f32x4*)(part + (size_t)ks * NMOD + D + 4 * i4); }
            }
            const f32x4 gv = *(const GAS f32x4*)(g + 4 * i4);
            *(LAS f32x4*)(A_ + 4 * i4) = gv * (s1 + 1.0f); *(LAS f32x4*)(B_ + 4 * i4) = s0; }
        const int nred = modn, per = (nred + G - 1) / G, iend = (vcu + 1) * per < nred ? (vcu + 1) * per : nred;
        for (int i = vcu * per + tid; i < iend; i += 512) { float s = bada[i];
            for (int ks = 0; ks < (blocked ? KSPLIT_A : KSPLIT); ++ks) s += part[(size_t)ks * NMOD + i];
            modout[i] = s; }
    } else {
        for (int i = tid; i < D; i += 512) { A_[i] = g[i] * (1.0f + sc[i]); B_[i] = sh[i]; }
    }
    __syncthreads();
    for (int blk = vcu; blk < T / 32; blk += G) {
        const int row0 = blk * 32;
#pragma unroll 1
        for (int j = 0; j < 4; ++j) {
            const int row = row0 + wave * 4 + j;
            const GAS f32x4* xr = (const GAS f32x4*)(x + (size_t)row * D) + lane;
            f32x4 v[16]; float s = 0.f;
#pragma unroll
            for (int jj = 0; jj < 16; ++jj) { v[jj] = __builtin_nontemporal_load(xr + 64 * jj);
                if constexpr (!FGATE) { const unsigned long long dw = ((const GAS unsigned long long*)(d1 + (size_t)row * D) + lane)[64 * jj]; const unsigned w0 = (unsigned)dw, w1 = (unsigned)(dw >> 32);
                    v[jj].x += __uint_as_float(w0 << 16); v[jj].y += __uint_as_float(w0 & 0xffff0000u); v[jj].z += __uint_as_float(w1 << 16); v[jj].w += __uint_as_float(w1 & 0xffff0000u); }
                s += (v[jj].x * v[jj].x + v[jj].y * v[jj].y) + (v[jj].z * v[jj].z + v[jj].w * v[jj].w); }
            const float r = 1.0f / sqrtf(wave_sum(s) * (1.0f / D) + EPS);
            GAS unsigned long long* o8 = (GAS unsigned long long*)(H + (size_t)row * D) + lane;
#pragma unroll
            for (int jj = 0; jj < 16; ++jj) { const f32x4 av = *(const LAS f32x4*)(A_ + 4 * (lane + 64 * jj)), bv = *(const LAS f32x4*)(B_ + 4 * (lane + 64 * jj));
                const f32x4 hv = v[jj] * r * av + bv;
                o8[64 * jj] = (unsigned long long)pk2(hv.x, hv.y) | ((unsigned long long)pk2(hv.z, hv.w) << 32); }
        }
        if constexpr (FGATE) for (int fr_ = 0; fr_ < FG_REP; ++fr_) {
            __syncthreads();
            const int g_ = wave >> 2, kq = wave & 3; f32x4 acc = {0.f, 0.f, 0.f, 0.f};
            const bf16* ap = H + (size_t)(row0 + 16 * g_ + (lane & 15)) * D + kq * 1024 + (lane >> 4) * 8;
            const bf16* bp = WfT + (size_t)(lane & 15) * D + kq * 1024 + (lane >> 4) * 8;
#pragma unroll 16
            for (int s = 0; s < 32; ++s) { const bf16x8 av = *(const GAS bf16x8*)(ap + 32 * s), bv = *(const GAS bf16x8*)(bp + 32 * s); acc = __builtin_amdgcn_mfma_f32_16x16x32_bf16(av, bv, acc, 0, 0, 0); }
            LAS f32x4* red = (LAS f32x4*)(lds + 32768);
            red[wave * 64 + lane] = acc;
            __syncthreads();
            if (kq == 0) { const f32x4 t = (red[(g_ * 4 + 0) * 64 + lane] + red[(g_ * 4 + 1) * 64 + lane]) + (red[(g_ * 4 + 2) * 64 + lane] + red[(g_ * 4 + 3) * 64 + lane]);
                const int head = lane & 15; const float bias = bfox[head];
#pragma unroll
                for (int e = 0; e < 4; ++e) { const float z = t[e] + bias; lf[(size_t)head * T + row0 + 16 * g_ + (lane >> 4) * 4 + e] = fminf(z, 0.f) - log1pf(__expf(-fabsf(z))); } }
            __syncthreads();
        }
    }
}
__device__ __forceinline__ void ph_cum(const Args* ka, LAS unsigned char* lds, int vcu, int tid, int lane) {
    if (vcu >= NH) return;
    const int h = vcu; const float* lf = (const float*)(ka->ws + WS_LF) + (size_t)h * T + tid * 16; float* cl = (float*)(ka->ws + WS_CL) + (size_t)h * T + tid * 16;
    double* Bb = (double*)(ka->ws + WS_BB) + h * 32;
    float v[16];
#pragma unroll
    for (int q = 0; q < 4; ++q) { const f32x4 t = ((const GAS f32x4*)lf)[q]; v[4 * q] = t.x; v[4 * q + 1] = t.y; v[4 * q + 2] = t.z; v[4 * q + 3] = t.w; }
    float run = 0.f;
#pragma unroll
    for (int j = 0; j < 16; ++j) { run += v[j] * LOG2E; v[j] = run; }
    float s = run;
#pragma unroll
    for (int d = 1; d < 16; d <<= 1) { const float y = __shfl_up(s, d, 16); if ((lane & 15) >= d) s += y; }
    const float excl = s - run;
#pragma unroll
    for (int q = 0; q < 4; ++q) ((GAS f32x4*)cl)[q] = (f32x4){-(v[4 * q] + excl), -(v[4 * q + 1] + excl), -(v[4 * q + 2] + excl), -(v[4 * q + 3] + excl)};
    LAS double* bt = (LAS double*)lds;
    if ((lane & 15) == 15) bt[tid >> 4] = (double)s;
    __syncthreads();
    if (tid == 0) { double c = 0.0; for (int b = 0; b < 32; ++b) { Bb[b] = c; c += bt[b]; } }
    __syncthreads();
    if (tid < 32) { double c = 0.0; for (int b = 0; b < tid; ++b) c += bt[b]; bt[32 + tid] = c; }
    __syncthreads();
    { float* dBt = (float*)(ka->ws + WS_DBT) + h * 1024;
      for (int e = tid; e < 1024; e += 512) dBt[e] = (float)(bt[32 + (e >> 5)] - bt[32 + (e & 31)]); }
    __syncthreads();
}
__device__ __forceinline__ void ph_convfix(const Args* ka, int vcu, int G, int tid) {
    const float* UH = (const float*)(ka->ws + WS_UH); bf16* ACT = (bf16*)(ka->ws + WS_ACT); const float* cw = ka->in[13]; const float* cb = ka->in[14];
    constexpr int NCG = FF / 4, NIT = 31 * NCG;
    for (int it = vcu * 512 + tid; it < NIT; it += G * 512) {
        const int pm = 1 + it / NCG, j0 = (it % NCG) * 4;
        f32x4 act[2];
        f32x4 ua[4], uv[4];
#pragma unroll
        for (int q = 0; q < 4; ++q) { const size_t rowoff = (size_t)((q < 2 ? (pm - 1) * 4 + 2 + q : pm * 4 + (q - 2))) * FF2;
            ua[q] = *(const GAS f32x4*)(UH + rowoff + j0); uv[q] = *(const GAS f32x4*)(UH + rowoff + FF + j0); }
        f32x4 wa[3], wv[3];
#pragma unroll
        for (int tp = 0; tp < 3; ++tp) { wa[tp] = *(const GAS f32x4*)(cw + (size_t)tp * FF2 + j0); wv[tp] = *(const GAS f32x4*)(cw + (size_t)tp * FF2 + FF + j0); }
        const f32x4 ba = *(const GAS f32x4*)(cb + j0), bv = *(const GAS f32x4*)(cb + FF + j0);
#pragma unroll
        for (int rr = 0; rr < 2; ++rr) { const f32x4 ya = ba + wa[0] * ua[rr] + wa[1] * ua[rr + 1] + wa[2] * ua[rr + 2], yv = bv + wv[0] * uv[rr] + wv[1] * uv[rr + 1] + wv[2] * uv[rr + 2];
            act[rr] = (f32x4){silu2_f(ya.x) * yv.x, silu2_f(ya.y) * yv.y, silu2_f(ya.z) * yv.z, silu2_f(ya.w) * yv.w};
            *(GAS unsigned long long*)(ACT + (size_t)(pm * 256 + rr) * FF + j0) = (unsigned long long)pk2(act[rr].x, act[rr].y) | ((unsigned long long)pk2(act[rr].z, act[rr].w) << 32); }
    }
}
__device__ __forceinline__ void ph_fnorm(const float* x, const bf16* d1, const bf16* d2, float* out, const float* g, int vcu, int G, int lane, int wave) {
    const int gw = vcu * 8 + wave, NGW = G * 8;
    for (int row = gw; row < T; row += NGW) {
        const GAS f32x4* xr = (const GAS f32x4*)(x + (size_t)row * D) + lane;
        const GAS unsigned long long* p1 = (const GAS unsigned long long*)(d1 + (size_t)row * D) + lane; const GAS unsigned long long* p2 = (const GAS unsigned long long*)(d2 + (size_t)row * D) + lane;
        f32x4 v[16]; float s = 0.f;
#pragma unroll
        for (int jj = 0; jj < 16; ++jj) { v[jj] = __builtin_nontemporal_load(xr + 64 * jj); const unsigned long long a1 = __builtin_nontemporal_load(p1 + 64 * jj), a2 = __builtin_nontemporal_load(p2 + 64 * jj);
            const unsigned w0 = (unsigned)a1, w1 = (unsigned)(a1 >> 32), y0 = (unsigned)a2, y1 = (unsigned)(a2 >> 32);
            v[jj].x += __uint_as_float(w0 << 16) + __uint_as_float(y0 << 16); v[jj].y += __uint_as_float(w0 & 0xffff0000u) + __uint_as_float(y0 & 0xffff0000u);
            v[jj].z += __uint_as_float(w1 << 16) + __uint_as_float(y1 << 16); v[jj].w += __uint_as_float(w1 & 0xffff0000u) + __uint_as_float(y1 & 0xffff0000u);
            s += (v[jj].x * v[jj].x + v[jj].y * v[jj].y) + (v[jj].z * v[jj].z + v[jj].w * v[jj].w); }
        const float r = 1.0f / sqrtf(wave_sum(s) * (1.0f / D) + EPS);
        GAS f32x4* orow = (GAS f32x4*)(out + (size_t)row * D) + lane;
#pragma unroll
        for (int jj = 0; jj < 16; ++jj) { const f32x4 gv = *(const GAS f32x4*)(g + 4 * (lane + 64 * jj)); __builtin_nontemporal_store(v[jj] * r * gv, orow + 64 * jj); }
    }
}

namespace fa {
typedef short bf16x8 __attribute__((ext_vector_type(8)));
typedef short s16x4 __attribute__((ext_vector_type(4)));
typedef float f32x16 __attribute__((ext_vector_type(16)));
typedef float f32x4 __attribute__((ext_vector_type(4)));
typedef unsigned u32x4 __attribute__((ext_vector_type(4)));
constexpr int NW = 8, QBLK = 32, KVBLK = 64, QB = NW * QBLK, DH = 128;
constexpr int SHM_V = KVBLK * DH * 2, SHM_K = KVBLK * DH * 2;
constexpr int LDS_BYTES = 2 * SHM_V + 2 * SHM_K + NW * 64 * 4;
constexpr float THR2 = 11.5f;
#define KSWZ(row, colB) ((row) * 256 + ((colB) ^ (((row) & 7) << 4)))
#define SBAR() __builtin_amdgcn_sched_barrier(0)
__device__ __forceinline__ int v_st(int k, int c) { const int kk = (k & ~0xC) | ((k & 4) << 1) | ((k & 8) >> 1); return ((kk >> 3) * 4 + (c >> 5)) * 512 + ((kk & 7) * 32 + (c & 31)) * 2; }
__device__ __forceinline__ int v_rd_base(int lane) { return ((lane & 3) << 3) | (((lane >> 2) & 3) << 6) | (((lane >> 4) & 1) << 5) | (((lane >> 5) & 1) << 8); }
constexpr int v_rd_off(int d0, int ks, int half) { return d0 * 512 + ks * 4096 + half * 2048; }
__device__ __forceinline__ int crow(int r, int hi) { return (r & 3) + 8 * (r >> 2) + 4 * hi; }
__device__ __forceinline__ unsigned cvtpk(float lo, float hi) { unsigned r; asm volatile("v_cvt_pk_bf16_f32 %0, %1, %2" : "=v"(r) : "v"(lo), "v"(hi)); return r; }
template <int M> __device__ __forceinline__ float swz_xor(float v) { return __int_as_float(__builtin_amdgcn_ds_swizzle(__float_as_int(v), 0x1F | (M << 10))); }
__device__ __forceinline__ bf16x8 load8(const bf16* p) { return *reinterpret_cast<const bf16x8*>(p); }
__device__ __forceinline__ void mask_tile(f32x16& p0, f32x16& p1, int dq) {
    const float NEG = -__builtin_inff();
#pragma unroll
    for (int r = 0; r < 16; ++r) { const int c = (r & 3) + 8 * (r >> 2); if (dq - c < 0) p0[r] = NEG; if (dq - c - 32 < 0) p1[r] = NEG; }
}
__device__ __forceinline__ void partialSM(f32x16& p0, f32x16& p1, float& m_reg, float& mn, float& alpha, float dB) {
    float pmax = p0[0]; for (int r = 1; r < 16; ++r) pmax = fmaxf(pmax, p0[r]); for (int r = 0; r < 16; ++r) pmax = fmaxf(pmax, p1[r]);
    { auto rr = __builtin_amdgcn_permlane32_swap(__float_as_uint(pmax), __float_as_uint(pmax), false, false);
      pmax = fmaxf(__uint_as_float(rr[0]), __uint_as_float(rr[1])); }
    const float pm = pmax + dB;
    if (__builtin_expect(__all(pm - m_reg <= THR2), 1)) { mn = m_reg; alpha = 1.f; }
    else { mn = fmaxf(m_reg, pm); alpha = __builtin_amdgcn_exp2f(m_reg - mn); m_reg = mn; }
    const float sub = mn - dB;
    for (int r = 0; r < 16; ++r) p0[r] = p0[r] - sub; for (int r = 0; r < 16; ++r) p1[r] = p1[r] - sub;
    for (int r = 0; r < 16; ++r) p0[r] = __builtin_amdgcn_exp2f(p0[r]);
}
__device__ __forceinline__ void finishSM(f32x16& p0, f32x16& p1, float alpha, float& l_reg, bf16x8& pa0, bf16x8& pa1, bf16x8& pa2, bf16x8& pa3) {
    for (int r = 0; r < 16; ++r) p1[r] = __builtin_amdgcn_exp2f(p1[r]);
    float ps = 0; for (int r = 0; r < 16; ++r) ps += p0[r]; for (int r = 0; r < 16; ++r) ps += p1[r];
    { auto rr = __builtin_amdgcn_permlane32_swap(__float_as_uint(ps), __float_as_uint(ps), false, false);
      ps = __uint_as_float(rr[0]) + __uint_as_float(rr[1]); }
    l_reg = l_reg * alpha + ps;
#define PK4(P, B_, OUT) do { unsigned a0 = cvtpk(P[B_+0], P[B_+1]), a1 = cvtpk(P[B_+2], P[B_+3]);                          \
        unsigned b0 = cvtpk(P[B_+4], P[B_+5]), b1 = cvtpk(P[B_+6], P[B_+7]);                                             \
        auto r0 = __builtin_amdgcn_permlane32_swap(a0, b0, false, false); auto r1 = __builtin_amdgcn_permlane32_swap(a1, b1, false, false); \
        u32x4 w = {r0[0], r1[0], r0[1], r1[1]}; OUT = *reinterpret_cast<bf16x8*>(&w); } while (0)
    PK4(p0, 0, pa0); PK4(p0, 8, pa1); PK4(p1, 0, pa2); PK4(p1, 8, pa3);
#undef PK4
}
template <int KB>
__device__ __forceinline__ void qkt(f32x16& p0, f32x16& p1, const char* K_lds, int r32, int hi, const bf16x8* qr) {
    const char* kb[4];
#pragma unroll
    for (int dd = 0; dd < 4; ++dd) kb[dd] = K_lds + KB * SHM_K + KSWZ(r32, (dd * 16 + hi * 8) * 2);
#pragma unroll
    for (int d0 = 0; d0 < 8; ++d0) { const char* a = kb[d0 & 3] + (d0 >> 2) * 128;
        bf16x8 b0 = *reinterpret_cast<const bf16x8*>(a);
        bf16x8 b1 = *reinterpret_cast<const bf16x8*>(a + 32 * 256);
        p0 = __builtin_amdgcn_mfma_f32_32x32x16_bf16(b0, qr[d0], p0, 0, 0, 0);
        p1 = __builtin_amdgcn_mfma_f32_32x32x16_bf16(b1, qr[d0], p1, 0, 0, 0); }
}
template <int VB>
__device__ __forceinline__ void pv_tile(f32x16* o, int vb0, bf16x8 pa0, bf16x8 pa1, bf16x8 pa2, bf16x8 pa3) {
#define TRRD(dst, off) asm volatile("ds_read_b64_tr_b16 %0, %1 offset:%2" : "=&v"(dst) : "v"(vb0), "i"(off) : "memory")
#define PV_D0(d0) do { s16x4 l0, l1, l2, l3, h0, h1, h2, h3; constexpr int b_ = VB * SHM_V + v_rd_off(d0, 0, 0);   \
        TRRD(l0, b_); TRRD(h0, b_ + 2048); TRRD(l1, b_ + 4096); TRRD(h1, b_ + 6144); TRRD(l2, b_ + 8192); TRRD(h2, b_ + 10240); TRRD(l3, b_ + 12288); TRRD(h3, b_ + 14336); \
        asm volatile("s_waitcnt lgkmcnt(0)" ::: "memory"); SBAR();   \
        o[d0] = __builtin_amdgcn_mfma_f32_32x32x16_bf16(pa0, (bf16x8){l0[0], l0[1], l0[2], l0[3], h0[0], h0[1], h0[2], h0[3]}, o[d0], 0, 0, 0);   \
        o[d0] = __builtin_amdgcn_mfma_f32_32x32x16_bf16(pa1, (bf16x8){l1[0], l1[1], l1[2], l1[3], h1[0], h1[1], h1[2], h1[3]}, o[d0], 0, 0, 0);   \
        o[d0] = __builtin_amdgcn_mfma_f32_32x32x16_bf16(pa2, (bf16x8){l2[0], l2[1], l2[2], l2[3], h2[0], h2[1], h2[2], h2[3]}, o[d0], 0, 0, 0);   \
        o[d0] = __builtin_amdgcn_mfma_f32_32x32x16_bf16(pa3, (bf16x8){l3[0], l3[1], l3[2], l3[3], h3[0], h3[1], h3[2], h3[3]}, o[d0], 0, 0, 0); } while (0)
    PV_D0(0); PV_D0(1); PV_D0(2); PV_D0(3);
#undef PV_D0
#undef TRRD
}
typedef __amdgpu_buffer_rsrc_t rsrc_t;
__device__ __forceinline__ rsrc_t mk_rsrc(const void* p, unsigned bytes) { return __builtin_amdgcn_make_buffer_rsrc((void*)p, (short)0, (int)bytes, 0x00020000); }
__device__ __forceinline__ bf16x8 bload8(rsrc_t r, unsigned voff, unsigned soff) { const u32x4 w = __builtin_bit_cast(u32x4, __builtin_amdgcn_raw_buffer_load_b128(r, (int)voff, (int)soff, 0)); return __builtin_bit_cast(bf16x8, w); }
__device__ __forceinline__ f32x4 bloadf4(rsrc_t r, unsigned voff, unsigned soff) { return __builtin_bit_cast(f32x4, __builtin_amdgcn_raw_buffer_load_b128(r, (int)voff, (int)soff, 0)); }
struct AttnPtrs { rsrc_t rsP, rsN, rsG, rsM; const float* dBt; };
struct BlockRef { int h; int P0; int jlo; };
struct Seam { bf16x8 qr[8]; bf16x8 st_v0, st_v1, st_k0, st_k1; };
#define ROWS(typ, hh, k0, add) ((unsigned)((((typ) * NH + (hh)) * T + (k0) + (add)) * (DH * 2)))
#define VMW() asm volatile("s_waitcnt vmcnt(0)" ::: "memory")
#define VMWN(n) asm volatile("s_waitcnt vmcnt(%0)" :: "i"(n) : "memory")
#define SLOAD_H(hh, k0) do { S.st_v0 = bload8(P.rsP, stoff, ROWS(2, hh, k0, 0)); S.st_v1 = bload8(P.rsP, stoff, ROWS(2, hh, k0, 32));              \
                         S.st_k0 = bload8(P.rsP, stoff, ROWS(1, hh, k0, 0)); S.st_k1 = bload8(P.rsP, stoff, ROWS(1, hh, k0, 32)); } while (0)
#define SWRITE_HK(bf) do { *(bf16x8*)(K_lds + (bf) * SHM_K + kws) = S.st_k0; *(bf16x8*)(K_lds + (bf) * SHM_K + kws + 32 * 256) = S.st_k1; } while (0)
#define SWRITE_HV(bf) do { *(bf16x8*)(V_lds + (bf) * SHM_V + vst0) = S.st_v0; *(bf16x8*)(V_lds + (bf) * SHM_V + vst1) = S.st_v1; } while (0)
#define SWRITE_H(bf) do { SWRITE_HV(bf); SWRITE_HK(bf); } while (0)
__device__ __forceinline__ void fox_prime(const AttnPtrs& P, const BlockRef& cur, char* lds, Seam& S, int wid) {
    const int lane = lane_id(), tid = wid * 64 + lane, r32 = lane & 31, hi = lane >> 5;
    const unsigned stoff = (unsigned)(((tid >> 4) * DH + (tid & 15) * 8) * 2), qoff = (unsigned)((r32 * DH + hi * 8) * 2);
    const int sr = tid >> 4, sc = (tid & 15) * 8, kws = KSWZ(sr, sc * 2); char* K_lds = lds + 2 * SHM_V; (void)qoff;
    const int kb0 = cur.jlo * KVBLK;
    for (int d0 = 0; d0 < 8; ++d0) S.qr[d0] = bload8(P.rsP, qoff + d0 * 32, ROWS(0, cur.h, cur.P0 + wid * QBLK, 0));
    SLOAD_H(cur.h, kb0); VMW(); SWRITE_HK(0);
    __syncthreads();
}
__device__ __forceinline__ void fox_block(const AttnPtrs& P, const BlockRef& cur, const BlockRef& nxt, char* lds, Seam& S, int wid) {
    const int lane = lane_id(), tid = wid * 64 + lane, r32 = lane & 31, hi = lane >> 5;
    const unsigned stoff = (unsigned)(((tid >> 4) * DH + (tid & 15) * 8) * 2), qoff = (unsigned)((r32 * DH + hi * 8) * 2);
    const int j_lo = cur.jlo;
    const int j_hi = (cur.P0 + QB - 1) / KVBLK + 1;
    const int NT = j_hi - j_lo;
    const int kbn = nxt.jlo * KVBLK;
    const int qlo = cur.P0 + wid * QBLK, qm = qlo + r32 - 4 * hi;
    char* V_lds = lds; char* K_lds = lds + 2 * SHM_V;
    float* ws = (float*)(lds + 2 * SHM_V + 2 * SHM_K) + wid * 64; float* li_l = ws, * al_l = ws + 32;
    float m_reg = -1e30f, l_reg = 0; f32x16 o[4] = {};
    const int sr = tid >> 4, sc = (tid & 15) * 8, vst0 = v_st(sr, sc), vst1 = v_st(32 + sr, sc), kws = KSWZ(sr, sc * 2);
    const int vb0 = (int)(uintptr_t)V_lds + v_rd_base(lane);
    const float* dbrow = P.dBt + (cur.h * 32 + (cur.P0 >> 8)) * 32;
#define RESC(a) do { if (__any((a) < 1.f)) { if (hi == 0) al_l[r32] = (a); asm volatile("s_waitcnt lgkmcnt(0)" ::: "memory");              \
                     for (int d_ = 0; d_ < 4; ++d_) for (int r = 0; r < 16; ++r) o[d_][r] *= al_l[crow(r, hi)]; } } while (0)
#define KBASE(t) ((j_lo + (t)) * KVBLK)
#define DB(t) (__int_as_float(__builtin_amdgcn_readfirstlane(__float_as_int(dbrow[KBASE(t) >> 8]))))
#define MASKT(P0_, P1_, t) do { const int kb_ = KBASE(t); if (kb_ + KVBLK - 1 > qlo) mask_tile(P0_, P1_, qm - kb_); } while (0)
#define BIASLD(P0_, P1_, t) do { const unsigned so_ = (unsigned)((cur.h * T + KBASE(t)) * 4), vo_ = (unsigned)(hi * 16);                                             \
        _Pragma("unroll") for (int g_ = 0; g_ < 4; ++g_) { const f32x4 x_ = bloadf4(P.rsN, vo_ + 32 * g_, so_), y_ = bloadf4(P.rsN, vo_ + 128 + 32 * g_, so_);   \
            P0_[4 * g_] = x_.x; P0_[4 * g_ + 1] = x_.y; P0_[4 * g_ + 2] = x_.z; P0_[4 * g_ + 3] = x_.w; P1_[4 * g_] = y_.x; P1_[4 * g_ + 1] = y_.y; P1_[4 * g_ + 2] = y_.z; P1_[4 * g_ + 3] = y_.w; } } while (0)
    constexpr int NQL = 8;
#define SEAM_K0() do { VMWN(NQL); SWRITE_HK(0); SBAR(); } while (0)
    f32x16 pA0, pA1, pB0, pB1; float mnA, mnB, alA, alB; bf16x8 pa0, pa1, pa2, pa3;
    BIASLD(pA0, pA1, 0);
    SWRITE_HV(0); SBAR();
    SLOAD_H(cur.h, KBASE(1));
    SBAR(); qkt<0>(pA0, pA1, K_lds, r32, hi, S.qr);
    BIASLD(pB0, pB1, 1);
    MASKT(pA0, pA1, 0); partialSM(pA0, pA1, m_reg, mnA, alA, DB(0));
    VMW(); SWRITE_H(1);
    __syncthreads();
#define HALF_STEP(PX0, PX1, mnX, alX, PY0, PY1, alY, t, KB, VB, SB) do {                                                      \
        if ((t) + 1 < NT) { SLOAD_H(cur.h, KBASE((t) + 1)); }     \
        SBAR(); qkt<KB>(PX0, PX1, K_lds, r32, hi, S.qr);                                                                      \
        finishSM(PY0, PY1, alY, l_reg, pa0, pa1, pa2, pa3); SBAR();                                                           \
        if ((t) + 1 < NT) { BIASLD(PY0, PY1, (t) + 1); SBAR(); }                                                              \
        pv_tile<VB>(o, vb0, pa0, pa1, pa2, pa3); MASKT(PX0, PX1, (t)); partialSM(PX0, PX1, m_reg, mnX, alX, DB(t));           \
        __syncthreads();                                                                                                      \
        if ((t) + 1 < NT) { VMW(); SWRITE_H(SB); }                                                                            \
        RESC(alX); __syncthreads(); } while (0)
    for (int t = 1; t + 1 < NT; t += 2) {
        HALF_STEP(pB0, pB1, mnB, alB, pA0, pA1, alA, t, 1, 0, 0);
        HALF_STEP(pA0, pA1, mnA, alA, pB0, pB1, alB, t + 1, 0, 1, 1);
    }
    const bool even = (NT & 1) == 0;
    if (even) { SBAR(); qkt<1>(pB0, pB1, K_lds, r32, hi, S.qr); SBAR(); }
    SLOAD_H(nxt.h, kbn); SBAR();
#pragma unroll
    for (int d0 = 0; d0 < 8; ++d0) S.qr[d0] = bload8(P.rsP, qoff + d0 * 32, ROWS(0, nxt.h, nxt.P0 + wid * QBLK, 0));
    SBAR();
    finishSM(pA0, pA1, alA, l_reg, pa0, pa1, pa2, pa3); SBAR();
    pv_tile<0>(o, vb0, pa0, pa1, pa2, pa3);
    if (even) { MASKT(pB0, pB1, NT - 1); partialSM(pB0, pB1, m_reg, mnB, alB, DB(NT - 1)); __syncthreads(); RESC(alB);
        finishSM(pB0, pB1, alB, l_reg, pa0, pa1, pa2, pa3); SBAR(); pv_tile<1>(o, vb0, pa0, pa1, pa2, pa3); }
    SBAR(); SEAM_K0();
    if (hi == 0) li_l[r32] = l_reg; asm volatile("s_waitcnt lgkmcnt(0)" ::: "memory");
    float rs[16];
#pragma unroll
    for (int r = 0; r < 16; ++r) { const float rl = __builtin_amdgcn_rcpf(li_l[crow(r, hi)]); float ss = 0.f;
#pragma unroll
        for (int d0 = 0; d0 < 4; ++d0) { o[d0][r] *= rl; ss += o[d0][r] * o[d0][r]; }
        rs[r] = ss; }
#pragma unroll
    for (int r = 0; r < 16; ++r) { rs[r] += swz_xor<1>(rs[r]); rs[r] += swz_xor<2>(rs[r]); rs[r] += swz_xor<4>(rs[r]); rs[r] += swz_xor<8>(rs[r]); rs[r] += swz_xor<16>(rs[r]); }
    float gv[4];
#pragma unroll
    for (int d0 = 0; d0 < 4; ++d0) gv[d0] = __builtin_bit_cast(float, __builtin_amdgcn_raw_buffer_load_b32(P.rsG, (int)(r32 * 4 + d0 * 128), (int)(cur.h * DH * 4), 0));
    const unsigned olane = (unsigned)((4 * hi * D + r32) * 2);
#pragma unroll
    for (int r = 0; r < 16; ++r) { const int orow_u = (r & 3) + 8 * (r >> 2); const float rn = 1.0f / sqrtf(rs[r] * (1.0f / 128.0f) + EPS);
#pragma unroll
        for (int d0 = 0; d0 < 4; ++d0) { const float v = o[d0][r] * rn * gv[d0]; const float vn = swz_xor<1>(v);
            if ((r32 & 1) == 0) __builtin_amdgcn_raw_buffer_store_b32(cvtpk(v, vn), P.rsM, (int)olane, (int)((((cur.P0 + wid * QBLK + orow_u) * D) + cur.h * DH + d0 * 32) * 2), 0); } }
    __syncthreads();
#undef RESC
#undef KBASE
#undef DB
#undef MASKT
#undef BIASLD
#undef SEAM_K0
#undef HALF_STEP
}
#undef ROWS
#undef VMW
#undef VMWN
#undef SLOAD_H
#undef SWRITE_HK
#undef SWRITE_HV
#undef SWRITE_H
}

constexpr float SKIPT = 64.0f;
__device__ __forceinline__ float nrm_of(const float* n4, int tile) { const f32x4 v = *(const GAS f32x4*)(n4 + 4 * tile); return sqrtf((v.x + v.y) + (v.z + v.w)); }
__device__ __forceinline__ int fox_jlo(const Args* ka, int h, int qb, int lane) {
    const float* nrm = (const float*)(ka->ws + WS_NRM); const float* ncl = (const float*)(ka->ws + WS_CL) + (size_t)h * T; const float* dbrow = (const float*)(ka->ws + WS_DBT) + (h * 32 + qb) * 32;
    const float* qn = nrm + (size_t)h * 128 * 4; const float* kn = nrm + (size_t)(16 + h) * 128 * 4;
    const float Qn = fmaxf(fmaxf(nrm_of(qn, 4 * qb), nrm_of(qn, 4 * qb + 1)), fmaxf(nrm_of(qn, 4 * qb + 2), nrm_of(qn, 4 * qb + 3)));
    const float Knb = fmaxf(fmaxf(nrm_of(kn, 4 * qb), nrm_of(kn, 4 * qb + 1)), fmaxf(nrm_of(kn, 4 * qb + 2), nrm_of(kn, 4 * qb + 3)));
    const float c0 = ncl[qb * 256];
    bool ns[2];
#pragma unroll
    for (int q = 0; q < 2; ++q) { const int j = lane + 64 * q; bool keep = true;
        if (j < 4 * qb) { const float bm = dbrow[j >> 2] - c0 + ncl[64 * j + 63]; const float bound = Qn * (nrm_of(kn, j) + Knb) + bm; keep = !(bound < -SKIPT); }
        ns[q] = keep; }
    const unsigned long long m0 = __ballot(ns[0]), m1 = __ballot(ns[1]);
    const int j0 = m0 ? (int)__builtin_ctzll(m0) : 64 + (int)__builtin_ctzll(m1);
    return __builtin_amdgcn_readfirstlane(j0 < 4 * qb ? j0 : 4 * qb);
}
__device__ __forceinline__ fa::BlockRef mk_ref(int item, int pass_, int L0, int jl0, int jl1) { const int x = item & 15, qb = pass_ ? 31 - x : x; fa::BlockRef r; r.h = item >> 4; r.P0 = qb * 256; r.jlo = item == L0 ? (pass_ ? jl1 : jl0) : 0; return r; }
namespace fa {
#define ROWS(typ, hh, k0, add) ((unsigned)((((typ) * NH + (hh)) * T + (k0) + (add)) * (DH * 2)))
__device__ __forceinline__ void fox_wave_unit(const AttnPtrs& P, int h, int R0, int jlo, char* vlds, float* wsl) {
    const int lane = lane_id(), r32 = lane & 31, hi = lane >> 5;
    const unsigned qoff = (unsigned)((r32 * DH + hi * 8) * 2);
    float* li_l = wsl; float* al_l = wsl + 32;
    bf16x8 qr[8];
#pragma unroll
    for (int d0 = 0; d0 < 8; ++d0) qr[d0] = bload8(P.rsP, qoff + d0 * 32, ROWS(0, h, R0, 0));
    const int jd = R0 >> 6;
    const int qm = R0 + r32 - 4 * hi;
    const float* dbrow = P.dBt + (h * 32 + (R0 >> 8)) * 32;
    const int vb0 = (int)(uintptr_t)vlds + v_rd_base(lane);
    const unsigned vld = (unsigned)(((lane >> 4) * DH + (lane & 15) * 8) * 2);
    char* vwr = vlds + (((lane & 15) * 8) >> 5) * 512 + ((lane >> 4) * 32 + (((lane & 15) * 8) & 31)) * 2;
    float m_reg = -1e30f, l_reg = 0.f; f32x16 o[4] = {};
    for (int j = jlo; j <= jd; ++j) {
        const int key0 = j * KVBLK;
        f32x16 p0, p1;
        { const unsigned so_ = (unsigned)((h * T + key0) * 4), vo_ = (unsigned)(hi * 16);
#pragma unroll
          for (int g_ = 0; g_ < 4; ++g_) { const f32x4 x_ = bloadf4(P.rsN, vo_ + 32 * g_, so_), y_ = bloadf4(P.rsN, vo_ + 128 + 32 * g_, so_);
              p0[4 * g_] = x_.x; p0[4 * g_ + 1] = x_.y; p0[4 * g_ + 2] = x_.z; p0[4 * g_ + 3] = x_.w; p1[4 * g_] = y_.x; p1[4 * g_ + 1] = y_.y; p1[4 * g_ + 2] = y_.z; p1[4 * g_ + 3] = y_.w; } }
        { bf16x8 k0[8], k1[8];
#pragma unroll
          for (int d0 = 0; d0 < 8; ++d0) { k0[d0] = bload8(P.rsP, qoff + d0 * 32, ROWS(1, h, key0, 0)); k1[d0] = bload8(P.rsP, qoff + d0 * 32, ROWS(1, h, key0, 32)); }
#pragma unroll
          for (int d0 = 0; d0 < 8; ++d0) { p0 = __builtin_amdgcn_mfma_f32_32x32x16_bf16(k0[d0], qr[d0], p0, 0, 0, 0); p1 = __builtin_amdgcn_mfma_f32_32x32x16_bf16(k1[d0], qr[d0], p1, 0, 0, 0); } }
        SBAR();
        bf16x8 vv[16];
#pragma unroll
        for (int i = 0; i < 16; ++i) vv[i] = bload8(P.rsP, vld + i * (4 * DH * 2), ROWS(2, h, key0, 0));
        SBAR();
        if (key0 + KVBLK - 1 > R0) mask_tile(p0, p1, qm - key0);
        float mn, al; bf16x8 pa0, pa1, pa2, pa3;
        const float dB = __int_as_float(__builtin_amdgcn_readfirstlane(__float_as_int(dbrow[key0 >> 8])));
        partialSM(p0, p1, m_reg, mn, al, dB);
        if (__any(al < 1.f)) { if (hi == 0) al_l[r32] = al; asm volatile("s_waitcnt lgkmcnt(0)" ::: "memory");
#pragma unroll
            for (int d_ = 0; d_ < 4; ++d_)
#pragma unroll
                for (int r = 0; r < 16; ++r) o[d_][r] *= al_l[crow(r, hi)]; }
        finishSM(p0, p1, al, l_reg, pa0, pa1, pa2, pa3);
        SBAR();
#pragma unroll
        for (int i = 0; i < 16; ++i) *(bf16x8*)(vwr + ((i & 1) + 2 * (i >> 2)) * 2048 + ((i >> 1) & 1) * 256) = vv[i];
        asm volatile("s_waitcnt lgkmcnt(0)" ::: "memory");
        pv_tile<0>(o, vb0, pa0, pa1, pa2, pa3);
        asm volatile("s_waitcnt lgkmcnt(0)" ::: "memory");
        SBAR();
    }
    if (hi == 0) li_l[r32] = l_reg; asm volatile("s_waitcnt lgkmcnt(0)" ::: "memory");
    float rs[16];
#pragma unroll
    for (int r = 0; r < 16; ++r) { const float rl = __builtin_amdgcn_rcpf(li_l[crow(r, hi)]); float ss = 0.f;
#pragma unroll
        for (int d0 = 0; d0 < 4; ++d0) { o[d0][r] *= rl; ss += o[d0][r] * o[d0][r]; }
        rs[r] = ss; }
#pragma unroll
    for (int r = 0; r < 16; ++r) { rs[r] += swz_xor<1>(rs[r]); rs[r] += swz_xor<2>(rs[r]); rs[r] += swz_xor<4>(rs[r]); rs[r] += swz_xor<8>(rs[r]); rs[r] += swz_xor<16>(rs[r]); }
    float gv[4];
#pragma unroll
    for (int d0 = 0; d0 < 4; ++d0) gv[d0] = __builtin_bit_cast(float, __builtin_amdgcn_raw_buffer_load_b32(P.rsG, (int)(r32 * 4 + d0 * 128), (int)(h * DH * 4), 0));
    const unsigned olane = (unsigned)((4 * hi * D + r32) * 2);
#pragma unroll
    for (int r = 0; r < 16; ++r) { const int orow_u = (r & 3) + 8 * (r >> 2); const float rn = 1.0f / sqrtf(rs[r] * (1.0f / 128.0f) + EPS);
#pragma unroll
        for (int d0 = 0; d0 < 4; ++d0) { const float v = o[d0][r] * rn * gv[d0]; const float vn = swz_xor<1>(v);
            if ((r32 & 1) == 0) __builtin_amdgcn_raw_buffer_store_b32(cvtpk(v, vn), P.rsM, (int)olane, (int)((((R0 + orow_u) * D) + h * DH + d0 * 32) * 2), 0); } }
    asm volatile("s_waitcnt lgkmcnt(0)" ::: "memory");
}
#undef ROWS
}
__device__ __forceinline__ int fox_jlo_w(const Args* ka, int h, int R0, int lane) {
    const float* nrm = (const float*)(ka->ws + WS_NRM); const float* ncl = (const float*)(ka->ws + WS_CL) + (size_t)h * T; const float* dbrow = (const float*)(ka->ws + WS_DBT) + (h * 32 + (R0 >> 8)) * 32;
    const float* qn = nrm + (size_t)h * 128 * 4; const float* kn = nrm + (size_t)(16 + h) * 128 * 4;
    const int jd = R0 >> 6;
    const float Qn = nrm_of(qn, jd), Knb = nrm_of(kn, jd);
    const float c0 = ncl[R0];
    bool ns[2];
#pragma unroll
    for (int q = 0; q < 2; ++q) { const int j = lane + 64 * q; bool keep = true;
        if (j < jd) { const float bm = dbrow[j >> 2] - c0 + ncl[64 * j + 63]; const float bound = Qn * (nrm_of(kn, j) + Knb) + bm; keep = !(bound < -SKIPT); }
        ns[q] = keep; }
    const unsigned long long m0 = __ballot(ns[0]), m1 = __ballot(ns[1]);
    const int j0 = m0 ? (int)__builtin_ctzll(m0) : 64 + (int)__builtin_ctzll(m1);
    return __builtin_amdgcn_readfirstlane(j0 < jd ? j0 : jd);
}
__device__ __forceinline__ void ph_attn_w(const Args* ka, LAS unsigned char* lds_las, int vcu, int G, int wave) {
    char* lds = (char*)lds_las; unsigned char* ws = ka->ws; const int lane = lane_id();
    fa::AttnPtrs P; P.rsP = fa::mk_rsrc(ws + WS_PROJ, (unsigned)(3 * HEADBUF * 2)); P.rsN = fa::mk_rsrc(ws + WS_CL, (unsigned)(NH * T * 4)); P.rsG = fa::mk_rsrc(ka->in[8], 2048u * 4u);
    P.rsM = fa::mk_rsrc(ws + WS_MIX, (unsigned)((size_t)T * D * 2)); P.dBt = (const float*)(ws + WS_DBT);
    char* vl = lds + wave * 16640; float* wsl = (float*)(vl + 16384);
    __syncthreads();
    const int u0 = vcu * 8 + wave, ustep = G * 8, NU = NH * (T / 32);
    int jl0 = 0, jl1 = 0;
    if (u0 < NU) jl0 = fox_jlo_w(ka, u0 / (T / 32), (u0 % (T / 32)) * 32, lane);
    if (u0 + ustep < NU) jl1 = fox_jlo_w(ka, (u0 + ustep) / (T / 32), ((u0 + ustep) % (T / 32)) * 32, lane);
    asm volatile("" ::: "memory");
    int cnt = 0;
    for (int u = u0; u < NU; u += ustep, ++cnt) {
        const int h = u / (T / 32), R0 = (u % (T / 32)) * 32;
        fa::fox_wave_unit(P, h, R0, cnt == 0 ? jl0 : (cnt == 1 ? jl1 : 0), vl, wsl);
    }
    __syncthreads();
}
__device__ __forceinline__ void ph_attn(const Args* ka, LAS unsigned char* lds_las, int vcu, int G, int wave) {
    char* lds = (char*)lds_las;
    unsigned char* ws = ka->ws;
    fa::AttnPtrs P; P.rsP = fa::mk_rsrc(ws + WS_PROJ, (unsigned)(3 * HEADBUF * 2)); P.rsN = fa::mk_rsrc(ws + WS_CL, (unsigned)(NH * T * 4)); P.rsG = fa::mk_rsrc(ka->in[8], 2048u * 4u);
    P.rsM = fa::mk_rsrc(ws + WS_MIX, (unsigned)((size_t)T * D * 2)); P.dBt = (const float*)(ws + WS_DBT);
    const int total = NH * 16;
    int L = vcu; if (L >= total) return;
    const int L0 = L; int jl0, jl1; { const int lane = lane_id(); jl0 = fox_jlo(ka, L >> 4, L & 15, lane); jl1 = fox_jlo(ka, L >> 4, 31 - (L & 15), lane); }
    int pass = 0; fa::BlockRef cur = mk_ref(L, 0, L0, jl0, jl1); fa::Seam S;
    fa::fox_prime(P, cur, lds, S, wave);
    for (;;) {
        const bool more_pass = pass == 0, more_item = L + G < total, last = !more_pass && !more_item;
        int passn = pass + 1, Ln = L; if (!more_pass) { passn = 0; Ln = more_item ? L + G : L; }
        const fa::BlockRef nxt = last ? cur : mk_ref(Ln, passn, L0, jl0, jl1);
        fa::fox_block(P, cur, nxt, lds, S, wave);
        if (last) break;
        cur = nxt; pass = passn; L = Ln;
    }
}

#ifndef HG_DLIM
#define HG_DLIM 100.0f
#endif
namespace hg {
typedef short bf16x8 __attribute__((ext_vector_type(8)));
typedef float f32x16 __attribute__((ext_vector_type(16)));
typedef float f32x4 __attribute__((ext_vector_type(4)));
typedef float f32x2 __attribute__((ext_vector_type(2)));
template <int M> __device__ __forceinline__ float swzx(float v) { return __int_as_float(__builtin_amdgcn_ds_swizzle(__float_as_int(v), 0x1F | (M << 10))); }
__device__ __forceinline__ float b2f(bf16 v) { return __uint_as_float((unsigned)v << 16); }
__device__ __forceinline__ float ex2(float v) { return __builtin_amdgcn_exp2f(v); }
__device__ __forceinline__ int crow(int r, int hi) { return (r & 3) + 8 * (r >> 2) + 4 * hi; }
__device__ __forceinline__ void gate(float f, float lbk, float omlb, float& g2, float& kk) {
    const float e = ex2(f * LOG2E);
    const float sg = __builtin_amdgcn_rcpf(1.0f + __builtin_amdgcn_rcpf(e)), sgn = __builtin_amdgcn_rcpf(1.0f + e);
    g2 = __builtin_amdgcn_logf(lbk + omlb * sg); kk = omlb * sgn;
}
}

__device__ __forceinline__ void ph_hgA(const Args* ka, LAS unsigned char* lds, int vcu, int G, int wave) {
    using namespace hg;
    const int lane = lane_id(), tid = wave * 64 + lane;
    unsigned char* ws = ka->ws;
    const bf16* HF = (const bf16*)(ws + WS_PROJ) + 4 * HEADBUF; const bf16* HI = (const bf16*)(ws + WS_PROJ) + 5 * HEADBUF;
    bf16* UT = (bf16*)(ws + WS_HU); float* dv = (float*)(ws + WS_HD); const float* lb = (const float*)(ws + WS_LB);
    LAS bf16* kdT = (LAS bf16*)lds; LAS bf16* iT = (LAS bf16*)(lds + 18432); LAS float* qt = (LAS float*)(lds + 36864);
    const int k = tid & 127, rq = tid >> 7;
    bf16 fraw[16]; v4u ivn0 = {0u, 0u, 0u, 0u}, ivn1 = ivn0;
    if (vcu < NH * 128) { const size_t rb = ((size_t)(vcu >> 7) * T + (vcu & 127) * 64 + 16 * rq) * 128 + k;
#pragma unroll
        for (int j = 0; j < 16; ++j) fraw[j] = HF[rb + j * 128];
        const bf16* ipn = HI + ((size_t)(vcu >> 7) * T + (vcu & 127) * 64 + (tid >> 4)) * 128 + (tid & 15) * 8; ivn0 = *(const GAS v4u*)ipn; ivn1 = *(const GAS v4u*)(ipn + 32 * 128); }
    for (int u = vcu; u < NH * 128; u += G) {
        const int h = u >> 7, n = u & 127, t0 = n * 64;
        const float lbk = lb[h * 128 + k], omlb = 1.0f - lbk;
        float c[16], kk[16]; float run = 0.f;
#pragma unroll
        for (int j = 0; j < 16; ++j) { float g2; gate(b2f(fraw[j]), lbk, omlb, g2, kk[j]); run += g2; c[j] = run; }
        qt[rq * 128 + k] = run;
        const v4u iv0 = ivn0, iv1 = ivn1;
        { const int un = u + G < NH * 128 ? u + G : u; const size_t rb = ((size_t)(un >> 7) * T + (un & 127) * 64 + 16 * rq) * 128 + k;
#pragma unroll
          for (int j = 0; j < 16; ++j) fraw[j] = HF[rb + j * 128];
          const bf16* ipn = HI + ((size_t)(un >> 7) * T + (un & 127) * 64 + (tid >> 4)) * 128 + (tid & 15) * 8; ivn0 = *(const GAS v4u*)ipn; ivn1 = *(const GAS v4u*)(ipn + 32 * 128); }
        __syncthreads();
        float off = 0.f, tot = 0.f;
#pragma unroll
        for (int q = 0; q < 4; ++q) { const float xq = qt[q * 128 + k]; if (q < rq) off += xq; tot += xq; }
#pragma unroll
        for (int j = 0; j < 16; ++j) (kdT + k * 72 + 16 * rq)[j] = (bf16)f2bf(kk[j] * ex2(tot - (off + c[j])));
        if (rq == 0) dv[(size_t)u * 128 + k] = ex2(tot);
        { const int tt = tid >> 4, v0 = (tid & 15) * 8;
#pragma unroll
          for (int e = 0; e < 4; ++e) { iT[(v0 + 2 * e) * 72 + tt] = (bf16)(iv0[e] & 0xffffu); iT[(v0 + 2 * e + 1) * 72 + tt] = (bf16)(iv0[e] >> 16);
                                        iT[(v0 + 2 * e) * 72 + tt + 32] = (bf16)(iv1[e] & 0xffffu); iT[(v0 + 2 * e + 1) * 72 + tt + 32] = (bf16)(iv1[e] >> 16); } }
        __syncthreads();
        const int mb = wave >> 1, nh = wave & 1, r = lane & 31, hh = lane >> 5;
        f32x16 acc0 = {}, acc1 = {};
#pragma unroll
        for (int s = 0; s < 4; ++s) { const bf16x8 av = *(const LAS bf16x8*)(iT + (mb * 32 + r) * 72 + 16 * s + 8 * hh);
            const bf16x8 b0 = *(const LAS bf16x8*)(kdT + (nh * 64 + r) * 72 + 16 * s + 8 * hh), b1 = *(const LAS bf16x8*)(kdT + (nh * 64 + 32 + r) * 72 + 16 * s + 8 * hh);
            acc0 = __builtin_amdgcn_mfma_f32_32x32x16_bf16(av, b0, acc0, 0, 0, 0); acc1 = __builtin_amdgcn_mfma_f32_32x32x16_bf16(av, b1, acc1, 0, 0, 0); }
        bf16* up = UT + (size_t)u * 16384 + nh * 64 + r;
#pragma unroll
        for (int r_ = 0; r_ < 16; ++r_) { const int v = mb * 32 + crow(r_, hh); const float n0 = swzx<1>(acc0[r_]), n1 = swzx<1>(acc1[r_]);
            if ((r & 1) == 0) { *(unsigned*)(up + v * 128) = pk2(acc0[r_], n0); *(unsigned*)(up + v * 128 + 32) = pk2(acc1[r_], n1); } }
        __syncthreads();
    }
}

__device__ __forceinline__ void ph_hgB(const Args* ka, int vcu, int G, int wave) {
    using namespace hg;
    const int lane = lane_id(), tid = wave * 64 + lane;
    unsigned char* ws = ka->ws;
    const bf16* UT = (const bf16*)(ws + WS_HU); const float* dv = (const float*)(ws + WS_HD); bf16* ST = (bf16*)(ws + WS_HS);
    for (int idx = vcu * 512 + tid; idx < NH * 128 * 64; idx += G * 512) {
        const int h = idx >> 13, v = (idx >> 6) & 127, kp = idx & 63;
        const unsigned* up = (const unsigned*)(UT + (size_t)h * 128 * 16384 + v * 128 + 2 * kp);
        const float* dp = dv + (size_t)h * 128 * 128 + 2 * kp;
        unsigned* sp = (unsigned*)(ST + (size_t)h * 128 * 16384 + v * 128 + 2 * kp);
        float s0 = 0.f, s1 = 0.f;
#ifndef HGB_DEPTH
#define HGB_DEPTH 32
#endif
#pragma unroll 1
        for (int n0 = 0; n0 < 128; n0 += HGB_DEPTH) {
            unsigned uw[HGB_DEPTH]; f32x2 dd[HGB_DEPTH];
#pragma unroll
            for (int j = 0; j < HGB_DEPTH; ++j) { uw[j] = __builtin_nontemporal_load(up + (size_t)(n0 + j) * 8192); dd[j] = *(const GAS f32x2*)(dp + (n0 + j) * 128); }
#pragma unroll
            for (int j = 0; j < HGB_DEPTH; ++j) { sp[(size_t)(n0 + j) * 8192] = pk2(s0, s1); s0 = dd[j].x * s0 + __uint_as_float(uw[j] << 16); s1 = dd[j].y * s1 + __uint_as_float(uw[j] & 0xffff0000u); }
        }
    }
}

__device__ __forceinline__ void ph_hgC(const Args* ka, LAS unsigned char* lds, int vcu, int G, int wave) {
    using namespace hg;
    const int lane = lane_id(), tid = wave * 64 + lane;
    unsigned char* ws = ka->ws;
    const bf16* PR = (const bf16*)(ws + WS_PROJ);
    const bf16* HQ = PR + 3 * HEADBUF; const bf16* HF = PR + 4 * HEADBUF; const bf16* HI = PR + 5 * HEADBUF; const bf16* HGb = PR + 6 * HEADBUF;
    const bf16* ST = (const bf16*)(ws + WS_HS); const float* lb = (const float*)(ws + WS_LB); bf16* MIX = (bf16*)(ws + WS_MIX); const float* ghg = ka->in[9];
    constexpr int OFF_QM = 0, OFF_KM = 17408, OFF_QR = 34816, OFF_KD = 52224, OFF_AM = 78336, OFF_QT = 87552, OFF_FLAG = 89600, OFF_FBQ = 89856, OFF_FBK = 107264;
    constexpr int BST = 132, HST = 136, AST = 72; constexpr float DLIM = HG_DLIM;
    LAS bf16* qmS = (LAS bf16*)(lds + OFF_QM); LAS bf16* kmS = (LAS bf16*)(lds + OFF_KM); LAS bf16* qrS = (LAS bf16*)(lds + OFF_QR); LAS bf16* kdS = (LAS bf16*)(lds + OFF_KD);
    LAS bf16* Am = (LAS bf16*)(lds + OFF_AM); LAS float* qt = (LAS float*)(lds + OFF_QT); volatile LAS unsigned* flag = (volatile LAS unsigned*)(lds + OFF_FLAG);
    LAS float* bS = (LAS float*)(lds + OFF_QM); LAS bf16* qS = (LAS bf16*)(lds + OFF_FBQ); LAS bf16* kkS = (LAS bf16*)(lds + OFF_FBK);
    LAS bf16* qdS = (LAS bf16*)(lds + OFF_QM); LAS bf16* iT = (LAS bf16*)(lds + OFF_KD); LAS bf16* STl = (LAS bf16*)(lds + OFF_KM); LAS float* oS = (LAS float*)(lds + OFF_KM);
    const int k = tid & 127, rq = tid >> 7;
    bf16 fraw[16], qraw[16];
    if (vcu < NH * 128) { const size_t rb = ((size_t)(vcu >> 7) * T + (vcu & 127) * 64 + 16 * rq) * 128 + k;
#pragma unroll
        for (int j = 0; j < 16; ++j) { fraw[j] = HF[rb + j * 128]; qraw[j] = HQ[rb + j * 128]; } }
    if (tid < 2) flag[tid] = 0u;
    __syncthreads();
    int par = 0;
    for (int u = vcu; u < NH * 128; u += G, par ^= 1) {
        const int h = u >> 7, n = u & 127, t0 = n * 64;
        const float lbk = lb[h * 128 + k], omlb = 1.0f - lbk;
        float c[16], kk[16], qv[16]; float run = 0.f;
#pragma unroll
        for (int j = 0; j < 16; ++j) { float g2; gate(b2f(fraw[j]), lbk, omlb, g2, kk[j]); run += g2; c[j] = run; qv[j] = b2f(qraw[j]); }
        { const int un = u + G < NH * 128 ? u + G : u; const size_t rb = ((size_t)(un >> 7) * T + (un & 127) * 64 + 16 * rq) * 128 + k;
#pragma unroll
          for (int j = 0; j < 16; ++j) { fraw[j] = HF[rb + j * 128]; qraw[j] = HQ[rb + j * 128]; } }
        qt[rq * 128 + k] = run;
        if (!(fmaxf(c[7] - c[15], c[0] - c[7]) <= DLIM)) flag[par] = 1u;
        for (int i = tid; i < 64 * AST / 2; i += 512) ((LAS unsigned*)Am)[i] = 0u;
        __syncthreads();
        const bool exact = flag[par] != 0u;
        if (tid == 0) flag[par ^ 1] = 0u;
        const float P1 = qt[k], P2 = P1 + qt[128 + k], P3 = P2 + qt[256 + k];
        const float off = rq == 0 ? 0.f : (rq == 1 ? P1 : (rq == 2 ? P2 : P3));
        { const int rbq = rq * (16 * HST) + k;
          LAS bf16* qr0 = qrS + rbq; LAS bf16* kd1 = kdS + rbq; LAS bf16* kd2 = kdS + 16 * HST + rbq; LAS bf16* kd3 = kdS + 48 * HST + rbq;
#pragma unroll
          for (int j = 0; j < 16; ++j) { const float bv = off + c[j];
            if (rq >= 1) qr0[j * HST] = (bf16)f2bf(qv[j] * ex2(c[j]));
            if (rq < 1) kd1[j * HST] = (bf16)f2bf(kk[j] * ex2(P1 - bv));
            if (rq < 2) kd2[j * HST] = (bf16)f2bf(kk[j] * ex2(P2 - bv));
            if (rq < 3) kd3[j * HST] = (bf16)f2bf(kk[j] * ex2(P3 - bv)); }
          if (!exact) { LAS bf16* qm0 = qmS + rbq; LAS bf16* km0 = kmS + rbq;
#pragma unroll
            for (int j = 0; j < 16; ++j) { qm0[j * HST] = (bf16)f2bf(qv[j] * ex2(c[j] - c[7])); km0[j * HST] = (bf16)f2bf(kk[j] * ex2(c[7] - c[j])); } }
          else { LAS float* bS0 = bS + rq * (16 * BST) + k; LAS bf16* kk0 = kkS + rbq; LAS bf16* q0 = qS + rbq;
#pragma unroll
            for (int j = 0; j < 16; ++j) { bS0[j * BST] = off + c[j]; kk0[j * HST] = (bf16)f2bf(kk[j]); q0[j * HST] = (bf16)f2bf(qv[j]); } } }
        __syncthreads();
        if (wave < 6) {
            const int I = wave < 1 ? 1 : (wave < 3 ? 2 : 3), J = wave < 1 ? 0 : (wave < 3 ? wave - 1 : wave - 3), kb = I == 1 ? 0 : (I == 2 ? 16 : 48);
            const int r16 = lane & 15, kq = lane >> 4; f32x4 acc = {0.f, 0.f, 0.f, 0.f};
#pragma unroll
            for (int ks = 0; ks < 4; ++ks) { const bf16x8 av = *(const LAS bf16x8*)(qrS + (16 * I + r16) * HST + 32 * ks + 8 * kq), bv = *(const LAS bf16x8*)(kdS + (kb + 16 * J + r16) * HST + 32 * ks + 8 * kq);
                acc = __builtin_amdgcn_mfma_f32_16x16x32_bf16(av, bv, acc, 0, 0, 0); }
#pragma unroll
            for (int e = 0; e < 4; ++e) Am[(16 * I + kq * 4 + e) * AST + 16 * J + r16] = (bf16)f2bf(acc[e]);
        }
        if (!exact && wave < 4) {
            const int I = wave, r16 = lane & 15, kq = lane >> 4; f32x4 acc = {0.f, 0.f, 0.f, 0.f};
#pragma unroll
            for (int ks = 0; ks < 4; ++ks) { const bf16x8 av = *(const LAS bf16x8*)(qmS + (16 * I + r16) * HST + 32 * ks + 8 * kq), bv = *(const LAS bf16x8*)(kmS + (16 * I + r16) * HST + 32 * ks + 8 * kq);
                acc = __builtin_amdgcn_mfma_f32_16x16x32_bf16(av, bv, acc, 0, 0, 0); }
#pragma unroll
            for (int e = 0; e < 4; ++e) if (r16 <= kq * 4 + e) Am[(16 * I + kq * 4 + e) * AST + 16 * I + r16] = (bf16)f2bf(acc[e]);
        }
        const bf16* ip = HI + ((size_t)h * T + t0 + (tid >> 4)) * 128 + (tid & 15) * 8;
        const v4u iv0 = *(const GAS v4u*)ip, iv1 = *(const GAS v4u*)(ip + 32 * 128);
        const bf16* sp = ST + (size_t)u * 16384 + (size_t)tid * 8;
        const v4u sv0 = __builtin_nontemporal_load((const GAS v4u*)sp), sv1 = __builtin_nontemporal_load((const GAS v4u*)(sp + 4096)), sv2 = __builtin_nontemporal_load((const GAS v4u*)(sp + 8192)), sv3 = __builtin_nontemporal_load((const GAS v4u*)(sp + 12288));
        if (exact) {
          const int ks = tid & 7, sq = (tid >> 3) & 3, tq = (tid >> 5) & 3, bI = tid >> 7;
          if (sq <= tq) {
            float acc[4][4];
#pragma unroll
            for (int i = 0; i < 4; ++i)
#pragma unroll
                for (int j = 0; j < 4; ++j) acc[i][j] = 0.f;
            const int tb = 16 * bI + 4 * tq, sb = 16 * bI + 4 * sq;
#pragma unroll 1
            for (int k4 = 0; k4 < 4; ++k4) { const int kc = ks * 16 + 4 * k4;
                f32x4 bt[4], bs[4]; float qf[4][4], kf[4][4];
#pragma unroll
                for (int i = 0; i < 4; ++i) { bt[i] = *(const LAS f32x4*)(bS + (tb + i) * BST + kc); const f32x2 qw = *(const LAS f32x2*)(qS + (tb + i) * HST + kc);
                    const unsigned w0 = __float_as_uint(qw.x), w1 = __float_as_uint(qw.y); qf[i][0] = __uint_as_float(w0 << 16); qf[i][1] = __uint_as_float(w0 & 0xffff0000u); qf[i][2] = __uint_as_float(w1 << 16); qf[i][3] = __uint_as_float(w1 & 0xffff0000u); }
#pragma unroll
                for (int j = 0; j < 4; ++j) { bs[j] = *(const LAS f32x4*)(bS + (sb + j) * BST + kc); const f32x2 kw = *(const LAS f32x2*)(kkS + (sb + j) * HST + kc);
                    const unsigned w0 = __float_as_uint(kw.x), w1 = __float_as_uint(kw.y); kf[j][0] = __uint_as_float(w0 << 16); kf[j][1] = __uint_as_float(w0 & 0xffff0000u); kf[j][2] = __uint_as_float(w1 << 16); kf[j][3] = __uint_as_float(w1 & 0xffff0000u); }
#pragma unroll
                for (int i = 0; i < 4; ++i)
#pragma unroll
                    for (int j = 0; j < 4; ++j)
#pragma unroll
                        for (int e = 0; e < 4; ++e) acc[i][j] += qf[i][e] * kf[j][e] * ex2(fminf(bt[i][e] - bs[j][e], 0.f));
            }
#pragma unroll
            for (int i = 0; i < 4; ++i)
#pragma unroll
                for (int j = 0; j < 4; ++j) { float a_ = acc[i][j]; a_ += swzx<1>(a_); a_ += swzx<2>(a_); a_ += swzx<4>(a_);
                    if (ks == 0 && sb + j <= tb + i) Am[(tb + i) * AST + sb + j] = (bf16)f2bf(a_); }
          }
        }
        __syncthreads();
        { LAS bf16* qd0 = qdS + rq * (16 * HST) + k;
#pragma unroll
          for (int j = 0; j < 16; ++j) qd0[j * HST] = (bf16)f2bf(qv[j] * ex2(off + c[j])); }
        { const int tt = tid >> 4, v0 = (tid & 15) * 8;
#pragma unroll
          for (int e = 0; e < 4; ++e) { iT[(v0 + 2 * e) * AST + tt] = (bf16)(iv0[e] & 0xffffu); iT[(v0 + 2 * e + 1) * AST + tt] = (bf16)(iv0[e] >> 16);
                                        iT[(v0 + 2 * e) * AST + tt + 32] = (bf16)(iv1[e] & 0xffffu); iT[(v0 + 2 * e + 1) * AST + tt + 32] = (bf16)(iv1[e] >> 16); }
          *(LAS v4u*)(STl + ((tid >> 4)) * HST + (tid & 15) * 8) = sv0; *(LAS v4u*)(STl + ((tid >> 4) + 32) * HST + (tid & 15) * 8) = sv1;
          *(LAS v4u*)(STl + ((tid >> 4) + 64) * HST + (tid & 15) * 8) = sv2; *(LAS v4u*)(STl + ((tid >> 4) + 96) * HST + (tid & 15) * 8) = sv3; }
        __syncthreads();
        const int mb = wave >> 2, nb = wave & 3, r = lane & 31, hh = lane >> 5;
        f32x16 oacc = {};
#pragma unroll
        for (int s = 0; s < 8; ++s) { const bf16x8 av = *(const LAS bf16x8*)(qdS + (mb * 32 + r) * HST + 16 * s + 8 * hh), bv = *(const LAS bf16x8*)(STl + (nb * 32 + r) * HST + 16 * s + 8 * hh);
            oacc = __builtin_amdgcn_mfma_f32_32x32x16_bf16(av, bv, oacc, 0, 0, 0); }
#pragma unroll
        for (int s = 0; s < 4; ++s) { const bf16x8 av = *(const LAS bf16x8*)(Am + (mb * 32 + r) * AST + 16 * s + 8 * hh), bv = *(const LAS bf16x8*)(iT + (nb * 32 + r) * AST + 16 * s + 8 * hh);
            oacc = __builtin_amdgcn_mfma_f32_32x32x16_bf16(av, bv, oacc, 0, 0, 0); }
        __syncthreads();
#pragma unroll
        for (int r_ = 0; r_ < 16; ++r_) oS[(mb * 32 + crow(r_, hh)) * BST + nb * 32 + r] = oacc[r_];
        __syncthreads();
        { const int t = tid >> 3, seg = tid & 7; float ov[16]; float ss = 0.f;
#pragma unroll
          for (int q = 0; q < 4; ++q) { const f32x4 x4 = *(const LAS f32x4*)(oS + t * BST + seg * 16 + 4 * q); ov[4 * q] = x4.x; ov[4 * q + 1] = x4.y; ov[4 * q + 2] = x4.z; ov[4 * q + 3] = x4.w;
              ss += (x4.x * x4.x + x4.y * x4.y) + (x4.z * x4.z + x4.w * x4.w); }
          ss += swzx<1>(ss); ss += swzx<2>(ss); ss += swzx<4>(ss);
          const float rn = 1.0f / sqrtf(ss * (1.0f / 128.0f) + EPS);
          const bf16* gp = HGb + ((size_t)h * T + t0 + t) * 128 + seg * 16;
          const v4u g0 = *(const GAS v4u*)gp, g1 = *(const GAS v4u*)(gp + 8);
          float gf[16];
#pragma unroll
          for (int e = 0; e < 4; ++e) { gf[2 * e] = __uint_as_float(g0[e] << 16); gf[2 * e + 1] = __uint_as_float(g0[e] & 0xffff0000u); gf[8 + 2 * e] = __uint_as_float(g1[e] << 16); gf[8 + 2 * e + 1] = __uint_as_float(g1[e] & 0xffff0000u); }
          float yv[16];
#pragma unroll
          for (int q = 0; q < 4; ++q) { const f32x4 gg = *(const GAS f32x4*)(ghg + h * 128 + seg * 16 + 4 * q);
              yv[4 * q] = ov[4 * q] * rn * gg.x * gf[4 * q]; yv[4 * q + 1] = ov[4 * q + 1] * rn * gg.y * gf[4 * q + 1]; yv[4 * q + 2] = ov[4 * q + 2] * rn * gg.z * gf[4 * q + 2]; yv[4 * q + 3] = ov[4 * q + 3] * rn * gg.w * gf[4 * q + 3]; }
          bf16* mp = MIX + (size_t)(t0 + t) * D + 2048 + h * 128 + seg * 16;
          v4u w0, w1;
#pragma unroll
          for (int e = 0; e < 4; ++e) { w0[e] = pk2(yv[2 * e], yv[2 * e + 1]); w1[e] = pk2(yv[8 + 2 * e], yv[8 + 2 * e + 1]); }
          *(GAS v4u*)mp = w0; *(GAS v4u*)(mp + 8) = w1; }
        __syncthreads();
    }
}

__global__ void __launch_bounds__(512, 2) fwd(Args a) {
    const Args* ka = (const Args*)__builtin_amdgcn_kernarg_segment_ptr();
    extern __shared__ __attribute__((aligned(16))) unsigned char lds_[];
    LAS unsigned char* lds = (LAS unsigned char*)lds_;
    volatile LAS unsigned* MISC = (volatile LAS unsigned*)(lds + MISC_OFF);
    const int wave = __builtin_amdgcn_readfirstlane(threadIdx.x >> 6);
#define lane lane_id()
#define tid (wave * 64 + lane_id())
    const int G = gridDim.x; const int bx = blockIdx.x; const int vcu = (G % 8 == 0) ? (bx % 8) * (G / 8) + bx / 8 : bx;
    for (int u = tid; u < (LDS_BYTES - LDSCTL_OFF) / 4; u += 512) ((LAS unsigned*)(lds + LDSCTL_OFF))[u] = 0u;
    __syncthreads();
#define ws (ka->ws)
    gu32* ctl = (gu32*)(ws + WS_CTL);
    XcdBarrier bar = xcd_barrier_post((unsigned*)(ctl + CW_BAR), MISC + 8);
    const unsigned mask = ka->mask;
#ifndef GEMM_SP2
#define GEMM_SP2 true
#endif
#define HAS(p) (mask & (1u << (p)))
#ifndef REPEAT_MASK
#define REPEAT_MASK 0u
#endif
#define REP(p) for (int rep_ = 0; rep_ < 1 + (int)((REPEAT_MASK >> (p)) & 1u); ++rep_) if (rep_ ? (__syncthreads(), true) : true)
#ifdef TP_A
    unsigned long long tpa_ = wall_clock64(), tpb_ = 0;
#define SEAM(k) do { if ((mask & ((1u << (k)) - 1u)) && (mask >> (k))) xcd_barrier(bar); if ((k) == TP_A) tpa_ = wall_clock64(); if ((k) == TP_B) tpb_ = wall_clock64(); } while (0)
#else
#define SEAM(k) do { if ((mask & ((1u << (k)) - 1u)) && (mask >> (k))) xcd_barrier(bar); } while (0)
#endif
#define x (ka->in[0])
#define mod ((float*)(ws + WS_MOD))
#define Hb ((bf16*)(ws + WS_H))
#define PROJ ((bf16*)(ws + WS_PROJ))
#define MIX ((bf16*)(ws + WS_MIX))
#define D1b ((bf16*)(ws + WS_D1))
#define D2b ((bf16*)(ws + WS_D2))

#ifndef G1_SPLIT
#define G1_SPLIT 224
#endif
    const int G1 = (G == 256) ? G1_SPLIT : G;
    if (HAS(PC_PRO)) REP(PC_PRO) { if (G1 < G) ph_prologue<1>(ka, lds, vcu, G, tid, lane, wave); else ph_prologue<3>(ka, lds, vcu, G, tid, lane, wave); }
    SEAM(PC_NORM1);
    if (HAS(PC_NORM1)) REP(PC_NORM1) ph_norm<true>(x, nullptr, ka->in[4], (const float*)(ws + WS_PART), ka->in[3], Hb, (const bf16*)(ws + WS_WF), ka->in[6], (float*)(ws + WS_LF), mod, G1 < G ? 2 * D : NMOD, lds, vcu, G, tid, lane, wave);
    SEAM(PC_CUM);
    if (HAS(PC_GEMM1)) REP(PC_GEMM1) {
        pg8::Gemm g{Hb, (const bf16*)(ws + WS_WIN), T, NPROJ, D}; pg8::StaticOrder S; S.init(T, NPROJ, G1, bx);
        pg8::EpiProj E{PROJ, HEADBUF, T, QSCALE, (float*)(ws + WS_NRM)};
        if (bx < G1) pg8::gemm_phase<pg8::EpiProj, pg8::StaticOrder, true, GEMM_SP2>(lds, g, S, E, wave);
#ifndef STREAM_REP
#define STREAM_REP 1
#endif
        else { if (HAS(PC_CUM)) ph_cum(ka, lds, bx - G1, tid, lane);
            for (int sr_ = 0; sr_ < STREAM_REP; ++sr_) { if (sr_) __syncthreads(); ph_prologue<2>(ka, lds, bx - G1, G - G1, tid, lane, wave); }
#ifdef STREAM_DELAY_US
            { const unsigned long long t0_ = wall_clock64(); while (wall_clock64() - t0_ < 100ull * STREAM_DELAY_US) __builtin_amdgcn_s_sleep(8); }
#endif
        }
    }
    SEAM(PC_HGA);
    if (HAS(PC_GEMM1) && G1 < G) ph_modreduce(ka, 2 * D, vcu, G, tid);
    if (HAS(PC_CUM) && G1 == G) REP(PC_CUM) ph_cum(ka, lds, vcu, tid, lane);
    if (HAS(PC_HGA)) REP(PC_HGA) ph_hgA(ka, lds, vcu, G, wave);
    SEAM(PC_HGB);
    if (HAS(PC_HGB)) REP(PC_HGB) ph_hgB(ka, vcu, G, wave);
    SEAM(PC_HGC);
    if (HAS(PC_HGC)) REP(PC_HGC) ph_hgC(ka, lds, vcu, G, wave);
#ifdef SPLIT_HC
    SEAM(PC_ATTN);
#endif
#ifdef ATTN_COOP
    if (HAS(PC_ATTN)) REP(PC_ATTN) ph_attn(ka, lds, vcu, G, wave);
#else
    if (HAS(PC_ATTN)) REP(PC_ATTN) ph_attn_w(ka, lds, vcu, G, wave);
#endif
    SEAM(PC_GEMM2);
    if (HAS(PC_GEMM2)) REP(PC_GEMM2) {
        pg8::Gemm g{MIX, (const bf16*)(ws + WS_WO), T, D, D}; pg8::StaticOrder S; S.init(T, D, G, bx);
        pg8::EpiGate E{D1b, D, mod + 2 * D};
        pg8::gemm_phase<pg8::EpiGate, pg8::StaticOrder, true, GEMM_SP2>(lds, g, S, E, wave);
    }
    SEAM(PC_NORM2);
    if (HAS(PC_NORM2)) REP(PC_NORM2) ph_norm<false>(x, D1b, ka->in[11], mod + 3 * D, mod + 4 * D, Hb, nullptr, nullptr, nullptr, nullptr, 0, lds, vcu, G, tid, lane, wave);
    SEAM(PC_GEMM3);
    if (HAS(PC_GEMM3)) REP(PC_GEMM3) {
        pg8::Gemm g{Hb, (const bf16*)(ws + WS_WUP), T, FF2, D}; pg8::StaticOrder S; S.init(T, FF2, G, bx);
        pg8::EpiConv E{(bf16*)(ws + WS_ACT), ka->in[13], ka->in[14], (float*)(ws + WS_UH), lds + HALO_OFF, FF};
        pg8::gemm_phase<pg8::EpiConv, pg8::StaticOrder, true, GEMM_SP2>(lds, g, S, E, wave);
#ifndef WD_DYN
        { const int nun = (T / 256) * (FF2 / 256), rem = nun % G;
          const int rank = rem ? bx - rem : bx, nrank = rem ? G - rem : G;
          if (rank >= 0) ph_convert_wd(ka, lds, rank, nrank, wave); }
#else
        ph_convert_wd_dyn(ka, lds, wave);
#endif
    }
    SEAM(PC_CONV);
    if (HAS(PC_CONV)) REP(PC_CONV) ph_convfix(ka, vcu, G, tid);
    SEAM(PC_GEMM4);
    if (HAS(PC_GEMM4)) REP(PC_GEMM4) {
        pg8::Gemm g{(const bf16*)(ws + WS_ACT), (const bf16*)(ws + WS_WD), T, D, FF}; pg8::StaticOrder S; S.init(T, D, G, bx);
        pg8::EpiGate E{D2b, D, mod + 5 * D};
        pg8::gemm_phase<pg8::EpiGate, pg8::StaticOrder, true, GEMM_SP2>(lds, g, S, E, wave);
    }
    SEAM(PC_FNORM);
    if (HAS(PC_FNORM)) REP(PC_FNORM) ph_fnorm(x, D1b, D2b, ka->out, ka->in[16], vcu, G, lane, wave);
#ifdef TP_A
    if (TP_B >= PC_N) tpb_ = wall_clock64();
    if (bx == 0) { const unsigned long long t0_ = wall_clock64(), dd_ = (tpb_ - tpa_) * TP_K; while (wall_clock64() - t0_ < dd_) __builtin_amdgcn_s_sleep(16); }
#endif
#undef HAS
#undef lane
#undef tid
#undef SEAM
#undef ws
#undef x
#undef mod
#undef Hb
#undef PROJ
#undef MIX
#undef D1b
#undef D2b
}

extern "C" void kernel_launch(void* const* d_in, const int* in_sizes, int n_in, void* d_out, int out_size, void* d_ws, size_t ws_size, hipStream_t stream) {
    static int grid = 0;
    if (grid == 0) {
        if (n_in != 17 || in_sizes[0] != T * D || out_size != T * D || ws_size < WS_END) { fprintf(stderr, "kernel_launch: unexpected shapes / workspace (n_in %d, ws %zu)\n", n_in, ws_size); grid = -1; return; }
        int dev = 0, cus = 0, per_cu = 0;
        if (hipGetDevice(&dev) != hipSuccess || hipDeviceGetAttribute(&cus, hipDeviceAttributeMultiprocessorCount, dev) != hipSuccess) { grid = -1; return; }
        if (hipFuncSetAttribute((const void*)fwd, hipFuncAttributeMaxDynamicSharedMemorySize, LDS_BYTES) != hipSuccess) { fprintf(stderr, "kernel_launch: hipFuncSetAttribute failed\n"); grid = -1; return; }
        if (hipOccupancyMaxActiveBlocksPerMultiprocessor(&per_cu, (const void*)fwd, 512, LDS_BYTES) != hipSuccess || per_cu < 1) fprintf(stderr, "kernel_launch: occupancy query reports %d\n", per_cu);
        (void)hipGetLastError();
        grid = cus;
    }
    if (grid < 0) return;
    (void)hipMemsetAsync((char*)d_ws + WS_CTL, 0, CTL_ZERO_BYTES, stream);
    Args a{};
    for (int i = 0; i < 17; ++i) a.in[i] = (const float*)d_in[i];
    a.out = (float*)d_out; a.ws = (unsigned char*)d_ws; a.mask = (1u << PC_N) - 1u; a.pad = 0u;
    hipLaunchKernelGGL(fwd, dim3(grid), dim3(512), LDS_BYTES, stream, a);
}
```
